# Optimizing an MI355X kernel written in HIP

```python
import math
import jax, jax.numpy as jnp
from jax import lax
import numpy as np

D_MODEL = 1024
BATCH = 8
SEQ = 2048
DEPTH = 1
DEC_BATCH = 128
DEC_SEQ = 4
PAST_LEN = 16384
PAGE_SIZE = 128

N_META = 16
S5_WIDTH = D_MODEL // 2
S5_GROUP = 16
S5_GROUPS = S5_WIDTH // S5_GROUP
S5_STATE = 64
GDN_HEADS = 4
GDN_DK = 128
GDN_DV = 128
GDN_KW = GDN_HEADS * GDN_DK
GDN_VW = GDN_HEADS * GDN_DV
QKV_W = 2 * GDN_KW + GDN_VW
CONV_W = 4
CHUNK = 64
D_FF = ((8 * D_MODEL + 3 * 256 - 1) // (3 * 256)) * 256
IN_W = S5_WIDTH + QKV_W + GDN_VW + 2 * GDN_HEADS + 2 * D_MODEL
EPS = 1e-6

kernel_name = "hybrid_s5_gated_deltanet_step"

F32 = jnp.float32


def rms_norm(x, g):
    xf = x.astype(F32)
    y = xf * lax.rsqrt(jnp.mean(xf * xf, axis=-1, keepdims=True) + EPS)
    return (y * g.astype(F32)).astype(x.dtype)


def l2_norm(x):
    return x * lax.rsqrt(jnp.sum(x * x, axis=-1, keepdims=True) + EPS)


def s5_mix(u, h0_re, h0_im, A_re, A_im, B_re, B_im, C_re, C_im, log_dt, D):
    b, l, _ = u.shape
    uf = u.astype(F32)
    ug = uf.reshape(b, l, S5_GROUPS, S5_GROUP).astype(jnp.complex64)
    lam = lax.complex(A_re.astype(F32), A_im.astype(F32))
    dt = jnp.exp(log_dt.astype(F32))[:, None]
    a_bar = jnp.exp(lam * dt)
    B = lax.complex(B_re.astype(F32), B_im.astype(F32))
    B_bar = ((a_bar - 1.0) / lam)[..., None] * B
    bu = jnp.einsum('gpc,blgc->blgp', B_bar, ug)
    h0 = lax.complex(h0_re.astype(F32), h0_im.astype(F32))
    bu = bu.at[:, 0].add(a_bar[None] * h0)
    a_seq = jnp.broadcast_to(a_bar, bu.shape)

    def combine(e1, e2):
        a1, b1 = e1
        a2, b2 = e2
        return a1 * a2, a2 * b1 + b2

    _, h = lax.associative_scan(combine, (a_seq, bu), axis=1)
    C = lax.complex(C_re.astype(F32), C_im.astype(F32))
    y = jnp.real(jnp.einsum('gcp,blgp->blgc', C, h)).reshape(b, l, S5_WIDTH) + D.astype(F32) * uf
    h_last = h[:, -1]
    return y.astype(u.dtype), jnp.real(h_last), jnp.imag(h_last)


def short_conv(x, buf, w):
    l = x.shape[1]
    xp = jnp.concatenate([buf.astype(x.dtype), x], axis=1)
    y = w[0] * xp[:, 0:l]
    for j in range(1, CONV_W):
        y = y + w[j] * xp[:, j:j + l]
    return jax.nn.silu(y), xp[:, xp.shape[1] - (CONV_W - 1):]


def gdn_segment(q, k, v, g, beta, S0):
    b, l, h, dk = q.shape
    dv = v.shape[-1]
    c = min(CHUNK, l)
    n = -(-l // c)
    pad = n * c - l
    if pad:
        padf = lambda t: jnp.pad(t, [(0, 0), (0, pad)] + [(0, 0)] * (t.ndim - 2))
        q, k, v, g, beta = padf(q), padf(k), padf(v), padf(g), padf(beta)

    def to_chunks(t):
        return jnp.moveaxis(t.reshape((b, n, c) + t.shape[2:]), 3, 1)

    q, k, v, g, beta = to_chunks(q), to_chunks(k), to_chunks(v), to_chunks(g), to_chunks(beta)
    gc = jnp.cumsum(g, axis=-1)
    idx = jnp.arange(c)
    causal = idx[:, None] >= idx[None, :]
    strict = idx[:, None] > idx[None, :]
    decay = jnp.exp(jnp.where(causal, gc[..., :, None] - gc[..., None, :], -jnp.inf))
    kb = k * beta[..., None]
    m = jnp.where(strict, jnp.einsum('bhnid,bhnjd->bhnij', kb, k) * decay, 0.0)
    eye = jnp.eye(c, dtype=F32)
    t = lax.linalg.triangular_solve(eye + m, jnp.broadcast_to(eye, m.shape), left_side=True, lower=True)
    u = t @ (v * beta[..., None])
    w = t @ (kb * jnp.exp(gc)[..., None])
    qk = jnp.einsum('bhnid,bhnjd->bhnij', q, k) * decay
    q_dec = q * jnp.exp(gc)[..., None]
    g_last = gc[..., -1]
    k_dec = k * jnp.exp(g_last[..., None] - gc)[..., None]

    def step(S, xs):
        u_i, w_i, qk_i, qd_i, kd_i, gl_i = xs
        v_new = u_i - w_i @ S
        o = qd_i @ S + qk_i @ v_new
        S = S * jnp.exp(gl_i)[..., None, None] + jnp.einsum('bhcd,bhce->bhde', kd_i, v_new)
        return S, o

    xs = (jnp.moveaxis(u, 2, 0), jnp.moveaxis(w, 2, 0), jnp.moveaxis(qk, 2, 0),
          jnp.moveaxis(q_dec, 2, 0), jnp.moveaxis(k_dec, 2, 0), jnp.moveaxis(g_last, 2, 0))
    S, o = lax.scan(step, S0, xs)
    o = jnp.transpose(o, (1, 0, 3, 2, 4)).reshape(b, n * c, h, dv)[:, :l]
    return o, S


def layer(x, h_re, h_im, s_gdn, conv_buf, splits, lp):
    b, l, _ = x.shape
    hn = rms_norm(x, lp['norm_mix_pre'])
    proj = hn @ lp['w_in']
    o1 = S5_WIDTH
    o2 = o1 + QKV_W
    o3 = o2 + GDN_VW
    o4 = o3 + GDN_HEADS
    o5 = o4 + GDN_HEADS
    u, qkv, z, a, bt, gates = jnp.split(proj, [o1, o2, o3, o4, o5], axis=-1)
    y_s5, h_re_n, h_im_n = s5_mix(u, h_re, h_im, lp['s5_A_re'], lp['s5_A_im'], lp['s5_B_re'], lp['s5_B_im'],
                                  lp['s5_C_re'], lp['s5_C_im'], lp['s5_log_dt'], lp['s5_D'])
    gs = jax.nn.gelu(y_s5)
    br_a = (gs @ lp['w_s5_glu_a']) * jax.nn.sigmoid(gs @ lp['w_s5_glu_b'])
    qkv_c, conv_new = short_conv(qkv, conv_buf, lp['gdn_conv_w'])
    qkv_c = qkv_c.astype(F32)
    q = l2_norm(qkv_c[..., :GDN_KW].reshape(b, l, GDN_HEADS, GDN_DK)) * (GDN_DK ** -0.5)
    k = l2_norm(qkv_c[..., GDN_KW:2 * GDN_KW].reshape(b, l, GDN_HEADS, GDN_DK))
    v = qkv_c[..., 2 * GDN_KW:].reshape(b, l, GDN_HEADS, GDN_DV)
    g = -jnp.exp(lp['gdn_A_log'].astype(F32)) * jax.nn.softplus(a.astype(F32) + lp['gdn_dt_bias'].astype(F32))
    beta = jax.nn.sigmoid(bt.astype(F32))
    S = s_gdn.astype(F32)
    bounds = (0,) + tuple(splits) + (l,)
    outs = []
    for s0, s1 in zip(bounds[:-1], bounds[1:]):
        o_seg, S = gdn_segment(q[:, s0:s1], k[:, s0:s1], v[:, s0:s1], g[:, s0:s1], beta[:, s0:s1], S)
        outs.append(o_seg)
    o = jnp.concatenate(outs, axis=1)
    zf = z.astype(F32).reshape(b, l, GDN_HEADS, GDN_DV)
    o = rms_norm(o, lp['gdn_norm']) * jax.nn.silu(zf)
    br_b = o.reshape(b, l, GDN_VW).astype(x.dtype) @ lp['w_gdn_out']
    ga, gb = jnp.split(gates, 2, axis=-1)
    mix = (jax.nn.sigmoid(ga) * br_a + jax.nn.sigmoid(gb) * br_b) @ lp['w_out']
    x = x + rms_norm(mix, lp['norm_mix_post'])
    f = rms_norm(x, lp['norm_ffn_pre'])
    f = (jax.nn.silu(f @ lp['w_ffn_gate']) * (f @ lp['w_ffn_up'])) @ lp['w_ffn_down']
    x = x + rms_norm(f, lp['norm_ffn_post'])
    return x, h_re_n, h_im_n, S, conv_new


def setup_inputs(seed: int = 0) -> dict:
    key = jax.random.key(seed)
    ks = jax.random.split(key, 40)
    nrm = lambda i, shape, s=1.0: jax.random.normal(ks[i], shape, F32) * s
    gain = lambda i, shape: 1.0 + 0.02 * jax.random.normal(ks[i], shape, F32)
    n_idx = jnp.arange(S5_STATE, dtype=F32)
    dt_gdn = jnp.exp(jax.random.uniform(ks[30], (DEPTH, GDN_HEADS), F32, math.log(0.001), math.log(0.1)))
    return {
        'x_prompt': nrm(0, (BATCH, SEQ, D_MODEL)),
        'x_sample': nrm(1, (DEC_BATCH, DEC_SEQ, D_MODEL)),
        'state_s5_re': nrm(2, (DEPTH, DEC_BATCH, S5_GROUPS, S5_STATE), 0.1),
        'state_s5_im': nrm(3, (DEPTH, DEC_BATCH, S5_GROUPS, S5_STATE), 0.1),
        'state_gdn': nrm(4, (DEPTH, DEC_BATCH, GDN_HEADS, GDN_DK, GDN_DV), 0.1),
        'state_conv': nrm(5, (DEPTH, DEC_BATCH, CONV_W - 1, QKV_W)),
        'meta_tokens': nrm(6, (N_META, D_MODEL)),
        'norm_mix_pre': gain(7, (DEPTH, D_MODEL)),
        'norm_mix_post': gain(8, (DEPTH, D_MODEL)),
        'norm_ffn_pre': gain(9, (DEPTH, D_MODEL)),
        'norm_ffn_post': gain(10, (DEPTH, D_MODEL)),
        'w_in': nrm(11, (DEPTH, D_MODEL, IN_W), D_MODEL ** -0.5),
        's5_A_re': -0.5 + nrm(12, (DEPTH, S5_GROUPS, S5_STATE), 0.01),
        's5_A_im': math.pi * n_idx + nrm(13, (DEPTH, S5_GROUPS, S5_STATE), 0.01),
        's5_B_re': nrm(14, (DEPTH, S5_GROUPS, S5_STATE, S5_GROUP), (2 * S5_GROUP) ** -0.5),
        's5_B_im': nrm(15, (DEPTH, S5_GROUPS, S5_STATE, S5_GROUP), (2 * S5_GROUP) ** -0.5),
        's5_C_re': nrm(16, (DEPTH, S5_GROUPS, S5_GROUP, S5_STATE), (2 * S5_STATE) ** -0.5),
        's5_C_im': nrm(17, (DEPTH, S5_GROUPS, S5_GROUP, S5_STATE), (2 * S5_STATE) ** -0.5),
        's5_log_dt': jax.random.uniform(ks[18], (DEPTH, S5_GROUPS), F32, math.log(0.001), math.log(0.1)),
        's5_D': nrm(19, (DEPTH, S5_WIDTH)),
        'w_s5_glu_a': nrm(20, (DEPTH, S5_WIDTH, D_MODEL), S5_WIDTH ** -0.5),
        'w_s5_glu_b': nrm(21, (DEPTH, S5_WIDTH, D_MODEL), S5_WIDTH ** -0.5),
        'gdn_conv_w': nrm(22, (DEPTH, CONV_W, QKV_W), CONV_W ** -0.5),
        'gdn_A_log': jnp.log(jax.random.uniform(ks[23], (DEPTH, GDN_HEADS), F32, 1.0, 16.0)),
        'gdn_dt_bias': dt_gdn + jnp.log(-jnp.expm1(-dt_gdn)),
        'gdn_norm': gain(24, (DEPTH, GDN_DV)),
        'w_gdn_out': nrm(25, (DEPTH, GDN_VW, D_MODEL), GDN_VW ** -0.5),
        'w_out': nrm(26, (DEPTH, D_MODEL, D_MODEL), D_MODEL ** -0.5),
        'w_ffn_gate': nrm(27, (DEPTH, D_MODEL, D_FF), D_MODEL ** -0.5),
        'w_ffn_up': nrm(28, (DEPTH, D_MODEL, D_FF), D_MODEL ** -0.5),
        'w_ffn_down': nrm(29, (DEPTH, D_FF, D_MODEL), D_FF ** -0.5),
    }


def reference(x_prompt, x_sample, state_s5_re, state_s5_im, state_gdn, state_conv, meta_tokens,
              norm_mix_pre, norm_mix_post, norm_ffn_pre, norm_ffn_post, w_in,
              s5_A_re, s5_A_im, s5_B_re, s5_B_im, s5_C_re, s5_C_im, s5_log_dt, s5_D,
              w_s5_glu_a, w_s5_glu_b, gdn_conv_w, gdn_A_log, gdn_dt_bias, gdn_norm, w_gdn_out,
              w_out, w_ffn_gate, w_ffn_up, w_ffn_down):
    xp = jnp.concatenate([jnp.broadcast_to(meta_tokens.astype(x_prompt.dtype)[None], (BATCH, N_META, D_MODEL)),
                          x_prompt], axis=1)
    xs = x_sample
    p_re, p_im, p_gdn, p_conv = [], [], [], []
    s_re, s_im, s_gdn, s_conv = [], [], [], []
    for i in range(DEPTH):
        lp = dict(norm_mix_pre=norm_mix_pre[i], norm_mix_post=norm_mix_post[i],
                  norm_ffn_pre=norm_ffn_pre[i], norm_ffn_post=norm_ffn_post[i], w_in=w_in[i],
                  s5_A_re=s5_A_re[i], s5_A_im=s5_A_im[i], s5_B_re=s5_B_re[i], s5_B_im=s5_B_im[i],
                  s5_C_re=s5_C_re[i], s5_C_im=s5_C_im[i], s5_log_dt=s5_log_dt[i], s5_D=s5_D[i],
                  w_s5_glu_a=w_s5_glu_a[i], w_s5_glu_b=w_s5_glu_b[i], gdn_conv_w=gdn_conv_w[i],
                  gdn_A_log=gdn_A_log[i], gdn_dt_bias=gdn_dt_bias[i], gdn_norm=gdn_norm[i],
                  w_gdn_out=w_gdn_out[i], w_out=w_out[i], w_ffn_gate=w_ffn_gate[i],
                  w_ffn_up=w_ffn_up[i], w_ffn_down=w_ffn_down[i])
        zh = jnp.zeros((BATCH, S5_GROUPS, S5_STATE), F32)
        zs = jnp.zeros((BATCH, GDN_HEADS, GDN_DK, GDN_DV), F32)
        zc = jnp.zeros((BATCH, CONV_W - 1, QKV_W), xp.dtype)
        xp, hr, hi, sg, cb = layer(xp, zh, zh, zs, zc, (N_META,), lp)
        p_re.append(hr.astype(xp.dtype)); p_im.append(hi.astype(xp.dtype))
        p_gdn.append(sg.astype(xp.dtype)); p_conv.append(cb.astype(xp.dtype))
        xs, hr, hi, sg, cb = layer(xs, state_s5_re[i], state_s5_im[i], state_gdn[i], state_conv[i], (), lp)
        s_re.append(hr.astype(state_s5_re.dtype)); s_im.append(hi.astype(state_s5_im.dtype))
        s_gdn.append(sg.astype(state_gdn.dtype)); s_conv.append(cb.astype(state_conv.dtype))
    y_prompt = xp[:, N_META:]
    y_sample = xs
    return (y_prompt, y_sample, jnp.stack(p_re), jnp.stack(p_im), jnp.stack(p_gdn), jnp.stack(p_conv),
            jnp.stack(s_re), jnp.stack(s_im), jnp.stack(s_gdn), jnp.stack(s_conv))
```

```cpp
#include <hip/hip_runtime.h>
#include <hip/hip_cooperative_groups.h>
#include <cstdio>
#include <cstdint>
namespace cg = cooperative_groups;
namespace pg8 {
#define PG8_LAS __attribute__((address_space(3)))
typedef unsigned short bf16_t;
typedef short bf16x8 __attribute__((ext_vector_type(8)));
typedef float f32x4 __attribute__((ext_vector_type(4)));
typedef unsigned u32x4 __attribute__((ext_vector_type(4)));
constexpr int BM = 256, BK = 64, HALF = 128, HTB = HALF * BK * 2  , STAGE_BYTES = 8 * HTB, NXCD = 8, WGM = 8;

__host__ __device__ __forceinline__ int lds_byte(int r, int c) { const int st = (r >> 4) * 2 + (c >> 5), rr = r & 15, cc = c & 31, ob = rr * 64 + cc * 2; return st * 1024 + (ob ^ (((ob >> 9) & 1) << 5)); }
__host__ __device__ __forceinline__ void stage_rc(int b, int& R, int& C) { const int st = b / 1024, sb = b % 1024, swz = sb ^ (((sb >> 9) & 1) << 5); R = (st >> 1) * 16 + swz / 64; C = (st & 1) * 32 + (swz % 64) / 2; }
__host__ __device__ __forceinline__ int perm32(int rho) { const int n = rho >> 4, i = rho & 15; return 8 * (i >> 2) + 4 * n + (i & 3); }

struct Unit { int pm, pn, ks; };
struct SplitK2Order {
    int nM, nN, nwg, G, c;
    __host__ __device__ void init(int M, int N, int G_, int c_) { nM = M / BM; nN = N / BM; nwg = nM * nN; G = G_; c = c_; }
    __host__ __device__ bool next(int i, Unit& u) const {
        const long L = (long)i * G + c; if (L >= 2L * nwg) return false;
        int wgid = (int)(L >> 1); { const int q = nwg / NXCD, r = nwg % NXCD, xcd = wgid % NXCD, off = wgid / NXCD; wgid = (xcd < r ? xcd * (q + 1) : r * (q + 1) + (xcd - r) * q) + off; }
        const int nig = WGM * nN, gid = wgid / nig, fm = gid * WGM, gsz = (nM - fm) < WGM ? (nM - fm) : WGM;
        u.pm = fm + ((wgid % nig) % gsz); u.pn = (wgid % nig) / gsz; u.ks = (int)(L & 1); return true;
    }
    __device__ __forceinline__ void a_ready(const Unit&) const {}
    __device__ __forceinline__ void done(const Unit&) const {}
};
struct Gemm { const bf16_t* A; const bf16_t* Bt; int M, N, K; int ld; };
struct StaticOrder {
    int nM, nN, nwg, G, c;
    __host__ __device__ void init(int M, int N, int G_, int c_) { nM = M / BM; nN = N / BM; nwg = nM * nN; G = G_; c = c_; }
    __host__ __device__ bool next(int i, Unit& u) const {
        const long L = (long)i * G + c; if (L >= nwg) return false;
        int wgid = (int)L; { const int q = nwg / NXCD, r = nwg % NXCD, xcd = wgid % NXCD, off = wgid / NXCD; wgid = (xcd < r ? xcd * (q + 1) : r * (q + 1) + (xcd - r) * q) + off; }
        const int nig = WGM * nN, gid = wgid / nig, fm = gid * WGM, gsz = (nM - fm) < WGM ? (nM - fm) : WGM;
        u.pm = fm + ((wgid % nig) % gsz); u.pn = (wgid % nig) / gsz; u.ks = 0; return true;
    }
    __device__ __forceinline__ void a_ready(const Unit&) const {}
    __device__ __forceinline__ void done(const Unit&) const {}
};
__device__ __forceinline__ unsigned cvt_pk_bf16(float lo, float hi) { unsigned r; asm volatile("v_cvt_pk_bf16_f32 %0, %1, %2" : "=v"(r) : "v"(lo), "v"(hi)); return r; }
template <class Epi, class Sched, bool ALIGN_EPI = false, bool SP2 = false>
__device__ __forceinline__ void gemm_phase(PG8_LAS unsigned char* lds, const Gemm g, const Sched& S, const Epi& E) {
    const int tid = threadIdx.x, wid = __builtin_amdgcn_readfirstlane(tid >> 6), lane = tid & 63, wr = wid >> 2, wc = wid & 3, fr = lane & 15, fq = lane >> 4;
    const int K = g.K, nt = K / BK, LD = g.ld ? g.ld : g.K;
    unsigned voffA[2], voffB[2];
#pragma unroll
    for (int i = 0; i < 2; ++i) { int R, C; stage_rc(tid * 16 + i * 8192, R, C); const int Rb = Epi::PERM ? ((R & ~31) + perm32(R & 31)) : R;
        voffA[i] = (unsigned)(R * LD + C) * 2u; voffB[i] = (unsigned)(Rb * LD + C) * 2u; }
    const size_t kstep = (size_t)(BK * 2);
    const size_t hstep = (size_t)HALF * LD * 2;
    const size_t tstep = 2 * hstep;
    const unsigned ldsw = (unsigned)wid * 1024u;
    const int aoff = lds_byte(wr * 64 + fr, fq * 8), boff = lds_byte(wc * 32 + fr, fq * 8);
#define PG8_SA(b, h) (((b) * 2 + (h)) * HTB)
#define PG8_SB(b, h) ((4 + (b) * 2 + (h)) * HTB)
#define PG8_STAGE(bufoff, gbase, voff) do { _Pragma("unroll") for (int _i = 0; _i < 2; ++_i) \
        __builtin_amdgcn_global_load_lds((const unsigned*)((const char*)(gbase) + (voff)[_i]), (PG8_LAS unsigned*)(lds + (bufoff) + ldsw + _i * 8192), 16, 0, 0); } while (0)
#define PG8_LDA(dst, b, h) do { _Pragma("unroll") for (int m = 0; m < 4; ++m) _Pragma("unroll") for (int k = 0; k < 2; ++k) dst[m][k] = *(const PG8_LAS bf16x8*)(lds + PG8_SA(b, h) + aoff + m * 2048 + k * 1024); } while (0)
#define PG8_LDB(dst, b, h) do { _Pragma("unroll") for (int n = 0; n < 2; ++n) _Pragma("unroll") for (int k = 0; k < 2; ++k) dst[n][k] = *(const PG8_LAS bf16x8*)(lds + PG8_SB(b, h) + boff + n * 2048 + k * 1024); } while (0)
#define PG8_MMA(ai, bj, At, Bt) do { __builtin_amdgcn_s_setprio(1); _Pragma("unroll") for (int m = 0; m < 4; ++m) _Pragma("unroll") for (int n = 0; n < 2; ++n) _Pragma("unroll") for (int k = 0; k < 2; ++k) \
        acc[ai][bj][m][n] = __builtin_amdgcn_mfma_f32_16x16x32_bf16(Bt[n][k], At[m][k], acc[ai][bj][m][n], 0, 0, 0); __builtin_amdgcn_s_setprio(0); } while (0)
#define PG8_WAIT_V(n) asm volatile("s_waitcnt vmcnt(" #n ")" ::: "memory")
#define PG8_WAIT_L(n) asm volatile("s_waitcnt lgkmcnt(" #n ")" ::: "memory")
#define PG8_BAR __builtin_amdgcn_s_barrier()
#define PG8_SCHED __builtin_amdgcn_sched_barrier(0)
    Unit cur, nxt; int ui = 0;
    if (!S.next(0, cur)) return;
    f32x4 acc[2][2][4][2];
#pragma unroll
    for (int a = 0; a < 2; ++a)
#pragma unroll
        for (int b = 0; b < 2; ++b)
#pragma unroll
            for (int m = 0; m < 4; ++m)
#pragma unroll
                for (int n = 0; n < 2; ++n) acc[a][b][m][n] = (f32x4){0.f, 0.f, 0.f, 0.f};
    bf16x8 At[4][2], B0[2][2], B1[2][2];
    const size_t kslice = (size_t)K * 2;
    const char* cA = (const char*)g.A + (size_t)cur.pm * tstep + (size_t)cur.ks * kslice; const char* cB = (const char*)g.Bt + (size_t)cur.pn * tstep + (size_t)cur.ks * kslice;
    S.a_ready(cur);
    if constexpr (SP2) {
        PG8_STAGE(PG8_SB(0, 0), cB, voffB); PG8_STAGE(PG8_SB(0, 1), cB + hstep, voffB); PG8_STAGE(PG8_SA(0, 0), cA, voffA); PG8_STAGE(PG8_SA(0, 1), cA + hstep, voffA);
        if (wr == 1) PG8_BAR;
        PG8_WAIT_V(2); PG8_BAR;
        PG8_STAGE(PG8_SB(1, 0), cB + kstep, voffB); PG8_STAGE(PG8_SA(1, 0), cA + kstep, voffA); PG8_STAGE(PG8_SB(1, 1), cB + hstep + kstep, voffB);
        PG8_WAIT_V(6); PG8_BAR;
    } else {
        PG8_STAGE(PG8_SB(0, 0), cB, voffB); PG8_STAGE(PG8_SA(0, 0), cA, voffA); PG8_STAGE(PG8_SB(0, 1), cB + hstep, voffB); PG8_STAGE(PG8_SA(0, 1), cA + hstep, voffA);
        if (wr == 1) PG8_BAR;
        PG8_WAIT_V(4); PG8_BAR;
        PG8_STAGE(PG8_SB(1, 0), cB + kstep, voffB); PG8_STAGE(PG8_SA(1, 0), cA + kstep, voffA); PG8_STAGE(PG8_SB(1, 1), cB + hstep + kstep, voffB);
        PG8_WAIT_V(6); PG8_BAR;
    }
    for (;;) {
        const bool has_next = S.next(ui + 1, nxt);
        const char* nA = has_next ? (const char*)g.A + (size_t)nxt.pm * tstep + (size_t)nxt.ks * kslice : cA; const char* nB = has_next ? (const char*)g.Bt + (size_t)nxt.pn * tstep + (size_t)nxt.ks * kslice : cB;
        for (int t = 0; t < nt; t += 2) {
            const bool last = (t == nt - 2);
            const char* a1 = cA + (size_t)(t + 1) * kstep;
            const char* a2 = last ? nA : cA + (size_t)(t + 2) * kstep; const char* b2 = last ? nB : cB + (size_t)(t + 2) * kstep;
            const char* a3 = a2 + kstep; const char* b3 = b2 + kstep;
            if (last && has_next) S.a_ready(nxt);
            if constexpr (SP2) {
            PG8_LDB(B0, 0, 0); PG8_LDB(B1, 0, 1); PG8_SCHED; PG8_LDA(At, 0, 0); PG8_STAGE(PG8_SA(1, 1), a1 + hstep, voffA);
            PG8_WAIT_V(8); PG8_WAIT_L(0); PG8_BAR; PG8_MMA(0, 0, At, B0); PG8_MMA(0, 1, At, B1); PG8_BAR; PG8_SCHED;
            PG8_LDA(At, 0, 1); PG8_STAGE(PG8_SB(0, 0), b2, voffB); PG8_STAGE(PG8_SB(0, 1), b2 + hstep, voffB); PG8_STAGE(PG8_SA(0, 0), a2, voffA);
            PG8_WAIT_V(8); PG8_WAIT_L(0); PG8_BAR; PG8_MMA(1, 0, At, B0); PG8_MMA(1, 1, At, B1); PG8_BAR; PG8_SCHED;
            PG8_LDB(B0, 1, 0); PG8_LDB(B1, 1, 1); PG8_SCHED; PG8_LDA(At, 1, 0); PG8_STAGE(PG8_SA(0, 1), a2 + hstep, voffA);
            PG8_WAIT_V(8); PG8_WAIT_L(0); PG8_BAR; PG8_MMA(0, 0, At, B0); PG8_MMA(0, 1, At, B1); PG8_BAR; PG8_SCHED;
            PG8_LDA(At, 1, 1); PG8_STAGE(PG8_SB(1, 0), b3, voffB); PG8_STAGE(PG8_SB(1, 1), b3 + hstep, voffB); PG8_STAGE(PG8_SA(1, 0), a3, voffA);
            PG8_WAIT_V(8); PG8_WAIT_L(0); PG8_BAR; PG8_MMA(1, 0, At, B0); PG8_MMA(1, 1, At, B1); PG8_BAR; PG8_SCHED;
            } else {
            PG8_LDB(B0, 0, 0); PG8_SCHED; PG8_LDA(At, 0, 0); PG8_STAGE(PG8_SA(1, 1), a1 + hstep, voffA);
            PG8_WAIT_L(8); PG8_BAR; PG8_WAIT_L(0); PG8_MMA(0, 0, At, B0); PG8_BAR; PG8_SCHED;
            PG8_LDB(B1, 0, 1); PG8_STAGE(PG8_SB(0, 0), b2, voffB);
            PG8_BAR; PG8_WAIT_L(0); PG8_MMA(0, 1, At, B1); PG8_BAR;
            PG8_LDA(At, 0, 1); PG8_STAGE(PG8_SA(0, 0), a2, voffA);
            PG8_BAR; PG8_WAIT_L(0); PG8_MMA(1, 0, At, B0); PG8_BAR; PG8_SCHED;
            PG8_STAGE(PG8_SB(0, 1), b2 + hstep, voffB);
            PG8_WAIT_V(6); PG8_BAR; PG8_MMA(1, 1, At, B1); PG8_BAR;
            PG8_LDB(B0, 1, 0); PG8_SCHED; PG8_LDA(At, 1, 0); PG8_STAGE(PG8_SA(0, 1), a2 + hstep, voffA);
            PG8_WAIT_L(8); PG8_BAR; PG8_WAIT_L(0); PG8_MMA(0, 0, At, B0); PG8_BAR; PG8_SCHED;
            PG8_LDB(B1, 1, 1); PG8_STAGE(PG8_SB(1, 0), b3, voffB);
            PG8_BAR; PG8_WAIT_L(0); PG8_MMA(0, 1, At, B1); PG8_BAR;
            PG8_LDA(At, 1, 1); PG8_STAGE(PG8_SA(1, 0), a3, voffA);
            PG8_BAR; PG8_WAIT_L(0); PG8_MMA(1, 0, At, B0); PG8_BAR; PG8_SCHED;
            PG8_STAGE(PG8_SB(1, 1), b3 + hstep, voffB);
            PG8_WAIT_V(6); PG8_BAR; PG8_MMA(1, 1, At, B1); PG8_BAR;
            }
        }
        if constexpr (ALIGN_EPI) { if (wr == 0) PG8_BAR; }
        if constexpr (!Epi::AFTER_DRAIN) { E(acc, cur, wr, wc, fr, fq); S.done(cur); }
        if (!has_next) break;
#pragma unroll
        for (int a = 0; a < 2; ++a)
#pragma unroll
            for (int b = 0; b < 2; ++b)
#pragma unroll
                for (int m = 0; m < 4; ++m)
#pragma unroll
                    for (int n = 0; n < 2; ++n) acc[a][b][m][n] = (f32x4){0.f, 0.f, 0.f, 0.f};
        cur = nxt; cA = nA; cB = nB; ++ui;
        if constexpr (ALIGN_EPI) { if (wr == 1) PG8_BAR; }
    }
    PG8_WAIT_V(0);
    if constexpr (!ALIGN_EPI) { if (wr == 0) PG8_BAR; }
    PG8_BAR;
    if constexpr (Epi::AFTER_DRAIN) { E.fused(acc, cur, wr, wc, fr, fq, lds, wid, lane); S.done(cur); }
#undef PG8_SA
#undef PG8_SB
#undef PG8_STAGE
#undef PG8_LDA
#undef PG8_LDB
#undef PG8_MMA
#undef PG8_WAIT_V
#undef PG8_WAIT_L
#undef PG8_BAR
#undef PG8_SCHED
}
}

using pg8::bf16_t; using pg8::bf16x8; using pg8::f32x4; using pg8::u32x4;
typedef unsigned u32x2 __attribute__((ext_vector_type(2)));
typedef float f32x2 __attribute__((ext_vector_type(2)));
#define LDSP __attribute__((address_space(3)))

constexpr int DM = 1024, NB = 8, SEQ = 2048, NMETA = 16, LP = SEQ + NMETA, DB = 128, DS = 4;
constexpr int TPR = NB * LP;
constexpr int T = TPR + DB * DS;
constexpr int TPAD = 17152;
constexpr int S5W = 512, S5G = 32, S5P = 64;
constexpr int GH = 4, QKVW = 1536, DFF = 2816, INW = 4616;
constexpr float EPS = 1e-6f;
constexpr int NTHREADS = 512;
constexpr int LDS_BYTES = 163840;

constexpr size_t O_YP = 0, O_YS = 16777216, O_PRE = 17301504, O_PIM = 17317888, O_PGDN = 17334272, O_PCONV = 17858560,
                 O_SRE = 17895424, O_SIM = 18157568, O_SGDN = 18419712, O_SCONV = 26808320;
constexpr size_t DO_ON = 0, DO_GS = (size_t)TPAD * 512 * 2;
constexpr size_t MiB = 1u << 20;
constexpr size_t WS_W1 = 0, WS_WGLU = WS_W1 + (size_t)4608 * 1024 * 2, WS_WGO = WS_WGLU + (size_t)2048 * 512 * 2, WS_WO = WS_WGO + (size_t)1024 * 512 * 2,
                 WS_WGU = WS_WO + (size_t)1024 * 1024 * 2, WS_WD = WS_WGU + (size_t)5632 * 1024 * 2, WS_WEND = WS_WD + (size_t)1024 * 2816 * 2;
static_assert(WS_WEND <= 31 * MiB - 512 * 1024, "weights");
constexpr size_t WS_AB = 31 * MiB - 512 * 1024;
constexpr size_t WS_S5A = WS_AB + 640 * 1024;
constexpr size_t WS_S5C = WS_S5A + 262144;
constexpr size_t WS_S5K = WS_S5C + 131072;
constexpr size_t WS_S5ADV = WS_S5K + 1310720;
constexpr size_t WS_S5END = WS_S5ADV + 16384;
constexpr size_t WS_SSQ = WS_S5END + 1048576;
constexpr size_t WS_SSQ2 = WS_SSQ + 1089536;
constexpr size_t WS_BAR = 36 * MiB - 16384;
static_assert(WS_SSQ2 + 1089536 <= WS_BAR, "small region");
constexpr size_t WS_B = 36 * MiB;
constexpr size_t WS_C = 113 * MiB;
constexpr size_t WS_REC = WS_B, WS_SA = WS_B, WS_MIXIN = 70 * MiB, WS_FB = WS_B, WS_F2 = WS_B, WS_F2B = 70 * MiB;
constexpr size_t WS_QKV = WS_C, WS_SG = WS_C, WS_MIX = WS_C, WS_MIXB = WS_C + 34 * MiB, WS_H = WS_C;
constexpr size_t WS_U = 180 * MiB, WS_ZS = 197 * MiB, WS_HN = 214 * MiB;
static_assert(WS_SA + (size_t)T * 1024 * 2 <= WS_MIXIN && WS_MIXIN + (size_t)TPAD * 1024 * 2 <= WS_C, "B");
static_assert(WS_SG + (size_t)T * 2048 * 2 <= WS_U && WS_U + (size_t)T * 512 * 2 <= WS_ZS && WS_ZS + (size_t)T * 512 * 2 <= WS_HN, "C/D");
static_assert(WS_H + (size_t)TPAD * DFF * 2 <= WS_HN && WS_HN + (size_t)TPAD * 1024 * 2 <= 256 * MiB, "H/HN");

constexpr int CT = 32, NCH = 65;
constexpr int IMG_WN = 0, IMG_QD = 8704, IMG_KDT = 17408, IMG_QK = 27648, IMG_HDR = 30208, IMG_BYTES = 30272;
constexpr int REC_U = IMG_BYTES, REC_BYTES = IMG_BYTES + 8192 + 64;
constexpr int IMG_V4 = IMG_BYTES / 16;
static_assert(WS_REC + (size_t)32 * NCH * REC_BYTES <= WS_C, "rec");
constexpr int L_OPK = 0, L_OPKB = 8704, L_OPQ = 17408, L_MX = 30272, L_GC = 34880, L_BETA = 35008, L_EG = 35136, L_EGLK = 35264, L_SSQ = 35392,
              L_ULDS = 36864, L_PART = 45056, L_RED = 46080;
constexpr int LC_BUF0 = 0, LC_BUF1 = IMG_BYTES, LC_PART = 2 * IMG_BYTES;

struct Args { const float* in[31]; float* out; unsigned char* ws; int ph_lo, ph_hi; int rep3, pad_; };

typedef __bf16 bf16x2_t __attribute__((ext_vector_type(2)));
__device__ __forceinline__ unsigned pk2(float lo, float hi) { const f32x2 v = {lo, hi}; return __builtin_bit_cast(unsigned, __builtin_convertvector(v, bf16x2_t)); }
__device__ __forceinline__ unsigned short f2bf(float f) { return (unsigned short)(pk2(f, 0.f) & 0xffffu); }
__device__ __forceinline__ float bf2f(unsigned short b) { return __builtin_bit_cast(float, (unsigned)b << 16); }
__device__ __forceinline__ float bflo(unsigned w) { return __builtin_bit_cast(float, w << 16); }
__device__ __forceinline__ float bfhi(unsigned w) { return __builtin_bit_cast(float, w & 0xffff0000u); }
__device__ __forceinline__ float sigmoidf_(float x) { return 1.0f / (1.0f + __expf(-x)); }
__device__ __forceinline__ float siluf_(float x) { return x / (1.0f + __expf(-x)); }
__device__ __forceinline__ float geluf_(float x) { const float u = 1.5957691216057308f * (x + 0.044715f * x * x * x); return x / (1.0f + __expf(-u)); }
template <int CTRL> __device__ __forceinline__ float dpp0(float v) {
    return __builtin_bit_cast(float, __builtin_amdgcn_update_dpp(0, __builtin_bit_cast(int, v), CTRL, 0xF, 0xF, true));
}
__device__ __forceinline__ float row16_sum(float v) {
    v += dpp0<0xB1>(v); v += dpp0<0x4E>(v); v += dpp0<0x141>(v); v += dpp0<0x140>(v); return v;
}
__device__ __forceinline__ float wave_sum(float v) { v = row16_sum(v); v += __shfl_xor(v, 16); v += __shfl_xor(v, 32); return v; }
__device__ __forceinline__ bf16x8 pack8(const f32x4& a, const f32x4& b) {
    u32x4 w; w.x = pk2(a[0], a[1]); w.y = pk2(a[2], a[3]); w.z = pk2(b[0], b[1]); w.w = pk2(b[2], b[3]); return __builtin_bit_cast(bf16x8, w);
}
__device__ __forceinline__ int pos32(int d) { return (d >> 5) * 32 + ((d >> 2) & 3) * 8 + ((d >> 4) & 1) * 4 + (d & 3); }
__device__ __forceinline__ f32x4 mfma16(const bf16x8& a, const bf16x8& b, const f32x4& c) { return __builtin_amdgcn_mfma_f32_16x16x32_bf16(a, b, c, 0, 0, 0); }

__device__ __forceinline__ void lds_barrier() { asm volatile("s_waitcnt lgkmcnt(0)" ::: "memory"); __builtin_amdgcn_s_barrier(); asm volatile("" ::: "memory"); }
__device__ __forceinline__ const float* x_row_ptr(const Args& A, int r) {
    if (r < TPR) { const int b = r / LP, t = r - b * LP; return t < NMETA ? A.in[6] + (size_t)t * DM : A.in[0] + ((size_t)b * SEQ + (t - NMETA)) * DM; }
    return A.in[1] + (size_t)(r - TPR) * DM;
}
__device__ __forceinline__ float* y_row_ptr(const Args& A, int r) {
    if (r < TPR) { const int b = r / LP, t = r - b * LP; return t < NMETA ? nullptr : A.out + O_YP + ((size_t)b * SEQ + (t - NMETA)) * DM; }
    return A.out + O_YS + (size_t)(r - TPR) * DM;
}

#define EPI_LOOP4 _Pragma("unroll") for (int ai = 0; ai < 2; ++ai) _Pragma("unroll") for (int m = 0; m < 4; ++m)
struct EpiIn {
    static constexpr bool PERM = false, AFTER_DRAIN = false;
    bf16_t* U; bf16_t* QKV; bf16_t* ZS; float* out;
    __device__ __forceinline__ void operator()(const f32x4 (&acc)[2][2][4][2], const pg8::Unit& u, int wr, int wc, int fr, int fq) const {
        const int pn = u.pn;
        EPI_LOOP4 {
            const int r = u.pm * 256 + ai * 128 + wr * 64 + m * 16 + fr;
            if (r >= T) continue;
            float* cdst = nullptr;
            if (pn >= 2 && pn < 8) {
                if (r < TPR) { const int b = r / LP, t = r - b * LP; if (t >= LP - 3) cdst = out + O_PCONV + ((size_t)b * 3 + (t - (LP - 3))) * QKVW; }
                else { const int rr = r - TPR, b = rr >> 2, t = rr & 3; if (t >= 1) cdst = out + O_SCONV + ((size_t)b * 3 + (t - 1)) * QKVW; }
            }
#pragma unroll
            for (int bj = 0; bj < 2; ++bj)
#pragma unroll
                for (int n = 0; n < 2; ++n) {
                    const int c = pn * 256 + bj * 128 + wc * 32 + n * 16 + fq * 4; const f32x4 v = acc[ai][bj][m][n];
                    if (pn < 2) { u32x2 w; w.x = pk2(v[0], v[1]); w.y = pk2(v[2], v[3]); *(u32x2*)(U + (size_t)r * 512 + c) = w; }
                    else if (pn < 8) { u32x2 w; w.x = pk2(v[0], v[1]); w.y = pk2(v[2], v[3]); *(u32x2*)(QKV + (size_t)r * QKVW + (c - 512)) = w;
                        if (cdst) *(f32x4*)(cdst + (c - 512)) = v; }
                    else { u32x2 w; w.x = pk2(siluf_(v[0]), siluf_(v[1])); w.y = pk2(siluf_(v[2]), siluf_(v[3])); *(u32x2*)(ZS + (size_t)r * 512 + (c - 2048)) = w; }
                }
        }
    }
};
struct EpiGates {
    static constexpr bool PERM = false, AFTER_DRAIN = false;
    bf16_t* SG;
    __device__ __forceinline__ void operator()(const f32x4 (&acc)[2][2][4][2], const pg8::Unit& u, int wr, int wc, int fr, int fq) const {
        EPI_LOOP4 {
            const int r = u.pm * 256 + ai * 128 + wr * 64 + m * 16 + fr;
            if (r >= T) continue;
#pragma unroll
            for (int bj = 0; bj < 2; ++bj)
#pragma unroll
                for (int n = 0; n < 2; ++n) {
                    const int c = u.pn * 256 + bj * 128 + wc * 32 + n * 16 + fq * 4; const f32x4 v = acc[ai][bj][m][n];
                    u32x2 w; w.x = pk2(sigmoidf_(v[0]), sigmoidf_(v[1])); w.y = pk2(sigmoidf_(v[2]), sigmoidf_(v[3])); *(u32x2*)(SG + (size_t)r * 2048 + c) = w;
                }
        }
    }
};
struct EpiGlu {
    static constexpr bool PERM = false, AFTER_DRAIN = false;
    const bf16_t* SG; bf16_t* SA;
    __device__ __forceinline__ void operator()(const f32x4 (&acc)[2][2][4][2], const pg8::Unit& u, int wr, int wc, int fr, int fq) const {
        EPI_LOOP4 {
            const int r = u.pm * 256 + ai * 128 + wr * 64 + m * 16 + fr;
            if (r >= T) continue;
#pragma unroll
            for (int n = 0; n < 2; ++n) {
                const int c = u.pn * 128 + wc * 32 + n * 16 + fq * 4; const f32x4 a = acc[ai][0][m][n], b = acc[ai][1][m][n];
                const u32x2 g = *(const u32x2*)(SG + (size_t)r * 2048 + c);
                u32x2 w; w.x = pk2(bflo(g.x) * a[0] * sigmoidf_(b[0]), bfhi(g.x) * a[1] * sigmoidf_(b[1]));
                w.y = pk2(bflo(g.y) * a[2] * sigmoidf_(b[2]), bfhi(g.y) * a[3] * sigmoidf_(b[3]));
                *(u32x2*)(SA + (size_t)r * 1024 + c) = w;
            }
        }
    }
};
struct EpiGdnOut {
    static constexpr bool PERM = false, AFTER_DRAIN = false;
    const bf16_t* SG; const bf16_t* SA; bf16_t* MIXIN;
    __device__ __forceinline__ void operator()(const f32x4 (&acc)[2][2][4][2], const pg8::Unit& u, int wr, int wc, int fr, int fq) const {
        EPI_LOOP4 {
            const int r = u.pm * 256 + ai * 128 + wr * 64 + m * 16 + fr;
            if (r >= T) continue;
#pragma unroll
            for (int bj = 0; bj < 2; ++bj)
#pragma unroll
                for (int n = 0; n < 2; ++n) {
                    const int c = u.pn * 256 + bj * 128 + wc * 32 + n * 16 + fq * 4; const f32x4 v = acc[ai][bj][m][n];
                    const u32x2 g = *(const u32x2*)(SG + (size_t)r * 2048 + 1024 + c); const u32x2 s = *(const u32x2*)(SA + (size_t)r * 1024 + c);
                    u32x2 w; w.x = pk2(bflo(s.x) + bflo(g.x) * v[0], bfhi(s.x) + bfhi(g.x) * v[1]); w.y = pk2(bflo(s.y) + bflo(g.y) * v[2], bfhi(s.y) + bfhi(g.y) * v[3]);
                    *(u32x2*)(MIXIN + (size_t)r * 1024 + c) = w;
                }
        }
    }
};
struct EpiF32Ssq {
    static constexpr bool PERM = false, AFTER_DRAIN = false;
    float* O; float* SSQ;
    __device__ __forceinline__ void operator()(const f32x4 (&acc)[2][2][4][2], const pg8::Unit& u, int wr, int wc, int fr, int fq) const {
        EPI_LOOP4 {
            const int r = u.pm * 256 + ai * 128 + wr * 64 + m * 16 + fr;
            float ss = 0.f;
#pragma unroll
            for (int bj = 0; bj < 2; ++bj)
#pragma unroll
                for (int n = 0; n < 2; ++n) {
                    const int c = u.pn * 256 + bj * 128 + wc * 32 + n * 16 + fq * 4; const f32x4 v = acc[ai][bj][m][n];
                    ss += (v[0] * v[0] + v[1] * v[1]) + (v[2] * v[2] + v[3] * v[3]);
                    if (r < T) *(f32x4*)(O + (size_t)r * 1024 + c) = v;
                }
            ss += __shfl_xor(ss, 16); ss += __shfl_xor(ss, 32);
            if (fq == 0 && r < T) SSQ[((size_t)u.pn * T + r) * 4 + wc] = ss;
        }
    }
};
struct EpiBf16Part {
    static constexpr bool PERM = false, AFTER_DRAIN = false;
    bf16_t* O0; bf16_t* O1;
    __device__ __forceinline__ void operator()(const f32x4 (&acc)[2][2][4][2], const pg8::Unit& u, int wr, int wc, int fr, int fq) const {
        bf16_t* O = u.ks ? O1 : O0;
        EPI_LOOP4 {
            const int r = u.pm * 256 + ai * 128 + wr * 64 + m * 16 + fr;
            if (r >= T) continue;
#pragma unroll
            for (int bj = 0; bj < 2; ++bj)
#pragma unroll
                for (int n = 0; n < 2; ++n) {
                    const int c = u.pn * 256 + bj * 128 + wc * 32 + n * 16 + fq * 4; const f32x4 v = acc[ai][bj][m][n];
                    u32x2 w; w.x = pk2(v[0], v[1]); w.y = pk2(v[2], v[3]); *(u32x2*)(O + (size_t)r * 1024 + c) = w;
                }
        }
    }
};
struct EpiFfnUp {
    static constexpr bool PERM = false, AFTER_DRAIN = false;
    bf16_t* H;
    __device__ __forceinline__ void operator()(const f32x4 (&acc)[2][2][4][2], const pg8::Unit& u, int wr, int wc, int fr, int fq) const {
        EPI_LOOP4 {
            const int r = u.pm * 256 + ai * 128 + wr * 64 + m * 16 + fr;
            if (r >= T) continue;
#pragma unroll
            for (int n = 0; n < 2; ++n) {
                const int c = u.pn * 128 + wc * 32 + n * 16 + fq * 4; const f32x4 g = acc[ai][0][m][n], v = acc[ai][1][m][n];
                u32x2 w; w.x = pk2(siluf_(g[0]) * v[0], siluf_(g[1]) * v[1]); w.y = pk2(siluf_(g[2]) * v[2], siluf_(g[3]) * v[3]);
                *(u32x2*)(H + (size_t)r * DFF + c) = w;
            }
        }
    }
};
#define LAS __attribute__((address_space(3)))
#define XB_TMO      128
#define XB_XCNT(j)  (256  + 64 * (j))
#define XB_XSUB(j)  (1280 + 64 * (j))
#define XB_XGEN(j)  (2304 + 64 * (j))
#define XB_TOP      3328
#define XB_TOPGEN   3392
#define XCD_BAR_WORDS 3456
#define XB_SPIN_CAP (1u << 18)

__device__ __forceinline__ unsigned xb_ld(unsigned* p)              { return __hip_atomic_load(p, __ATOMIC_RELAXED, __HIP_MEMORY_SCOPE_AGENT); }
__device__ __forceinline__ unsigned xb_add(unsigned* p, unsigned v) { return __hip_atomic_fetch_add(p, v, __ATOMIC_RELAXED, __HIP_MEMORY_SCOPE_AGENT); }
__device__ __forceinline__ unsigned xb_xcc_id() { return (unsigned)__builtin_amdgcn_s_getreg((3 << 11) | 20) & 0xFu; }
#define XB_SPIN(cond, bar) do { unsigned _sp = 0; while (cond) { __builtin_amdgcn_s_sleep(1); \
    if ((++_sp & 255u) == 0u) { if (xb_ld(&(bar)[XB_TMO])) break; if (_sp > XB_SPIN_CAP) { atomicAdd(&(bar)[XB_TMO], 1u); break; } } } } while (0)

struct XcdBarrier {
    unsigned* bar; unsigned x;
    volatile LAS unsigned* st;
};

__device__ __forceinline__ XcdBarrier xcd_barrier_post(unsigned* bar, volatile LAS unsigned* st) {
    XcdBarrier b; b.bar = bar; b.x = xb_xcc_id(); b.st = st;
    if (threadIdx.x == 0) (void)xb_add(&bar[XB_XCNT(b.x)], 1u);
    return b;
}
__device__ __forceinline__ void xcd_barrier_complete(unsigned* bar, unsigned x, unsigned& nloc, unsigned& nx) {
    const unsigned G = gridDim.x * gridDim.y * gridDim.z;
    unsigned sum, cnt, mine, sp = 0u;
    for (;;) {
        sum = 0u; cnt = 0u; mine = 0u;
#pragma unroll
        for (unsigned j = 0; j < 16; ++j) { const unsigned c = xb_ld(&bar[XB_XCNT(j)]); sum += c; cnt += (c > 0u) ? 1u : 0u; mine = (j == x) ? c : mine; }
        if (sum == G) break;
        __builtin_amdgcn_s_sleep(1);
        if ((++sp & 255u) == 0u) { if (xb_ld(&bar[XB_TMO])) break; if (sp > XB_SPIN_CAP) { atomicAdd(&bar[XB_TMO], 1u); break; } }
    }
    nloc = mine > 0u ? mine : 1u; nx = cnt > 0u ? cnt : 1u;
}

__device__ __forceinline__ void xcd_barrier(const XcdBarrier& b) {
    asm volatile("s_waitcnt vmcnt(0)" ::: "memory");
    __syncthreads();
    if (threadIdx.x == 0) {
        unsigned* bar = b.bar;
        __builtin_amdgcn_s_waitcnt(0);
        unsigned nloc = b.st[0], nx = b.st[1];
        if (nloc == 0u) { xcd_barrier_complete(bar, b.x, nloc, nx); b.st[0] = nloc; b.st[1] = nx; }
        const unsigned old = xb_add(&bar[XB_XSUB(b.x)], 1u);
        const unsigned gen = old / nloc;
        if (old + 1u == (gen + 1u) * nloc) {
            __builtin_amdgcn_fence(__ATOMIC_RELEASE, "agent");
            asm volatile("s_waitcnt vmcnt(0)" ::: "memory");
            const unsigned og = xb_add(&bar[XB_TOP], 1u);
            const unsigned tg = og / nx;
            if (og + 1u == (tg + 1u) * nx) xb_add(&bar[XB_TOPGEN], 1u);
            else XB_SPIN(xb_ld(&bar[XB_TOPGEN]) == tg, bar);
            __builtin_amdgcn_fence(__ATOMIC_ACQUIRE, "agent");
            xb_add(&bar[XB_XGEN(b.x)], 1u);
            asm volatile("s_waitcnt vmcnt(0)" ::: "memory");
        } else {
            XB_SPIN(xb_ld(&bar[XB_XGEN(b.x)]) == gen, bar);
            __builtin_amdgcn_fence(__ATOMIC_ACQUIRE, "agent");
            asm volatile("s_waitcnt vmcnt(0)" ::: "memory");
        }
    }
    __syncthreads();
}

__device__ __forceinline__ void transpose_item(const float* src, int ld, int col0, int k0, bf16_t* dst, int K, int drow0, float* tile, int tid) {
    {
        const int k = tid >> 3, n8 = (tid & 7) * 8;
        const f32x4 a = *(const f32x4*)(src + (size_t)(k0 + k) * ld + col0 + n8), b = *(const f32x4*)(src + (size_t)(k0 + k) * ld + col0 + n8 + 4);
        float* tp = tile + k * 65 + n8;
        tp[0] = a[0]; tp[1] = a[1]; tp[2] = a[2]; tp[3] = a[3]; tp[4] = b[0]; tp[5] = b[1]; tp[6] = b[2]; tp[7] = b[3];
    }
    __syncthreads();
    {
        const int n = tid >> 3, k8 = (tid & 7) * 8; const float* tp = tile + k8 * 65 + n;
        u32x4 w; w.x = pk2(tp[0], tp[65]); w.y = pk2(tp[130], tp[195]); w.z = pk2(tp[260], tp[325]); w.w = pk2(tp[390], tp[455]);
        *(u32x4*)(dst + (size_t)(drow0 + n) * K + k0 + k8) = w;
    }
    __syncthreads();
}

__device__ __forceinline__ void cpow_(float lr, float li, float dt, int k, float& re, float& im) {
    const float mag = expf((float)k * lr * dt);
    double rev = (double)k * (double)li * (double)dt * 0.15915494309189535; rev -= rint(rev);
    const float rf = (float)rev;
    re = mag * __builtin_amdgcn_cosf(rf); im = mag * __builtin_amdgcn_sinf(rf);
}

__device__ __forceinline__ void p0_prologue(const Args& A, unsigned char* lds, int tid) {
    unsigned char* ws = A.ws;
    const int G = gridDim.x, bid = blockIdx.x;
    float* tile = (float*)lds;
    float* wab = (float*)(lds + 20480);
    constexpr int I1 = 72 * 16, I2 = 32 * 8, I3 = 16 * 8, I4 = 16 * 16, I5 = 88 * 16, I6 = 16 * 44, ITOT = I1 + I2 + I3 + I4 + I5 + I6;
    struct TI { const float* src; int ld, col0, k0; bf16_t* dst; int K, drow0; };
    auto item = [&](int it) -> TI {
        int r = it;
        if (r < I1) { const int nb = r >> 4, kb = r & 15, n0 = nb * 64; return TI{A.in[11], INW, n0 < 2560 ? n0 : n0 + 8, kb * 64, (bf16_t*)(ws + WS_W1), 1024, n0}; } r -= I1;
        if (r < I2) { const int nb = r >> 3, kb = r & 7, n0 = nb * 64, pn = n0 >> 8, j = n0 & 255; return TI{j < 128 ? A.in[20] : A.in[21], 1024, pn * 128 + (j & 127), kb * 64, (bf16_t*)(ws + WS_WGLU), 512, n0}; } r -= I2;
        if (r < I3) { const int nb = r >> 3, kb = r & 7; return TI{A.in[26], 1024, nb * 64, kb * 64, (bf16_t*)(ws + WS_WGO), 512, nb * 64}; } r -= I3;
        if (r < I4) { const int nb = r >> 4, kb = r & 15; return TI{A.in[27], 1024, nb * 64, kb * 64, (bf16_t*)(ws + WS_WO), 1024, nb * 64}; } r -= I4;
        if (r < I5) { const int nb = r >> 4, kb = r & 15, n0 = nb * 64, pn = n0 >> 8, j = n0 & 255; return TI{j < 128 ? A.in[28] : A.in[29], DFF, pn * 128 + (j & 127), kb * 64, (bf16_t*)(ws + WS_WGU), 1024, n0}; } r -= I5;
        const int nb = r / 44, kb = r - nb * 44; return TI{A.in[30], 1024, nb * 64, kb * 64, (bf16_t*)(ws + WS_WD), DFF, nb * 64};
    };
    float* tile2 = (float*)(lds + 65536);
    for (int it = bid; it < ITOT; it += 2 * G) {
        const bool two = it + G < ITOT;
        const TI t0 = item(it), t1 = item(two ? it + G : it);
        {
            const int k = tid >> 3, n8 = (tid & 7) * 8;
            const f32x4 a0 = *(const f32x4*)(t0.src + (size_t)(t0.k0 + k) * t0.ld + t0.col0 + n8), b0 = *(const f32x4*)(t0.src + (size_t)(t0.k0 + k) * t0.ld + t0.col0 + n8 + 4);
            const f32x4 a1 = *(const f32x4*)(t1.src + (size_t)(t1.k0 + k) * t1.ld + t1.col0 + n8), b1 = *(const f32x4*)(t1.src + (size_t)(t1.k0 + k) * t1.ld + t1.col0 + n8 + 4);
            float* tp = tile + k * 65 + n8; tp[0] = a0[0]; tp[1] = a0[1]; tp[2] = a0[2]; tp[3] = a0[3]; tp[4] = b0[0]; tp[5] = b0[1]; tp[6] = b0[2]; tp[7] = b0[3];
            float* tq = tile2 + k * 65 + n8; tq[0] = a1[0]; tq[1] = a1[1]; tq[2] = a1[2]; tq[3] = a1[3]; tq[4] = b1[0]; tq[5] = b1[1]; tq[6] = b1[2]; tq[7] = b1[3];
        }
        __syncthreads();
        {
            const int n = tid >> 3, k8 = (tid & 7) * 8; const float* tp = tile + k8 * 65 + n; const float* tq = tile2 + k8 * 65 + n;
            u32x4 w; w.x = pk2(tp[0], tp[65]); w.y = pk2(tp[130], tp[195]); w.z = pk2(tp[260], tp[325]); w.w = pk2(tp[390], tp[455]);
            *(u32x4*)(t0.dst + (size_t)(t0.drow0 + n) * t0.K + t0.k0 + k8) = w;
            if (two) { u32x4 v; v.x = pk2(tq[0], tq[65]); v.y = pk2(tq[130], tq[195]); v.z = pk2(tq[260], tq[325]); v.w = pk2(tq[390], tq[455]);
                *(u32x4*)(t1.dst + (size_t)(t1.drow0 + n) * t1.K + t1.k0 + k8) = v; }
        }
        __syncthreads();
    }
    {
        const int gt = bid * NTHREADS + tid, NT = G * NTHREADS;
        const float* Are = A.in[12]; const float* Aim = A.in[13]; const float* Bre = A.in[14]; const float* Bim = A.in[15];
        const float* Cre = A.in[16]; const float* Cim = A.in[17]; const float* ldt = A.in[18];
        for (int e = gt; e < 32 * 8 * 64; e += NT) {
            const int g = e >> 9, tile_ = (e >> 6) & 7, lane = e & 63, q = lane >> 4, r = lane & 15;
            const float dt = expf(ldt[g]);
            {
                const int pp = tile_ * 16 + r, st = pp >> 1, part = pp & 1;
                const float lr = Are[g * 64 + st], li = Aim[g * 64 + st];
                float ar, ai; cpow_(lr, li, dt, 1, ar, ai);
                const float nr = ar - 1.f, ni = ai, den = 1.f / (lr * lr + li * li);
                const float cr = (nr * lr + ni * li) * den, ci = (ni * lr - nr * li) * den;
                float v[8];
#pragma unroll
                for (int j = 0; j < 8; ++j) {
                    if (q < 2) { const int c = q * 8 + j; const float br = Bre[(g * 64 + st) * 16 + c], bi = Bim[(g * 64 + st) * 16 + c];
                        v[j] = part == 0 ? (cr * br - ci * bi) : (cr * bi + ci * br); } else v[j] = 0.f;
                }
                u32x4 w; w.x = pk2(v[0], v[1]); w.y = pk2(v[2], v[3]); w.z = pk2(v[4], v[5]); w.w = pk2(v[6], v[7]);
                *(u32x4*)(ws + WS_S5A + (size_t)e * 16) = w;
            }
            {
                float* kd = (float*)(ws + WS_S5K) + (size_t)e * 20;
#pragma unroll
                for (int s = 0; s < 2; ++s) {
                    const int st = tile_ * 8 + q * 2 + s; const float lr = Are[g * 64 + st], li = Aim[g * 64 + st];
                    float re, im;
                    cpow_(lr, li, dt, -r, re, im); kd[s * 6 + 0] = re; kd[s * 6 + 1] = im;
                    cpow_(lr, li, dt, r, re, im); kd[s * 6 + 2] = re; kd[s * 6 + 3] = im;
                    cpow_(lr, li, dt, r + 1, re, im); kd[s * 6 + 4] = re; kd[s * 6 + 5] = im;
                }
            }
            if (r == 0) {
                f32x4 o;
                { const int st = tile_ * 8 + q * 2; float re, im; cpow_(Are[g * 64 + st], Aim[g * 64 + st], dt, 256, re, im); o[0] = re; o[1] = im; }
                { const int st = tile_ * 8 + q * 2 + 1; float re, im; cpow_(Are[g * 64 + st], Aim[g * 64 + st], dt, 256, re, im); o[2] = re; o[3] = im; }
                *(f32x4*)(ws + WS_S5ADV + (size_t)((g * 8 + tile_) * 4 + q) * 16) = o;
            }
            if (tile_ < 4) {
                const int pair = tile_; float v[8];
#pragma unroll
                for (int jj = 0; jj < 8; ++jj) { const int pp = (2 * pair + (jj >> 2)) * 16 + q * 4 + (jj & 3), st = pp >> 1;
                    v[jj] = (pp & 1) ? -Cim[(g * 16 + r) * 64 + st] : Cre[(g * 16 + r) * 64 + st]; }
                u32x4 w; w.x = pk2(v[0], v[1]); w.y = pk2(v[2], v[3]); w.z = pk2(v[4], v[5]); w.w = pk2(v[6], v[7]);
                *(u32x4*)(ws + WS_S5C + (size_t)((g * 4 + pair) * 64 + lane) * 16) = w;
            }
        }
    }
    {
        for (int idx = tid; idx < 8192; idx += NTHREADS) { const int k = idx >> 3, o = idx & 7; wab[o * 1024 + k] = A.in[11][(size_t)k * INW + 2560 + o]; }
        __syncthreads();
        const int wave = tid >> 6, lane = tid & 63;
        bf16_t* HN = (bf16_t*)(A.ws + WS_HN); float* AB = (float*)(ws + WS_AB);
        const float* gw = A.in[7];
        f32x4 gv[4];
#pragma unroll
        for (int j = 0; j < 4; ++j) gv[j] = *(const f32x4*)(gw + 4 * lane + 256 * j);
        for (int r = bid * 8 + wave; r < T; r += G * 8) {
            const float* xr = x_row_ptr(A, r);
            f32x4 v[4]; float s = 0.f;
#pragma unroll
            for (int j = 0; j < 4; ++j) { v[j] = *(const f32x4*)(xr + 4 * lane + 256 * j); s += (v[j][0] * v[j][0] + v[j][1] * v[j][1]) + (v[j][2] * v[j][2] + v[j][3] * v[j][3]); }
            const float rs = rsqrtf(wave_sum(s) * (1.f / 1024.f) + EPS);
#pragma unroll
            for (int j = 0; j < 4; ++j) { v[j] = v[j] * rs * gv[j]; u32x2 w; w.x = pk2(v[j][0], v[j][1]); w.y = pk2(v[j][2], v[j][3]); *(u32x2*)(HN + (size_t)r * 1024 + 4 * lane + 256 * j) = w; }
            float ab[8];
#pragma unroll
            for (int o = 0; o < 8; ++o) { float d = 0.f;
#pragma unroll
                for (int j = 0; j < 4; ++j) { const f32x4 w4 = *(const f32x4*)(wab + o * 1024 + 4 * lane + 256 * j); d += (v[j][0] * w4[0] + v[j][1] * w4[1]) + (v[j][2] * w4[2] + v[j][3] * w4[3]); }
                ab[o] = wave_sum(d); }
            if (lane == 0) { *(f32x4*)(AB + (size_t)r * 8) = (f32x4){ab[0], ab[1], ab[2], ab[3]}; *(f32x4*)(AB + (size_t)r * 8 + 4) = (f32x4){ab[4], ab[5], ab[6], ab[7]}; }
        }
        __syncthreads();
    }
}

__device__ __forceinline__ void s5_scan_tile(f32x4& h, const f32x4& k0, const f32x4& k1, const f32x4& k2, const f32x4&, const f32x4&) {
    const float n0r = k0[0], n0i = k0[1], t0r = k0[2], t0i = k0[3], n1r = k1[2], n1i = k1[3], t1r = k2[0], t1i = k2[1];
    float g0 = n0r * h[0] - n0i * h[1], g1 = n0r * h[1] + n0i * h[0], g2 = n1r * h[2] - n1i * h[3], g3 = n1r * h[3] + n1i * h[2];
#define S5_PFX(CTRL) { g0 += dpp0<CTRL>(g0); g1 += dpp0<CTRL>(g1); g2 += dpp0<CTRL>(g2); g3 += dpp0<CTRL>(g3); }
    S5_PFX(0x111) S5_PFX(0x112) S5_PFX(0x114) S5_PFX(0x118)
#undef S5_PFX
    h[0] = t0r * g0 - t0i * g1; h[1] = t0r * g1 + t0i * g0; h[2] = t1r * g2 - t1i * g3; h[3] = t1r * g3 + t1i * g2;
}
__device__ __forceinline__ void s5_add_carry(f32x4& h, const f32x4& cr, const f32x4& k1, const f32x4& k2) {
    const float p0r = k1[0], p0i = k1[1], p1r = k2[2], p1i = k2[3];
    h[0] += p0r * cr[0] - p0i * cr[1]; h[1] += p0r * cr[1] + p0i * cr[0];
    h[2] += p1r * cr[2] - p1i * cr[3]; h[3] += p1r * cr[3] + p1i * cr[2];
}

template <int MODE> __device__ __forceinline__ void s5_unit(const Args& A, int g, int b, int run, int lane) {
    unsigned char* ws = A.ws;
    asm volatile("" : "+v"(lane));
    const int q = lane >> 4, t = lane & 15;
    const bf16_t* U = (const bf16_t*)(ws + WS_U);
    bf16_t* GS = (bf16_t*)((unsigned char*)A.out + DO_GS);
    constexpr int NSMAX = (MODE == 2) ? 16 : 17;
    constexpr int NV = (MODE == 2) ? 4 : 16;
    int nsub, row0, rstride;
    if (MODE == 2) { nsub = 16; row0 = TPR + b * 16 * DS; rstride = DS; }
    else { const int sc0 = run == 0 ? 0 : 17 + (run - 1) * 16; nsub = run == 0 ? 17 : 16; row0 = b * LP + sc0 * 16; rstride = 16; }
    f32x4 Y[NSMAX];
#pragma unroll
    for (int sc = 0; sc < NSMAX; ++sc) Y[sc] = (f32x4){0.f, 0.f, 0.f, 0.f};
    const bool uvalid = (q < 2) && (t < NV);
    for (int pair = 0; pair < 4; ++pair) {
        const int t0 = 2 * pair, t1 = 2 * pair + 1;
        const f32x4* kp0 = (const f32x4*)(ws + WS_S5K) + ((size_t)(g * 8 + t0) * 64 + lane) * 5;
        const f32x4* kp1 = (const f32x4*)(ws + WS_S5K) + ((size_t)(g * 8 + t1) * 64 + lane) * 5;
        const f32x4 ka0 = kp0[0], ka1 = kp0[1], ka2 = kp0[2], ka3 = ka0, ka4 = ka0;
        const f32x4 kb0 = kp1[0], kb1 = kp1[1], kb2 = kp1[2], kb3 = kb0, kb4 = kb0;
        const bf16x8 A0 = *(const bf16x8*)(ws + WS_S5A + ((size_t)(g * 8 + t0) * 64 + lane) * 16);
        const bf16x8 A1 = *(const bf16x8*)(ws + WS_S5A + ((size_t)(g * 8 + t1) * 64 + lane) * 16);
        const bf16x8 Cop = *(const bf16x8*)(ws + WS_S5C + ((size_t)(g * 4 + pair) * 64 + lane) * 16);
        f32x4 c0 = (f32x4){0.f, 0.f, 0.f, 0.f}, c1 = c0;
        const bf16_t* up = U + (size_t)(row0 + t) * 512 + g * 16 + q * 8;
        const bf16x8 bzero = (bf16x8){0, 0, 0, 0, 0, 0, 0, 0};
        bf16x8 bq[NSMAX + 2];
        bq[0] = uvalid ? *(const bf16x8*)up : bzero; up += rstride * 512; asm volatile("" : "+v"(up));
        bq[1] = (uvalid && 1 < nsub) ? *(const bf16x8*)up : bzero; up += rstride * 512; asm volatile("" : "+v"(up));
        if (MODE == 1) {
            const f32x4 ad0 = *(const f32x4*)(ws + WS_S5ADV + (size_t)((g * 8 + t0) * 4 + q) * 16), ad1 = *(const f32x4*)(ws + WS_S5ADV + (size_t)((g * 8 + t1) * 4 + q) * 16);
            const float* endp = (const float*)(ws + WS_S5END) + ((size_t)(b * 32 + g) * 8) * 128;
            for (int rp = 0; rp < run; ++rp) {
                const f32x4 e0 = *(const f32x4*)(endp + rp * 128 + t0 * 16 + q * 4), e1 = *(const f32x4*)(endp + rp * 128 + t1 * 16 + q * 4);
                f32x4 n0, n1;
                n0[0] = ad0[0] * c0[0] - ad0[1] * c0[1] + e0[0]; n0[1] = ad0[0] * c0[1] + ad0[1] * c0[0] + e0[1];
                n0[2] = ad0[2] * c0[2] - ad0[3] * c0[3] + e0[2]; n0[3] = ad0[2] * c0[3] + ad0[3] * c0[2] + e0[3];
                n1[0] = ad1[0] * c1[0] - ad1[1] * c1[1] + e1[0]; n1[1] = ad1[0] * c1[1] + ad1[1] * c1[0] + e1[1];
                n1[2] = ad1[2] * c1[2] - ad1[3] * c1[3] + e1[2]; n1[3] = ad1[2] * c1[3] + ad1[3] * c1[2] + e1[3];
                c0 = n0; c1 = n1;
            }
        }
#pragma unroll
        for (int sc = 0; sc < NSMAX; ++sc) {
            if (sc < nsub) {
                if (sc + 2 < NSMAX) { bq[sc + 2] = (uvalid && sc + 2 < nsub) ? *(const bf16x8*)up : bzero; up += rstride * 512; asm volatile("" : "+v"(up)); }
                const bf16x8 Bop = bq[sc];
                const f32x4 z = (f32x4){0.f, 0.f, 0.f, 0.f};
                f32x4 h0 = mfma16(A0, Bop, z), h1 = mfma16(A1, Bop, z);
                s5_scan_tile(h0, ka0, ka1, ka2, ka3, ka4);
                s5_scan_tile(h1, kb0, kb1, kb2, kb3, kb4);
                if (MODE == 2) {
                    const int bb = b * 16 + sc; const float* sre = A.in[2] + ((size_t)bb * 32 + g) * 64; const float* sim = A.in[3] + ((size_t)bb * 32 + g) * 64;
                    const int s0 = t0 * 8 + q * 2, s1 = t1 * 8 + q * 2;
                    c0 = (f32x4){sre[s0], sim[s0], sre[s0 + 1], sim[s0 + 1]}; c1 = (f32x4){sre[s1], sim[s1], sre[s1 + 1], sim[s1 + 1]};
                }
                s5_add_carry(h0, c0, ka1, ka2); s5_add_carry(h1, c1, kb1, kb2);
                const int src = (lane & 48) | (NV - 1);
#pragma unroll
                for (int k = 0; k < 4; ++k) { c0[k] = __shfl(h0[k], src); c1[k] = __shfl(h1[k], src); }
                if (MODE == 2) {
                    if (t == NV - 1) { const int bb = b * 16 + sc; float* ore = A.out + O_SRE + ((size_t)bb * 32 + g) * 64; float* oim = A.out + O_SIM + ((size_t)bb * 32 + g) * 64;
                        const int s0 = t0 * 8 + q * 2, s1 = t1 * 8 + q * 2;
                        ore[s0] = h0[0]; oim[s0] = h0[1]; ore[s0 + 1] = h0[2]; oim[s0 + 1] = h0[3];
                        ore[s1] = h1[0]; oim[s1] = h1[1]; ore[s1 + 1] = h1[2]; oim[s1 + 1] = h1[3]; }
                }
                if (MODE != 0) Y[sc] = mfma16(Cop, pack8(h0, h1), Y[sc]);
                asm volatile("" ::: "memory");
            }
        }
        if (MODE == 0) {
            if (t == 15) { float* endp = (float*)(ws + WS_S5END) + ((size_t)((b * 32 + g) * 8 + run)) * 128;
                *(f32x4*)(endp + t0 * 16 + q * 4) = c0; *(f32x4*)(endp + t1 * 16 + q * 4) = c1; }
        }
        if (MODE == 1) {
            if (run == 7 && t == 15) { float* ore = A.out + O_PRE + ((size_t)b * 32 + g) * 64; float* oim = A.out + O_PIM + ((size_t)b * 32 + g) * 64;
                const int s0 = t0 * 8 + q * 2, s1 = t1 * 8 + q * 2;
                ore[s0] = c0[0]; oim[s0] = c0[1]; ore[s0 + 1] = c0[2]; oim[s0 + 1] = c0[3];
                ore[s1] = c1[0]; oim[s1] = c1[1]; ore[s1 + 1] = c1[2]; oim[s1 + 1] = c1[3]; }
        }
    }
    if (MODE != 0) {
        const f32x4 Dv = *(const f32x4*)(A.in[19] + g * 16 + q * 4);
        size_t eoff = (size_t)(row0 + t) * 512 + g * 16 + q * 4;
#pragma unroll
        for (int sc = 0; sc < NSMAX; ++sc) {
            if (sc < nsub && t < NV) {
                const u32x2 uu = *(const u32x2*)(U + eoff);
                const float y0 = Y[sc][0] + Dv[0] * bflo(uu.x), y1 = Y[sc][1] + Dv[1] * bfhi(uu.x), y2 = Y[sc][2] + Dv[2] * bflo(uu.y), y3 = Y[sc][3] + Dv[3] * bfhi(uu.y);
                u32x2 w; w.x = pk2(geluf_(y0), geluf_(y1)); w.y = pk2(geluf_(y2), geluf_(y3));
                *(u32x2*)(GS + eoff) = w;
            }
            eoff += rstride * 512; asm volatile("" : "+v"(eoff));
        }
    }
}

__device__ __forceinline__ void s5_decode(const Args& A, int g, int bg, int lane) {
    unsigned char* ws = A.ws;
    asm volatile("" : "+v"(lane));
    const int q = lane >> 4, t = lane & 15;
    const bf16_t* U = (const bf16_t*)(ws + WS_U);
    bf16_t* GS = (bf16_t*)((unsigned char*)A.out + DO_GS);
    const bool uvalid = (q < 2) && (t < DS);
    const f32x4 Dv = *(const f32x4*)(A.in[19] + g * 16 + q * 4);
#pragma unroll 1
    for (int sc = 0; sc < 16; ++sc) {
        const int bb = bg * 16 + sc, row = TPR + bb * DS + t;
        bf16x8 Bop = (bf16x8){0, 0, 0, 0, 0, 0, 0, 0};
        if (uvalid) Bop = *(const bf16x8*)(U + (size_t)row * 512 + g * 16 + q * 8);
        const float* sre = A.in[2] + ((size_t)bb * 32 + g) * 64; const float* sim = A.in[3] + ((size_t)bb * 32 + g) * 64;
        float* ore = A.out + O_SRE + ((size_t)bb * 32 + g) * 64; float* oim = A.out + O_SIM + ((size_t)bb * 32 + g) * 64;
        f32x4 Y = (f32x4){0.f, 0.f, 0.f, 0.f};
#pragma unroll 1
        for (int pair = 0; pair < 4; ++pair) {
            const int t0 = 2 * pair, t1 = 2 * pair + 1;
            const f32x4* kp0 = (const f32x4*)(ws + WS_S5K) + ((size_t)(g * 8 + t0) * 64 + lane) * 5;
            const f32x4* kp1 = (const f32x4*)(ws + WS_S5K) + ((size_t)(g * 8 + t1) * 64 + lane) * 5;
            const f32x4 ka0 = kp0[0], ka1 = kp0[1], ka2 = kp0[2], ka3 = ka0, ka4 = ka0;
            const f32x4 kb0 = kp1[0], kb1 = kp1[1], kb2 = kp1[2], kb3 = kb0, kb4 = kb0;
            const bf16x8 A0 = *(const bf16x8*)(ws + WS_S5A + ((size_t)(g * 8 + t0) * 64 + lane) * 16);
            const bf16x8 A1 = *(const bf16x8*)(ws + WS_S5A + ((size_t)(g * 8 + t1) * 64 + lane) * 16);
            const bf16x8 Cop = *(const bf16x8*)(ws + WS_S5C + ((size_t)(g * 4 + pair) * 64 + lane) * 16);
            const f32x4 z = (f32x4){0.f, 0.f, 0.f, 0.f};
            f32x4 h0 = mfma16(A0, Bop, z), h1 = mfma16(A1, Bop, z);
            s5_scan_tile(h0, ka0, ka1, ka2, ka3, ka4);
            s5_scan_tile(h1, kb0, kb1, kb2, kb3, kb4);
            const int s0 = t0 * 8 + q * 2, s1 = t1 * 8 + q * 2;
            const f32x4 c0 = (f32x4){sre[s0], sim[s0], sre[s0 + 1], sim[s0 + 1]}, c1 = (f32x4){sre[s1], sim[s1], sre[s1 + 1], sim[s1 + 1]};
            s5_add_carry(h0, c0, ka1, ka2); s5_add_carry(h1, c1, kb1, kb2);
            if (t == DS - 1) { ore[s0] = h0[0]; oim[s0] = h0[1]; ore[s0 + 1] = h0[2]; oim[s0 + 1] = h0[3];
                               ore[s1] = h1[0]; oim[s1] = h1[1]; ore[s1 + 1] = h1[2]; oim[s1 + 1] = h1[3]; }
            Y = mfma16(Cop, pack8(h0, h1), Y);
        }
        if (t < DS) {
            const u32x2 uu = *(const u32x2*)(U + (size_t)row * 512 + g * 16 + q * 4);
            const float y0 = Y[0] + Dv[0] * bflo(uu.x), y1 = Y[1] + Dv[1] * bfhi(uu.x), y2 = Y[2] + Dv[2] * bflo(uu.y), y3 = Y[3] + Dv[3] * bfhi(uu.y);
            u32x2 w; w.x = pk2(geluf_(y0), geluf_(y1)); w.y = pk2(geluf_(y2), geluf_(y3));
            *(u32x2*)(GS + (size_t)row * 512 + g * 16 + q * 4) = w;
        }
    }
}

__device__ __forceinline__ void gdn_step(const LDSP unsigned char* img, const u32x2 (&uw)[2], f32x4 (&S)[8], f32x4 (&o)[2], int lane) {
    const int q = lane >> 4, r = lane & 15;
    bf16x8 Sop[4];
#pragma unroll
    for (int i = 0; i < 4; ++i) Sop[i] = pack8(S[2 * i], S[2 * i + 1]);
    bf16x8 aw[2][4];
#pragma unroll
    for (int mt = 0; mt < 2; ++mt)
#pragma unroll
        for (int i = 0; i < 4; ++i) aw[mt][i] = *(const LDSP bf16x8*)(img + IMG_WN + (mt * 16 + r) * 272 + i * 64 + q * 16);
    bf16x8 aq[2][5];
#pragma unroll
    for (int mt = 0; mt < 2; ++mt) {
#pragma unroll
        for (int i = 0; i < 4; ++i) aq[mt][i] = *(const LDSP bf16x8*)(img + IMG_QD + (mt * 16 + r) * 272 + i * 64 + q * 16);
        aq[mt][4] = *(const LDSP bf16x8*)(img + IMG_QK + (mt * 16 + r) * 80 + q * 16);
    }
    f32x4 vn[2];
#pragma unroll
    for (int mt = 0; mt < 2; ++mt) vn[mt] = (f32x4){bflo(uw[mt].x), bfhi(uw[mt].x), bflo(uw[mt].y), bfhi(uw[mt].y)};
#pragma unroll
    for (int i = 0; i < 4; ++i)
#pragma unroll
        for (int mt = 0; mt < 2; ++mt) vn[mt] = mfma16(aw[mt][i], Sop[i], vn[mt]);
    bf16x8 ak[8];
#pragma unroll
    for (int dt = 0; dt < 8; ++dt) ak[dt] = *(const LDSP bf16x8*)(img + IMG_KDT + (dt * 16 + r) * 80 + q * 16);
    const float egl = *(const LDSP float*)(img + IMG_HDR);
#pragma unroll
    for (int mt = 0; mt < 2; ++mt) o[mt] = (f32x4){0.f, 0.f, 0.f, 0.f};
#pragma unroll
    for (int i = 0; i < 4; ++i)
#pragma unroll
        for (int mt = 0; mt < 2; ++mt) o[mt] = mfma16(aq[mt][i], Sop[i], o[mt]);
    const bf16x8 Vop = pack8(vn[0], vn[1]);
#pragma unroll
    for (int mt = 0; mt < 2; ++mt) o[mt] = mfma16(aq[mt][4], Vop, o[mt]);
#pragma unroll
    for (int dt = 0; dt < 8; ++dt) S[dt] = mfma16(ak[dt], Vop, S[dt] * egl);
}
__device__ __forceinline__ void gdn_zs_prefetch(const Args& A, unsigned (&zs)[8], int rowbase, int nvalid, int h, int wave, int lane) {
    const int q = lane >> 4, n = lane & 15; const bf16_t* ZS = (const bf16_t*)(A.ws + WS_ZS); const int e = h * 128 + wave * 16 + n;
#pragma unroll
    for (int mt = 0; mt < 2; ++mt)
#pragma unroll
        for (int jj = 0; jj < 4; ++jj) { const int tok = mt * 16 + q * 4 + jj; zs[mt * 4 + jj] = tok < nvalid ? (unsigned)ZS[(size_t)(rowbase + tok) * 512 + e] : 0u; }
}
__device__ __forceinline__ void gdn_norm_store(const Args& A, const f32x4 (&o)[2], unsigned (&zs)[8], float gn, LDSP float* part, int rowbase, int nvalid, int h, int wave, int lane) {
    const int q = lane >> 4, n = lane & 15;
#pragma unroll
    for (int mt = 0; mt < 2; ++mt)
#pragma unroll
        for (int jj = 0; jj < 4; ++jj) { const float s = row16_sum(o[mt][jj] * o[mt][jj]); if (n == 0) part[wave * 32 + mt * 16 + q * 4 + jj] = s; }
    lds_barrier();
#pragma unroll
    for (int k = 0; k < 8; ++k) asm volatile("" : "+v"(zs[k]));
    bf16_t* ON = (bf16_t*)((unsigned char*)A.out + DO_ON);
    const int e = h * 128 + wave * 16 + n;
#pragma unroll
    for (int mt = 0; mt < 2; ++mt)
#pragma unroll
        for (int jj = 0; jj < 4; ++jj) {
            const int tok = mt * 16 + q * 4 + jj;
            if (tok < nvalid) {
                float tot = 0.f;
#pragma unroll
                for (int w = 0; w < 8; ++w) tot += part[w * 32 + tok];
                const float rs = rsqrtf(tot * (1.f / 128.f) + EPS);
                const size_t row = (size_t)(rowbase + tok);
#ifndef NO_ONSTORE
                ON[row * 512 + e] = f2bf(o[mt][jj] * rs * gn * __builtin_bit_cast(float, zs[mt * 4 + jj] << 16));
#endif
            }
        }
}
__device__ __forceinline__ void gdn_store_state(float* dst, const f32x4 (&S)[8], int wave, int lane) {
    const int q = lane >> 4, n = lane & 15;
#pragma unroll
    for (int dt = 0; dt < 8; ++dt)
#pragma unroll
        for (int jj = 0; jj < 4; ++jj) {
#ifdef SANITIZE
            float v = S[dt][jj]; if (!(fabsf(v) < 1e30f)) v = 12345.f; dst[(size_t)(dt * 16 + q * 4 + jj) * 128 + wave * 16 + n] = v;
#else
            dst[(size_t)(dt * 16 + q * 4 + jj) * 128 + wave * 16 + n] = S[dt][jj];
#endif
        }
}

__device__ __forceinline__ void gdn_prep(const Args& A, unsigned char* lds, int kind, int b, int h, int nchunk, int tid) {
    unsigned char* ws = A.ws;
    asm volatile("" : "+v"(tid));
    const int wave = tid >> 6, lane = tid & 63, grp = tid >> 7, cc = tid & 127;
    int rowbase, nvalid; bool hist_rows;
    if (kind == 0) { const int t0 = nchunk == 0 ? 0 : NMETA + (nchunk - 1) * CT; nvalid = nchunk == 0 ? NMETA : CT; rowbase = b * LP + t0; hist_rows = nchunk > 0; }
    else { nvalid = DS; rowbase = TPR + b * DS; hist_rows = false; }
    LDSP unsigned char* l3 = (LDSP unsigned char*)lds; asm volatile("" : "+v"(l3));
    LDSP float* MX = (LDSP float*)(l3 + L_MX); LDSP float* GC = (LDSP float*)(l3 + L_GC); LDSP float* BETA = (LDSP float*)(l3 + L_BETA); LDSP float* EG = (LDSP float*)(l3 + L_EG);
    LDSP float* EGLK = (LDSP float*)(l3 + L_EGLK); LDSP float* SSQ = (LDSP float*)(l3 + L_SSQ); LDSP float* PART = (LDSP float*)(l3 + L_PART);
    float x[CT];
    if (grp < 3) {
        const int colq = (grp == 0 ? 1024 : grp == 1 ? 512 : 0) + h * 128 + cc;
        const float* cw = A.in[22];
        const float w0 = cw[colq], w1 = cw[QKVW + colq], w2 = cw[2 * QKVW + colq], w3 = cw[3 * QKVW + colq];
        const bf16_t* QKV = (const bf16_t*)(ws + WS_QKV);
        float p0 = 0.f, p1 = 0.f, p2 = 0.f;
        if (kind == 1) { const float* sc = A.in[5] + (size_t)b * 3 * QKVW + colq; p0 = sc[0]; p1 = sc[QKVW]; p2 = sc[2 * QKVW]; }
        else if (hist_rows) { p0 = bf2f(QKV[(size_t)(rowbase - 3) * QKVW + colq]); p1 = bf2f(QKV[(size_t)(rowbase - 2) * QKVW + colq]); p2 = bf2f(QKV[(size_t)(rowbase - 1) * QKVW + colq]); }
#pragma unroll
        for (int i = 0; i < CT; ++i) {
            float cur = 0.f, v = 0.f;
            if (i < nvalid) { cur = bf2f(QKV[(size_t)(rowbase + i) * QKVW + colq]); const float y = w0 * p0 + w1 * p1 + w2 * p2 + w3 * cur; v = siluf_(y); }
            x[i] = v; p0 = p1; p1 = p2; p2 = cur;
        }
        if (grp >= 1) {
            LDSP float* red = (LDSP float*)(l3 + L_RED) + (wave - 2) * (CT * 68);
#pragma unroll
            for (int i = 0; i < CT; ++i) red[i * 68 + lane] = x[i] * x[i];
            asm volatile("s_waitcnt lgkmcnt(0)" ::: "memory");
            if (lane < CT) {
                f32x4 acc4 = (f32x4){0.f, 0.f, 0.f, 0.f};
#pragma unroll
                for (int c4 = 0; c4 < 16; ++c4) acc4 += *(const LDSP f32x4*)(red + lane * 68 + c4 * 4);
                SSQ[(wave - 2) * CT + lane] = (acc4[0] + acc4[1]) + (acc4[2] + acc4[3]);
            }
        }
    } else if (wave == 7) {
        float gval = 0.f, beta = 0.f;
        if (lane < nvalid) {
            const float* ab = (const float*)(ws + WS_AB) + (size_t)(rowbase + lane) * 8;
            const float a = ab[h] + A.in[24][h];
            const float sp = a > 20.f ? a : log1pf(expf(a));
            gval = -expf(A.in[23][h]) * sp;
            beta = 1.0f / (1.0f + expf(-ab[4 + h]));
        }
        float gc = gval;
#pragma unroll
        for (int off = 1; off < 64; off <<= 1) { const float v = __shfl_up(gc, off); if (lane >= off) gc += v; }
        const float gl = __shfl(gc, 63);
        if (lane < CT) { GC[lane] = gc; BETA[lane] = beta; EG[lane] = expf(gc); EGLK[lane] = expf(gl - gc); }
        if (lane == 0) *(LDSP float*)(l3 + IMG_HDR) = expf(gl);
    }
    lds_barrier();
    if (grp == 1 || grp == 2) {
        const int g0 = (grp - 1) * 2; const float sc = grp == 2 ? 0.08838834764831845f : 1.0f;
        LDSP bf16_t* op0 = (LDSP bf16_t*)(l3 + (grp == 1 ? L_OPK : L_OPQ)); LDSP bf16_t* opkb = (LDSP bf16_t*)(l3 + L_OPKB);
#pragma unroll
        for (int i = 0; i < CT; ++i) {
            const float inv = rsqrtf(SSQ[g0 * CT + i] + SSQ[(g0 + 1) * CT + i] + EPS) * sc;
            x[i] *= inv;
            op0[i * 136 + cc] = f2bf(x[i]);
            if (grp == 1) opkb[i * 136 + cc] = f2bf(x[i] * BETA[i]);
        }
    }
    lds_barrier();
    if (wave < 4) {
        const int q = lane >> 4, r = lane & 15, mt = wave >> 1, nt = wave & 1;
        f32x4 am = (f32x4){0.f, 0.f, 0.f, 0.f}, aq = am;
        if (nt <= mt) {
#pragma unroll
            for (int ks = 0; ks < 4; ++ks) {
                const bf16x8 bk = *(const LDSP bf16x8*)(l3 + L_OPK + (nt * 16 + r) * 272 + ks * 64 + q * 16);
                const bf16x8 akb = *(const LDSP bf16x8*)(l3 + L_OPKB + (mt * 16 + r) * 272 + ks * 64 + q * 16);
                const bf16x8 aqn = *(const LDSP bf16x8*)(l3 + L_OPQ + (mt * 16 + r) * 272 + ks * 64 + q * 16);
                am = mfma16(akb, bk, am); aq = mfma16(aqn, bk, aq);
            }
        }
        const int j = nt * 16 + r; const float gj = GC[j];
        LDSP bf16_t* qk = (LDSP bf16_t*)(l3 + IMG_QK);
#pragma unroll
        for (int jj = 0; jj < 4; ++jj) {
            const int i = mt * 16 + q * 4 + jj;
            const float dec = (i >= j) ? __expf(GC[i] - gj) : 0.f;
            MX[i * 36 + j] = (i > j) ? am[jj] * dec : 0.f;
            qk[i * 40 + pos32(j)] = f2bf(aq[jj] * dec);
        }
    }
    lds_barrier();
    if (grp == 1) {
        LDSP bf16_t* kdt = (LDSP bf16_t*)(l3 + IMG_KDT);
#pragma unroll
        for (int i = 0; i < CT; ++i) { kdt[cc * 40 + pos32(i)] = f2bf(x[i] * EGLK[i]); x[i] *= BETA[i] * EG[i]; }
    } else if (grp == 2) {
        LDSP bf16_t* qd = (LDSP bf16_t*)(l3 + IMG_QD); const int pc = pos32(cc);
#pragma unroll
        for (int i = 0; i < CT; ++i) qd[i * 136 + pc] = f2bf(x[i] * EG[i]);
    } else if (grp == 0) {
#pragma unroll
        for (int i = 0; i < CT; ++i) x[i] *= BETA[i];
    }
    if (grp < 2) {
#pragma unroll
        for (int i = 1; i < CT; ++i) {
            float s = x[i];
#pragma unroll
            for (int j4 = 0; j4 < (i + 3) / 4; ++j4) {
                const f32x4 mv = *(const LDSP f32x4*)(MX + i * 36 + j4 * 4);
                if (j4 * 4 + 0 < i) s -= mv[0] * x[j4 * 4 + 0];
                if (j4 * 4 + 1 < i) s -= mv[1] * x[j4 * 4 + 1];
                if (j4 * 4 + 2 < i) s -= mv[2] * x[j4 * 4 + 2];
                if (j4 * 4 + 3 < i) s -= mv[3] * x[j4 * 4 + 3];
            }
            x[i] = s;
            if ((i & 1) == 1) asm volatile("" ::: "memory");
        }
    }
    if (grp == 1) {
        LDSP bf16_t* wn = (LDSP bf16_t*)(l3 + IMG_WN); const int pc = pos32(cc);
#pragma unroll
        for (int i = 0; i < CT; ++i) wn[i * 136 + pc] = f2bf(-x[i]);
    } else if (grp == 0) {
        unsigned char* ub = (kind == 0) ? (ws + WS_REC + (size_t)((b * GH + h) * NCH + nchunk) * REC_BYTES + REC_U) : (lds + L_ULDS);
        const int et = cc >> 4, n = cc & 15;
#pragma unroll
        for (int mt = 0; mt < 2; ++mt)
#pragma unroll
            for (int qq = 0; qq < 4; ++qq) {
                u32x2 w; w.x = pk2(x[mt * 16 + qq * 4 + 0], x[mt * 16 + qq * 4 + 1]); w.y = pk2(x[mt * 16 + qq * 4 + 2], x[mt * 16 + qq * 4 + 3]);
                *(u32x2*)(ub + ((size_t)((et * 2 + mt) * 64 + qq * 16 + n)) * 8) = w;
            }
    }
    lds_barrier();
    if (kind == 0) {
        u32x4* dst = (u32x4*)(ws + WS_REC + (size_t)((b * GH + h) * NCH + nchunk) * REC_BYTES);
        for (int i = tid; i < IMG_V4; i += NTHREADS) dst[i] = *(const LDSP u32x4*)(l3 + i * 16);
    } else {
        f32x4 S[8], o[2];
        const float* s0 = A.in[4] + (size_t)(b * GH + h) * 128 * 128;
        const int q = lane >> 4, n = lane & 15;
#pragma unroll
        for (int dt = 0; dt < 8; ++dt)
#pragma unroll
            for (int jj = 0; jj < 4; ++jj) S[dt][jj] = s0[(size_t)(dt * 16 + q * 4 + jj) * 128 + wave * 16 + n];
        const float gnw = A.in[25][wave * 16 + (lane & 15)];
        unsigned zs[8]; gdn_zs_prefetch(A, zs, rowbase, nvalid, h, wave, lane);
        u32x2 uw[2]; { const bf16_t* Uw = (const bf16_t*)(lds + L_ULDS) + (size_t)wave * 512; uw[0] = *(const u32x2*)(Uw + (size_t)lane * 4); uw[1] = *(const u32x2*)(Uw + ((size_t)64 + lane) * 4); }
        gdn_step(l3, uw, S, o, lane);
        gdn_norm_store(A, o, zs, gnw, PART, rowbase, nvalid, h, wave, lane);
        gdn_store_state(A.out + O_SGDN + (size_t)(b * GH + h) * 128 * 128, S, wave, lane);
    }
    lds_barrier();
}

__device__ __forceinline__ void gdn_chain2(const Args& A, unsigned char* lds, int b, int h, int half, int tid) {
    const int wave = tid >> 6, lane = tid & 63, q = lane >> 4, nn = lane & 15;
    const bool act = wave < 4; const int et = half * 4 + (wave & 3);
    const unsigned char* rec = A.ws + WS_REC + (size_t)((b * GH + h) * NCH) * REC_BYTES;
    LDSP unsigned char* l3 = (LDSP unsigned char*)lds; asm volatile("" : "+v"(l3));
    const int e = h * 128 + et * 16 + nn;
    const float gnw = A.in[25][et * 16 + nn];
    bf16_t* ON = (bf16_t*)((unsigned char*)A.out + DO_ON); float* PSS = (float*)(A.ws + WS_SSQ);
    f32x4 S[8], o[2];
#pragma unroll
    for (int dt = 0; dt < 8; ++dt) S[dt] = (f32x4){0.f, 0.f, 0.f, 0.f};
    for (int i = tid; i < IMG_V4; i += NTHREADS) *(LDSP u32x4*)(l3 + LC_BUF0 + i * 16) = ((const u32x4*)rec)[i];
    u32x4 pfa[4], pfb[4]; u32x2 uw[2], uwn[2]; unsigned zs[8], zsn[8];
#define CH_LOADIMG(dst, nn_) do { const u32x4* nx_ = (const u32x4*)(rec + (size_t)(nn_) * REC_BYTES); _Pragma("unroll") for (int k = 0; k < 4; ++k) { const int i = tid + k * NTHREADS; if (i < IMG_V4) dst[k] = nx_[i]; } } while (0)
#define CH_STOREIMG(src, bufoff) do { _Pragma("unroll") for (int k = 0; k < 4; ++k) { const int i = tid + k * NTHREADS; if (i < IMG_V4) *(LDSP u32x4*)(l3 + (bufoff) + i * 16) = src[k]; } } while (0)
#define CH_LOADU(dst, nn_) do { if (act) { const bf16_t* Uw_ = (const bf16_t*)(rec + (size_t)(nn_) * REC_BYTES + REC_U) + (size_t)et * 512; dst[0] = *(const u32x2*)(Uw_ + (size_t)lane * 4); dst[1] = *(const u32x2*)(Uw_ + ((size_t)64 + lane) * 4); } } while (0)
#define CH_ROWBASE(nn_) (b * LP + ((nn_) == 0 ? 0 : NMETA + ((nn_) - 1) * CT))
#define CH_ZS(dst, nn_, nv_) do { if (act) { const bf16_t* ZS_ = (const bf16_t*)(A.ws + WS_ZS); _Pragma("unroll") for (int mt = 0; mt < 2; ++mt) _Pragma("unroll") for (int jj = 0; jj < 4; ++jj) { const int tok = mt * 16 + q * 4 + jj; dst[mt * 4 + jj] = tok < (nv_) ? (unsigned)ZS_[(size_t)(CH_ROWBASE(nn_) + tok) * 512 + e] : 0u; } } } while (0)
#define CH_OUT(zz, nn_, nv_) do { if (act) { _Pragma("unroll") for (int k = 0; k < 8; ++k) asm volatile("" : "+v"(zz[k])); \
        _Pragma("unroll") for (int mt = 0; mt < 2; ++mt) _Pragma("unroll") for (int jj = 0; jj < 4; ++jj) { const int tok = mt * 16 + q * 4 + jj; \
            const float ssq = row16_sum(o[mt][jj] * o[mt][jj]); \
            if (tok < (nv_)) { const size_t row = (size_t)(CH_ROWBASE(nn_) + tok); \
                ON[row * 512 + e] = f2bf(o[mt][jj] * gnw * __builtin_bit_cast(float, zz[mt * 4 + jj] << 16)); \
                if (nn == 0) PSS[row * 32 + h * 8 + et] = ssq; } } } } while (0)
    CH_LOADIMG(pfa, 1); CH_LOADU(uw, 0); CH_ZS(zs, 0, NMETA);
    CH_STOREIMG(pfa, IMG_BYTES);
    lds_barrier();
    CH_LOADIMG(pfa, 2);
    for (int n = 0; n < NCH; n += 2) {
        if (n + 1 < NCH) { CH_LOADU(uwn, n + 1); CH_ZS(zsn, n + 1, CT); }
        if (n + 3 < NCH) CH_LOADIMG(pfb, n + 3);
        if (act) gdn_step(l3 + (n % 3) * IMG_BYTES, uw, S, o, lane);
        CH_OUT(zs, n, (n == 0 ? NMETA : CT));
        if (n + 2 < NCH) CH_STOREIMG(pfa, ((n + 2) % 3) * IMG_BYTES);
        lds_barrier();
        if (n + 1 >= NCH) break;
        if (n + 2 < NCH) { CH_LOADU(uw, n + 2); CH_ZS(zs, n + 2, CT); }
        if (n + 4 < NCH) CH_LOADIMG(pfa, n + 4);
        if (act) gdn_step(l3 + ((n + 1) % 3) * IMG_BYTES, uwn, S, o, lane);
        CH_OUT(zsn, n + 1, CT);
        if (n + 3 < NCH) CH_STOREIMG(pfb, (n % 3) * IMG_BYTES);
        lds_barrier();
    }
#undef CH_LOADIMG
#undef CH_STOREIMG
#undef CH_LOADU
#undef CH_ROWBASE
#undef CH_ZS
#undef CH_OUT
    if (act) gdn_store_state(A.out + O_PGDN + (size_t)(b * GH + h) * 128 * 128, S, et, lane);
}
__device__ __forceinline__ void gdn_finish_rows(const Args& A, int tid, int skip) {
    if ((int)blockIdx.x < skip) return;
    const int wave = tid >> 6, lane = tid & 63, G = gridDim.x - skip;
    bf16_t* ON = (bf16_t*)((unsigned char*)A.out + DO_ON); const float* PSS = (const float*)(A.ws + WS_SSQ);
    for (int r = ((int)blockIdx.x - skip) * 8 + wave; r < TPR; r += G * 8) {
        float ps = (lane < 32) ? PSS[(size_t)r * 32 + lane] : 0.f;
        ps += __shfl_xor(ps, 1); ps += __shfl_xor(ps, 2); ps += __shfl_xor(ps, 4);
        const float tot = __shfl(ps, (lane >> 4) * 8);
        const float rs = rsqrtf(tot * (1.f / 128.f) + EPS);
        u32x4* p = (u32x4*)(ON + (size_t)r * 512 + lane * 8); u32x4 w = *p;
        w.x = pk2(bflo(w.x) * rs, bfhi(w.x) * rs); w.y = pk2(bflo(w.y) * rs, bfhi(w.y) * rs); w.z = pk2(bflo(w.z) * rs, bfhi(w.z) * rs); w.w = pk2(bflo(w.w) * rs, bfhi(w.w) * rs);
        *p = w;
    }
}

template <int CHAIN_PASS> __device__ __forceinline__ void gdn_chain(const Args& A, unsigned char* lds, int b, int h, int tid) {
    const int wave = tid >> 6, lane = tid & 63;
    const unsigned char* rec = A.ws + WS_REC + (size_t)((b * GH + h) * NCH) * REC_BYTES;
    LDSP unsigned char* l3 = (LDSP unsigned char*)lds; asm volatile("" : "+v"(l3));
    LDSP float* PART = (LDSP float*)(l3 + LC_PART);
    const float gnw = A.in[25][wave * 16 + (lane & 15)];
    f32x4 S[8], o[2];
#ifdef CHAIN_HASH
    {
        float hs = 0.f; float* dstp = A.out + O_PGDN + (size_t)(b * GH + h) * 128 * 128;
        for (int n = 0; n < NCH; ++n) { const u32x4* rp = (const u32x4*)(rec + (size_t)n * REC_BYTES);
            for (int i = tid; i < REC_BYTES / 16; i += NTHREADS) {
                const bool used = (i * 16 >= IMG_HDR && i * 16 < IMG_HDR + 16) || (i * 16 >= REC_U) || (i * 16 < IMG_KDT && ((i * 16) % 272) < 256) || (i * 16 >= IMG_KDT && i * 16 < IMG_HDR && (((i * 16) - IMG_KDT) % 80) < 64);
                if (!used) continue;
                const u32x4 w = rp[i];
                if (i * 16 == IMG_HDR) { hs += __builtin_bit_cast(float, w.x); continue; }
                hs += bflo(w.x) + bfhi(w.x) + bflo(w.y) + bfhi(w.y) + bflo(w.z) + bfhi(w.z) + bflo(w.w) + bfhi(w.w); } }
        for (int i = tid; i < 128 * 128; i += NTHREADS) dstp[i] = (i < NTHREADS) ? hs : 0.f;
        return;
    }
#endif
#pragma unroll
    for (int dt = 0; dt < 8; ++dt) S[dt] = (f32x4){0.f, 0.f, 0.f, 0.f};
    for (int i = tid; i < IMG_V4; i += NTHREADS) *(LDSP u32x4*)(l3 + LC_BUF0 + i * 16) = ((const u32x4*)rec)[i];
    __syncthreads();
#ifdef CHAIN_SIMPLE
    for (int n = 0; n < NCH; ++n) {
        if (n > 0) { const u32x4* rp = (const u32x4*)(rec + (size_t)n * REC_BYTES);
            for (int i = tid; i < IMG_V4; i += NTHREADS) *(LDSP u32x4*)(l3 + LC_BUF0 + i * 16) = rp[i];
            __syncthreads(); }
        const int rowbase = b * LP + (n == 0 ? 0 : NMETA + (n - 1) * CT), nvalid = n == 0 ? NMETA : CT;
        unsigned zs[8]; gdn_zs_prefetch(A, zs, rowbase, nvalid, h, wave, lane);
        u32x2 uw[2]; { const bf16_t* Uw = (const bf16_t*)(rec + (size_t)n * REC_BYTES + REC_U) + (size_t)wave * 512; uw[0] = *(const u32x2*)(Uw + (size_t)lane * 4); uw[1] = *(const u32x2*)(Uw + ((size_t)64 + lane) * 4); }
        gdn_step(l3 + LC_BUF0, uw, S, o, lane);
        gdn_norm_store(A, o, zs, gnw, PART, rowbase, nvalid, h, wave, lane);
        __syncthreads();
    }
#else
    u32x4 pfa[4], pfb[4]; u32x2 uw[2], uwn[2]; unsigned zs[8], zsn[8];
#define CH_LOADIMG(dst, nn) do { const u32x4* nx_ = (const u32x4*)(rec + (size_t)(nn) * REC_BYTES); _Pragma("unroll") for (int k = 0; k < 4; ++k) { const int i = tid + k * NTHREADS; if (i < IMG_V4) dst[k] = nx_[i]; } } while (0)
#define CH_STOREIMG(src, bufoff) do { _Pragma("unroll") for (int k = 0; k < 4; ++k) { const int i = tid + k * NTHREADS; if (i < IMG_V4) *(LDSP u32x4*)(l3 + (bufoff) + i * 16) = src[k]; } } while (0)
#define CH_LOADU(dst, nn) do { const bf16_t* Uw_ = (const bf16_t*)(rec + (size_t)(nn) * REC_BYTES + REC_U) + (size_t)wave * 512; dst[0] = *(const u32x2*)(Uw_ + (size_t)lane * 4); dst[1] = *(const u32x2*)(Uw_ + ((size_t)64 + lane) * 4); } while (0)
#define CH_ROWBASE(nn) (b * LP + ((nn) == 0 ? 0 : NMETA + ((nn) - 1) * CT))
    CH_LOADIMG(pfa, 1); CH_LOADU(uw, 0); gdn_zs_prefetch(A, zs, CH_ROWBASE(0), NMETA, h, wave, lane);
    CH_STOREIMG(pfa, LC_BUF1);
    lds_barrier();
    CH_LOADIMG(pfa, 2);
    for (int n = 0; n < NCH; n += 2) {
        if (n + 1 < NCH) { CH_LOADU(uwn, n + 1); gdn_zs_prefetch(A, zsn, CH_ROWBASE(n + 1), CT, h, wave, lane); }
        if (n + 3 < NCH) CH_LOADIMG(pfb, n + 3);
        gdn_step(l3 + LC_BUF0, uw, S, o, lane);
        gdn_norm_store(A, o, zs, gnw, PART, CH_ROWBASE(n), n == 0 ? NMETA : CT, h, wave, lane);
        if (n + 2 < NCH) CH_STOREIMG(pfa, LC_BUF0);
        lds_barrier();
        if (n + 1 >= NCH) break;
        if (n + 2 < NCH) { CH_LOADU(uw, n + 2); gdn_zs_prefetch(A, zs, CH_ROWBASE(n + 2), CT, h, wave, lane); }
        if (n + 4 < NCH) CH_LOADIMG(pfa, n + 4);
        gdn_step(l3 + LC_BUF1, uwn, S, o, lane);
        gdn_norm_store(A, o, zsn, gnw, PART, CH_ROWBASE(n + 1), CT, h, wave, lane);
        if (n + 3 < NCH) CH_STOREIMG(pfb, LC_BUF1);
        lds_barrier();
    }
#undef CH_LOADIMG
#undef CH_STOREIMG
#undef CH_LOADU
#undef CH_ROWBASE
#endif
#ifdef CHAIN_TWICE
    {
        float* scr = (float*)(A.ws + WS_C) + (size_t)(b * GH + h) * 128 * 128;
        if (CHAIN_PASS == 0) gdn_store_state(scr, S, wave, lane);
        else { const int q = lane >> 4, n = lane & 15; int bad = 0;
#pragma unroll
            for (int dt = 0; dt < 8; ++dt)
#pragma unroll
                for (int jj = 0; jj < 4; ++jj) bad |= (scr[(size_t)(dt * 16 + q * 4 + jj) * 128 + wave * 16 + n] != S[dt][jj]) ? 1 : 0;
            float* flagout = A.out + O_PRE + (size_t)(b * GH + h) * 512 + tid;
            if (!bad) *flagout = 0.f; }
    }
#else
#ifndef NO_PGDN
    gdn_store_state(A.out + O_PGDN + (size_t)(b * GH + h) * 128 * 128, S, wave, lane);
#endif
#endif
}

__device__ __forceinline__ void p5b_rows(const Args& A, int tid) {
    const int wave = tid >> 6, lane = tid & 63, G = gridDim.x;
    const bf16_t* MA = (const bf16_t*)(A.ws + WS_MIX); const bf16_t* MB = (const bf16_t*)(A.ws + WS_MIXB); bf16_t* F = (bf16_t*)(A.ws + WS_FB);
    f32x4 g1[4], g2[4];
#pragma unroll
    for (int j = 0; j < 4; ++j) { g1[j] = *(const f32x4*)(A.in[8] + 4 * lane + 256 * j); g2[j] = *(const f32x4*)(A.in[9] + 4 * lane + 256 * j); }
    for (int r0 = blockIdx.x * 8 + wave; r0 < T; r0 += G * 16) {
        int rr[2] = {r0, r0 + G * 8}; const bool has[2] = {true, rr[1] < T}; if (!has[1]) rr[1] = r0;
        u32x2 pa[2][4], pb[2][4]; f32x4 xv[2][4];
#pragma unroll
        for (int k = 0; k < 2; ++k) { const float* xr = x_row_ptr(A, rr[k]);
#pragma unroll
            for (int j = 0; j < 4; ++j) { pa[k][j] = *(const u32x2*)(MA + (size_t)rr[k] * 1024 + 4 * lane + 256 * j); pb[k][j] = *(const u32x2*)(MB + (size_t)rr[k] * 1024 + 4 * lane + 256 * j);
                xv[k][j] = *(const f32x4*)(xr + 4 * lane + 256 * j); } }
#pragma unroll
        for (int k = 0; k < 2; ++k) {
            if (!has[k]) continue;
            const int r = rr[k]; float* yr = y_row_ptr(A, r);
            f32x4 mvv[4]; float ss = 0.f;
#pragma unroll
            for (int j = 0; j < 4; ++j) { const u32x2 a = pa[k][j], b = pb[k][j];
                mvv[j] = (f32x4){bflo(a.x) + bflo(b.x), bfhi(a.x) + bfhi(b.x), bflo(a.y) + bflo(b.y), bfhi(a.y) + bfhi(b.y)};
                ss += (mvv[j][0] * mvv[j][0] + mvv[j][1] * mvv[j][1]) + (mvv[j][2] * mvv[j][2] + mvv[j][3] * mvv[j][3]); }
            const float rs = rsqrtf(wave_sum(ss) * (1.f / 1024.f) + EPS);
            f32x4 v[4]; float s1 = 0.f;
#pragma unroll
            for (int j = 0; j < 4; ++j) { v[j] = xv[k][j] + mvv[j] * rs * g1[j]; s1 += (v[j][0] * v[j][0] + v[j][1] * v[j][1]) + (v[j][2] * v[j][2] + v[j][3] * v[j][3]); }
            const float rs1 = rsqrtf(wave_sum(s1) * (1.f / 1024.f) + EPS);
#pragma unroll
            for (int j = 0; j < 4; ++j) {
                if (yr) *(f32x4*)(yr + 4 * lane + 256 * j) = v[j];
                const f32x4 f = v[j] * rs1 * g2[j]; u32x2 w; w.x = pk2(f[0], f[1]); w.y = pk2(f[2], f[3]); *(u32x2*)(F + (size_t)r * 1024 + 4 * lane + 256 * j) = w;
            }
        }
    }
}
__device__ __forceinline__ void p8_rows(const Args& A, int tid) {
    const int wave = tid >> 6, lane = tid & 63, G = gridDim.x;
    const bf16_t* FA = (const bf16_t*)(A.ws + WS_F2); const bf16_t* FB = (const bf16_t*)(A.ws + WS_F2B);
    f32x4 g1[4];
#pragma unroll
    for (int j = 0; j < 4; ++j) g1[j] = *(const f32x4*)(A.in[10] + 4 * lane + 256 * j);
    for (int r0 = blockIdx.x * 8 + wave; r0 < T; r0 += G * 16) {
        int rr[2] = {r0, r0 + G * 8}; float* yp[2];
        yp[0] = y_row_ptr(A, rr[0]); yp[1] = rr[1] < T ? y_row_ptr(A, rr[1]) : nullptr; if (rr[1] >= T) rr[1] = r0;
        u32x2 pa[2][4], pb[2][4]; f32x4 xv[2][4];
#pragma unroll
        for (int k = 0; k < 2; ++k) { const float* yr = yp[k] ? yp[k] : (yp[0] ? yp[0] : A.out);
#pragma unroll
            for (int j = 0; j < 4; ++j) { pa[k][j] = *(const u32x2*)(FA + (size_t)rr[k] * 1024 + 4 * lane + 256 * j); pb[k][j] = *(const u32x2*)(FB + (size_t)rr[k] * 1024 + 4 * lane + 256 * j);
                xv[k][j] = *(const f32x4*)(yr + 4 * lane + 256 * j); } }
#pragma unroll
        for (int k = 0; k < 2; ++k) {
            float* yr = yp[k]; if (!yr) continue;
            f32x4 f[4]; float ss = 0.f;
#pragma unroll
            for (int j = 0; j < 4; ++j) { const u32x2 a = pa[k][j], b = pb[k][j];
                f[j] = (f32x4){bflo(a.x) + bflo(b.x), bfhi(a.x) + bfhi(b.x), bflo(a.y) + bflo(b.y), bfhi(a.y) + bfhi(b.y)};
                ss += (f[j][0] * f[j][0] + f[j][1] * f[j][1]) + (f[j][2] * f[j][2] + f[j][3] * f[j][3]); }
            const float rs = rsqrtf(wave_sum(ss) * (1.f / 1024.f) + EPS);
#pragma unroll
            for (int j = 0; j < 4; ++j) *(f32x4*)(yr + 4 * lane + 256 * j) = xv[k][j] + f[j] * rs * g1[j];
        }
    }
}

__global__ void __launch_bounds__(NTHREADS, 2) hybrid_fwd(Args A) {
    extern __shared__ __attribute__((aligned(16))) unsigned char lds[];
    cg::grid_group grid = cg::this_grid();
    const int tid = threadIdx.x, wave = __builtin_amdgcn_readfirstlane(tid >> 6), lane = tid & 63, bid = blockIdx.x, G = gridDim.x;
    unsigned char* ws = A.ws;
    PG8_LAS unsigned char* ldsg = (PG8_LAS unsigned char*)lds;
    bf16_t* HN = (bf16_t*)(A.ws + WS_HN); bf16_t* GS = (bf16_t*)((unsigned char*)A.out + DO_GS);
#ifndef PHMASK
#define PHMASK 0x7ff
#endif
#ifndef DUPMASK
#define DUPMASK 0
#endif
#define IN(k) (((PHMASK >> (k)) & 1) && A.ph_lo <= (k) && (k) < A.ph_hi)
#define DUP(k) for (int rep_ = 0; rep_ < 1 + ((DUPMASK >> (k)) & 1); ++rep_)
#define DUPBAR(k) do { if (((DUPMASK >> (k)) & 1) && rep_ == 0) xcd_barrier(xbar); } while (0)
    volatile LAS unsigned* bst = (volatile LAS unsigned*)((LDSP unsigned char*)lds + (LDS_BYTES - 64));
    if (tid < 16) bst[tid] = 0u;
    __syncthreads();
    XcdBarrier xbar = xcd_barrier_post((unsigned*)(ws + WS_BAR), bst);
#define SEAM(k) do { if (IN(k) && IN((k) + 1)) xcd_barrier(xbar); } while (0)
    if (A.ph_lo < 0) grid.sync();
#ifdef L2_THRASH
    {
        const u32x4* src = (const u32x4*)A.in[0] + (size_t)bid * (L2_THRASH * 64); u32x4 accv = {0u, 0u, 0u, 0u};
        for (int i = tid; i < L2_THRASH * 64; i += NTHREADS) { const u32x4 v = src[i]; accv.x ^= v.x; accv.y ^= v.y; accv.z ^= v.z; accv.w ^= v.w; }
        if ((accv.x ^ accv.y ^ accv.z ^ accv.w) == 0x12345679u) ((unsigned*)(ws + WS_BAR))[4000] = 1u;
    }
#endif
#ifdef EXTRA_BARS
    for (int eb_ = 0; eb_ < EXTRA_BARS; ++eb_) xcd_barrier(xbar);
#endif
    if (IN(0)) DUP(0) {
#ifdef ZERO_REC
        { u32x4* zp = (u32x4*)(ws + WS_REC); const size_t nz = (size_t)32 * NCH * REC_BYTES / 16; const u32x4 z4 = {0u, 0u, 0u, 0u};
          for (size_t i = (size_t)bid * NTHREADS + tid; i < nz; i += (size_t)G * NTHREADS) zp[i] = z4; }
#endif
        p0_prologue(A, lds, tid);
        DUPBAR(0);
    }
    SEAM(0);
    if (IN(1)) DUP(1) {
        pg8::StaticOrder so; so.init(TPAD, 2560, G, bid);
        EpiIn e{(bf16_t*)(ws + WS_U), (bf16_t*)(ws + WS_QKV), (bf16_t*)(ws + WS_ZS), A.out};
        pg8::gemm_phase<EpiIn, pg8::StaticOrder, true, true>(ldsg, pg8::Gemm{HN, (const bf16_t*)(ws + WS_W1), TPAD, 2560, 1024}, so, e);
        DUPBAR(1);
    }
    SEAM(1);
    if (IN(2)) DUP(2) {
        for (int u = bid; u < 2880; u += G) {
#ifndef NO_GDNP2
#ifndef P2R_A
#define P2R_A 1
#endif
#ifndef P2R_B
#define P2R_B 1
#endif
#ifndef P2R_C
#define P2R_C 1
#endif
            if (u < 2080) { const int bh = u / NCH, n = u - bh * NCH; for (int rr_ = 0; rr_ < P2R_A; ++rr_) gdn_prep(A, lds, 0, bh >> 2, bh & 3, n, tid); }
            else if (u < 2592) { const int bh = u - 2080; for (int rr_ = 0; rr_ < P2R_B; ++rr_) gdn_prep(A, lds, 1, bh >> 2, bh & 3, 0, tid); }
#endif
#ifndef NO_S5A
            if (u >= 2592 && u < 2848) { const int v = u - 2592, g = v >> 3, b = v & 7; for (int rr_ = 0; rr_ < P2R_C; ++rr_) s5_unit<0>(A, g, b, wave, lane); }
#endif
#ifndef NO_S5D
            if (u >= 2848) { const int v = (u - 2848) * 8 + wave, g = v >> 3, bg = v & 7; s5_decode(A, g, bg, lane); }
#endif
        }
        DUPBAR(2);
    }
    SEAM(2);
    if (IN(3)) DUP(3) {
        const bool chainwg = (G >= 128) && (bid < 64);
        if (G >= 128) { if (chainwg) gdn_chain2(A, lds, bid >> 3, (bid >> 1) & 3, bid & 1, tid); }
        else if (bid < 32) { gdn_chain<0>(A, lds, bid >> 2, bid & 3, tid); }
        for (int u = bid; u < 256; u += G) { const int g = u >> 3, b = u & 7; s5_unit<1>(A, g, b, wave, lane); }
        __syncthreads();
#ifndef NO_GGEMM
        const bool skipg = chainwg;
        pg8::StaticOrder so; if (G >= 128) so.init(TPAD, 2048, G - 64, bid - 64); else so.init(TPAD, 2048, G, bid);
        EpiGates e{(bf16_t*)(ws + WS_SG)};
#ifndef P3R_GG
#define P3R_GG 1
#endif
        if (!skipg) for (int rr_ = 0; rr_ < P3R_GG; ++rr_) pg8::gemm_phase<EpiGates, pg8::StaticOrder, true, true>(ldsg, pg8::Gemm{HN, (const bf16_t*)(ws + WS_W1) + (size_t)2560 * 1024, TPAD, 2048, 1024}, so, e);
#endif
        DUPBAR(3);
    }
    SEAM(3);
    if (IN(4)) DUP(4) {
        pg8::StaticOrder so; so.init(TPAD, 2048, G, bid);
        if (G >= 128) gdn_finish_rows(A, tid, (67 * 8 > 2 * G && 67 * 8 < 3 * G) ? 67 * 8 - 2 * G : 0);
        EpiGlu e{(const bf16_t*)(ws + WS_SG), (bf16_t*)(ws + WS_SA)};
        pg8::gemm_phase<EpiGlu, pg8::StaticOrder, true, true>(ldsg, pg8::Gemm{GS, (const bf16_t*)(ws + WS_WGLU), TPAD, 2048, 512}, so, e);
        DUPBAR(4);
    }
    SEAM(4);
    if (IN(5)) DUP(5) {
        pg8::StaticOrder so; so.init(TPAD, 1024, G, bid);
        EpiGdnOut e{(const bf16_t*)(ws + WS_SG), (const bf16_t*)(ws + WS_SA), (bf16_t*)(ws + WS_MIXIN)};
        pg8::gemm_phase<EpiGdnOut, pg8::StaticOrder, true, true>(ldsg, pg8::Gemm{(const bf16_t*)((unsigned char*)A.out + DO_ON), (const bf16_t*)(ws + WS_WGO), TPAD, 1024, 512}, so, e);
        DUPBAR(5);
    }
    SEAM(5);
    if (IN(6)) DUP(6) {
        pg8::SplitK2Order so; so.init(TPAD, 1024, G, bid);
        EpiBf16Part e{(bf16_t*)(ws + WS_MIX), (bf16_t*)(ws + WS_MIXB)};
        pg8::gemm_phase<EpiBf16Part, pg8::SplitK2Order, true, true>(ldsg, pg8::Gemm{(const bf16_t*)(ws + WS_MIXIN), (const bf16_t*)(ws + WS_WO), TPAD, 1024, 512, 1024}, so, e);
    }
    SEAM(6);
    if (IN(7)) DUP(7) { p5b_rows(A, tid); DUPBAR(7); }
    SEAM(7);
    if (IN(8)) DUP(8) {
        pg8::StaticOrder so; so.init(TPAD, 5632, G, bid);
        EpiFfnUp e{(bf16_t*)(ws + WS_H)};
        pg8::gemm_phase<EpiFfnUp, pg8::StaticOrder, true, true>(ldsg, pg8::Gemm{(const bf16_t*)(ws + WS_FB), (const bf16_t*)(ws + WS_WGU), TPAD, 5632, 1024}, so, e);
        DUPBAR(8);
    }
    SEAM(8);
    if (IN(9)) DUP(9) {
        pg8::SplitK2Order so; so.init(TPAD, 1024, G, bid);
        EpiBf16Part e{(bf16_t*)(ws + WS_F2), (bf16_t*)(ws + WS_F2B)};
        pg8::gemm_phase<EpiBf16Part, pg8::SplitK2Order, true, true>(ldsg, pg8::Gemm{(const bf16_t*)(ws + WS_H), (const bf16_t*)(ws + WS_WD), TPAD, 1024, DFF / 2, DFF}, so, e);
    }
    SEAM(9);
    if (IN(10)) DUP(10) { p8_rows(A, tid); DUPBAR(10); }
#undef IN
#undef SEAM
}

extern "C" void kernel_launch(void* const* d_in, const int* in_sizes, int n_in, void* d_out, int out_size, void* d_ws, size_t ws_size, hipStream_t stream) {
    static int grid = 0;
    if (grid == 0) {
        int dev = 0, cus = 0, per_cu = 0;
        hipGetDevice(&dev);
        hipDeviceGetAttribute(&cus, hipDeviceAttributeMultiprocessorCount, dev);
        hipFuncSetAttribute((const void*)hybrid_fwd, hipFuncAttributeMaxDynamicSharedMemorySize, LDS_BYTES);
        hipOccupancyMaxActiveBlocksPerMultiprocessor(&per_cu, (const void*)hybrid_fwd, NTHREADS, LDS_BYTES);
        (void)hipGetLastError();
        if (per_cu < 1) per_cu = 1;
        grid = cus * per_cu;
        if (n_in != 31 || ws_size < 256 * MiB) fprintf(stderr, "kernel_launch: unexpected n_in %d / ws %zu\n", n_in, ws_size);
    }
    (void)hipMemsetAsync((unsigned char*)d_ws + WS_BAR, 0, 16384, stream);
    Args a{};
    for (int i = 0; i < 31; ++i) a.in[i] = (const float*)d_in[i];
    a.out = (float*)d_out; a.ws = (unsigned char*)d_ws; a.ph_lo = 0; a.ph_hi = 11;
#ifndef REP3
#define REP3 1
#endif
    a.rep3 = REP3; a.pad_ = 0;
    void* args[] = {&a};
    hipError_t e = hipLaunchCooperativeKernel((const void*)hybrid_fwd, dim3(grid), dim3(NTHREADS), args, LDS_BYTES, stream);
    if (e != hipSuccess) fprintf(stderr, "cooperative launch failed: %s (grid %d)\n", hipGetErrorString(e), grid);
}
```

```cpp
#include <hip/hip_runtime.h>
#include <hip/hip_cooperative_groups.h>
#include <cstdio>
#include <cstdint>
namespace cg = cooperative_groups;
namespace pg8 {
#define PG8_LAS __attribute__((address_space(3)))
typedef unsigned short bf16_t;
typedef short bf16x8 __attribute__((ext_vector_type(8)));
typedef float f32x4 __attribute__((ext_vector_type(4)));
typedef unsigned u32x4 __attribute__((ext_vector_type(4)));
constexpr int BM = 256, BK = 64, HALF = 128, HTB = HALF * BK * 2  , STAGE_BYTES = 8 * HTB, NXCD = 8, WGM = 8;

__host__ __device__ __forceinline__ int lds_byte(int r, int c) { const int st = (r >> 4) * 2 + (c >> 5), rr = r & 15, cc = c & 31, ob = rr * 64 + cc * 2; return st * 1024 + (ob ^ (((ob >> 9) & 1) << 5)); }
__host__ __device__ __forceinline__ void stage_rc(int b, int& R, int& C) { const int st = b / 1024, sb = b % 1024, swz = sb ^ (((sb >> 9) & 1) << 5); R = (st >> 1) * 16 + swz / 64; C = (st & 1) * 32 + (swz % 64) / 2; }
__host__ __device__ __forceinline__ int perm32(int rho) { const int n = rho >> 4, i = rho & 15; return 8 * (i >> 2) + 4 * n + (i & 3); }

struct Unit { int pm, pn, ks; };
struct SplitK2Order {
    int nM, nN, nwg, G, c;
    __host__ __device__ void init(int M, int N, int G_, int c_) { nM = M / BM; nN = N / BM; nwg = nM * nN; G = G_; c = c_; }
    __host__ __device__ bool next(int i, Unit& u) const {
        const long L = (long)i * G + c; if (L >= 2L * nwg) return false;
        int wgid = (int)(L >> 1); { const int q = nwg / NXCD, r = nwg % NXCD, xcd = wgid % NXCD, off = wgid / NXCD; wgid = (xcd < r ? xcd * (q + 1) : r * (q + 1) + (xcd - r) * q) + off; }
        const int nig = WGM * nN, gid = wgid / nig, fm = gid * WGM, gsz = (nM - fm) < WGM ? (nM - fm) : WGM;
        u.pm = fm + ((wgid % nig) % gsz); u.pn = (wgid % nig) / gsz; u.ks = (int)(L & 1); return true;
    }
    __device__ __forceinline__ void a_ready(const Unit&) const {}
    __device__ __forceinline__ void done(const Unit&) const {}
};
struct Gemm { const bf16_t* A; const bf16_t* Bt; int M, N, K; int ld; };
struct StaticOrder {
    int nM, nN, nwg, G, c;
    __host__ __device__ void init(int M, int N, int G_, int c_) { nM = M / BM; nN = N / BM; nwg = nM * nN; G = G_; c = c_; }
    __host__ __device__ bool next(int i, Unit& u) const {
        const long L = (long)i * G + c; if (L >= nwg) return false;
        int wgid = (int)L; { const int q = nwg / NXCD, r = nwg % NXCD, xcd = wgid % NXCD, off = wgid / NXCD; wgid = (xcd < r ? xcd * (q + 1) : r * (q + 1) + (xcd - r) * q) + off; }
        const int nig = WGM * nN, gid = wgid / nig, fm = gid * WGM, gsz = (nM - fm) < WGM ? (nM - fm) : WGM;
        u.pm = fm + ((wgid % nig) % gsz); u.pn = (wgid % nig) / gsz; u.ks = 0; return true;
    }
    __device__ __forceinline__ void a_ready(const Unit&) const {}
    __device__ __forceinline__ void done(const Unit&) const {}
};
__device__ __forceinline__ unsigned cvt_pk_bf16(float lo, float hi) { unsigned r; asm volatile("v_cvt_pk_bf16_f32 %0, %1, %2" : "=v"(r) : "v"(lo), "v"(hi)); return r; }
template <class Epi, class Sched, bool ALIGN_EPI = false, bool SP2 = false>
__device__ __forceinline__ void gemm_phase(PG8_LAS unsigned char* lds, const Gemm g, const Sched& S, const Epi& E) {
    const int tid = threadIdx.x, wid = __builtin_amdgcn_readfirstlane(tid >> 6), lane = tid & 63, wr = wid >> 2, wc = wid & 3, fr = lane & 15, fq = lane >> 4;
    const int K = g.K, nt = K / BK, LD = g.ld ? g.ld : g.K;
    unsigned voffA[2], voffB[2];
#pragma unroll
    for (int i = 0; i < 2; ++i) { int R, C; stage_rc(tid * 16 + i * 8192, R, C); const int Rb = Epi::PERM ? ((R & ~31) + perm32(R & 31)) : R;
        voffA[i] = (unsigned)(R * LD + C) * 2u; voffB[i] = (unsigned)(Rb * LD + C) * 2u; }
    const size_t kstep = (size_t)(BK * 2);
    const size_t hstep = (size_t)HALF * LD * 2;
    const size_t tstep = 2 * hstep;
    const unsigned ldsw = (unsigned)wid * 1024u;
    const int aoff = lds_byte(wr * 64 + fr, fq * 8), boff = lds_byte(wc * 32 + fr, fq * 8);
#define PG8_SA(b, h) (((b) * 2 + (h)) * HTB)
#define PG8_SB(b, h) ((4 + (b) * 2 + (h)) * HTB)
#define PG8_STAGE(bufoff, gbase, voff) do { _Pragma("unroll") for (int _i = 0; _i < 2; ++_i) \
        __builtin_amdgcn_global_load_lds((const unsigned*)((const char*)(gbase) + (voff)[_i]), (PG8_LAS unsigned*)(lds + (bufoff) + ldsw + _i * 8192), 16, 0, 0); } while (0)
#define PG8_LDA(dst, b, h) do { _Pragma("unroll") for (int m = 0; m < 4; ++m) _Pragma("unroll") for (int k = 0; k < 2; ++k) dst[m][k] = *(const PG8_LAS bf16x8*)(lds + PG8_SA(b, h) + aoff + m * 2048 + k * 1024); } while (0)
#define PG8_LDB(dst, b, h) do { _Pragma("unroll") for (int n = 0; n < 2; ++n) _Pragma("unroll") for (int k = 0; k < 2; ++k) dst[n][k] = *(const PG8_LAS bf16x8*)(lds + PG8_SB(b, h) + boff + n * 2048 + k * 1024); } while (0)
#define PG8_MMA(ai, bj, At, Bt) do { __builtin_amdgcn_s_setprio(1); _Pragma("unroll") for (int m = 0; m < 4; ++m) _Pragma("unroll") for (int n = 0; n < 2; ++n) _Pragma("unroll") for (int k = 0; k < 2; ++k) \
        acc[ai][bj][m][n] = __builtin_amdgcn_mfma_f32_16x16x32_bf16(Bt[n][k], At[m][k], acc[ai][bj][m][n], 0, 0, 0); __builtin_amdgcn_s_setprio(0); } while (0)
#define PG8_WAIT_V(n) asm volatile("s_waitcnt vmcnt(" #n ")" ::: "memory")
#define PG8_WAIT_L(n) asm volatile("s_waitcnt lgkmcnt(" #n ")" ::: "memory")
#define PG8_BAR __builtin_amdgcn_s_barrier()
#define PG8_SCHED __builtin_amdgcn_sched_barrier(0)
    Unit cur, nxt; int ui = 0;
    if (!S.next(0, cur)) return;
    f32x4 acc[2][2][4][2];
#pragma unroll
    for (int a = 0; a < 2; ++a)
#pragma unroll
        for (int b = 0; b < 2; ++b)
#pragma unroll
            for (int m = 0; m < 4; ++m)
#pragma unroll
                for (int n = 0; n < 2; ++n) acc[a][b][m][n] = (f32x4){0.f, 0.f, 0.f, 0.f};
    bf16x8 At[4][2], B0[2][2], B1[2][2];
    const size_t kslice = (size_t)K * 2;
    const char* cA = (const char*)g.A + (size_t)cur.pm * tstep + (size_t)cur.ks * kslice; const char* cB = (const char*)g.Bt + (size_t)cur.pn * tstep + (size_t)cur.ks * kslice;
    S.a_ready(cur);
    if constexpr (SP2) {
        PG8_STAGE(PG8_SB(0, 0), cB, voffB); PG8_STAGE(PG8_SB(0, 1), cB + hstep, voffB); PG8_STAGE(PG8_SA(0, 0), cA, voffA); PG8_STAGE(PG8_SA(0, 1), cA + hstep, voffA);
        if (wr == 1) PG8_BAR;
        PG8_WAIT_V(2); PG8_BAR;
        PG8_STAGE(PG8_SB(1, 0), cB + kstep, voffB); PG8_STAGE(PG8_SA(1, 0), cA + kstep, voffA); PG8_STAGE(PG8_SB(1, 1), cB + hstep + kstep, voffB);
        PG8_WAIT_V(6); PG8_BAR;
    } else {
        PG8_STAGE(PG8_SB(0, 0), cB, voffB); PG8_STAGE(PG8_SA(0, 0), cA, voffA); PG8_STAGE(PG8_SB(0, 1), cB + hstep, voffB); PG8_STAGE(PG8_SA(0, 1), cA + hstep, voffA);
        if (wr == 1) PG8_BAR;
        PG8_WAIT_V(4); PG8_BAR;
        PG8_STAGE(PG8_SB(1, 0), cB + kstep, voffB); PG8_STAGE(PG8_SA(1, 0), cA + kstep, voffA); PG8_STAGE(PG8_SB(1, 1), cB + hstep + kstep, voffB);
        PG8_WAIT_V(6); PG8_BAR;
    }
    for (;;) {
        const bool has_next = S.next(ui + 1, nxt);
        const char* nA = has_next ? (const char*)g.A + (size_t)nxt.pm * tstep + (size_t)nxt.ks * kslice : cA; const char* nB = has_next ? (const char*)g.Bt + (size_t)nxt.pn * tstep + (size_t)nxt.ks * kslice : cB;
        for (int t = 0; t < nt; t += 2) {
            const bool last = (t == nt - 2);
            const char* a1 = cA + (size_t)(t + 1) * kstep;
            const char* a2 = last ? nA : cA + (size_t)(t + 2) * kstep; const char* b2 = last ? nB : cB + (size_t)(t + 2) * kstep;
            const char* a3 = a2 + kstep; const char* b3 = b2 + kstep;
            if (last && has_next) S.a_ready(nxt);
            if constexpr (SP2) {
            PG8_LDB(B0, 0, 0); PG8_LDB(B1, 0, 1); PG8_SCHED; PG8_LDA(At, 0, 0); PG8_STAGE(PG8_SA(1, 1), a1 + hstep, voffA);
            PG8_WAIT_V(8); PG8_WAIT_L(0); PG8_BAR; PG8_MMA(0, 0, At, B0); PG8_MMA(0, 1, At, B1); PG8_BAR; PG8_SCHED;
            PG8_LDA(At, 0, 1); PG8_STAGE(PG8_SB(0, 0), b2, voffB); PG8_STAGE(PG8_SB(0, 1), b2 + hstep, voffB); PG8_STAGE(PG8_SA(0, 0), a2, voffA);
            PG8_WAIT_V(8); PG8_WAIT_L(0); PG8_BAR; PG8_MMA(1, 0, At, B0); PG8_MMA(1, 1, At, B1); PG8_BAR; PG8_SCHED;
            PG8_LDB(B0, 1, 0); PG8_LDB(B1, 1, 1); PG8_SCHED; PG8_LDA(At, 1, 0); PG8_STAGE(PG8_SA(0, 1), a2 + hstep, voffA);
            PG8_WAIT_V(8); PG8_WAIT_L(0); PG8_BAR; PG8_MMA(0, 0, At, B0); PG8_MMA(0, 1, At, B1); PG8_BAR; PG8_SCHED;
            PG8_LDA(At, 1, 1); PG8_STAGE(PG8_SB(1, 0), b3, voffB); PG8_STAGE(PG8_SB(1, 1), b3 + hstep, voffB); PG8_STAGE(PG8_SA(1, 0), a3, voffA);
            PG8_WAIT_V(8); PG8_WAIT_L(0); PG8_BAR; PG8_MMA(1, 0, At, B0); PG8_MMA(1, 1, At, B1); PG8_BAR; PG8_SCHED;
            } else {
            PG8_LDB(B0, 0, 0); PG8_SCHED; PG8_LDA(At, 0, 0); PG8_STAGE(PG8_SA(1, 1), a1 + hstep, voffA);
            PG8_WAIT_L(8); PG8_BAR; PG8_WAIT_L(0); PG8_MMA(0, 0, At, B0); PG8_BAR; PG8_SCHED;
            PG8_LDB(B1, 0, 1); PG8_STAGE(PG8_SB(0, 0), b2, voffB);
            PG8_BAR; PG8_WAIT_L(0); PG8_MMA(0, 1, At, B1); PG8_BAR;
            PG8_LDA(At, 0, 1); PG8_STAGE(PG8_SA(0, 0), a2, voffA);
            PG8_BAR; PG8_WAIT_L(0); PG8_MMA(1, 0, At, B0); PG8_BAR; PG8_SCHED;
            PG8_STAGE(PG8_SB(0, 1), b2 + hstep, voffB);
            PG8_WAIT_V(6); PG8_BAR; PG8_MMA(1, 1, At, B1); PG8_BAR;
            PG8_LDB(B0, 1, 0); PG8_SCHED; PG8_LDA(At, 1, 0); PG8_STAGE(PG8_SA(0, 1), a2 + hstep, voffA);
            PG8_WAIT_L(8); PG8_BAR; PG8_WAIT_L(0); PG8_MMA(0, 0, At, B0); PG8_BAR; PG8_SCHED;
            PG8_LDB(B1, 1, 1); PG8_STAGE(PG8_SB(1, 0), b3, voffB);
            PG8_BAR; PG8_WAIT_L(0); PG8_MMA(0, 1, At, B1); PG8_BAR;
            PG8_LDA(At, 1, 1); PG8_STAGE(PG8_SA(1, 0), a3, voffA);
            PG8_BAR; PG8_WAIT_L(0); PG8_MMA(1, 0, At, B0); PG8_BAR; PG8_SCHED;
            PG8_STAGE(PG8_SB(1, 1), b3 + hstep, voffB);
            PG8_WAIT_V(6); PG8_BAR; PG8_MMA(1, 1, At, B1); PG8_BAR;
            }
        }
        if constexpr (ALIGN_EPI) { if (wr == 0) PG8_BAR; }
        if constexpr (!Epi::AFTER_DRAIN) { E(acc, cur, wr, wc, fr, fq); S.done(cur); }
        if (!has_next) break;
#pragma unroll
        for (int a = 0; a < 2; ++a)
#pragma unroll
            for (int b = 0; b < 2; ++b)
#pragma unroll
                for (int m = 0; m < 4; ++m)
#pragma unroll
                    for (int n = 0; n < 2; ++n) acc[a][b][m][n] = (f32x4){0.f, 0.f, 0.f, 0.f};
        cur = nxt; cA = nA; cB = nB; ++ui;
        if constexpr (ALIGN_EPI) { if (wr == 1) PG8_BAR; }
    }
    PG8_WAIT_V(0);
    if constexpr (!ALIGN_EPI) { if (wr == 0) PG8_BAR; }
    PG8_BAR;
    if constexpr (Epi::AFTER_DRAIN) { E.fused(acc, cur, wr, wc, fr, fq, lds, wid, lane); S.done(cur); }
#undef PG8_SA
#undef PG8_SB
#undef PG8_STAGE
#undef PG8_LDA
#undef PG8_LDB
#undef PG8_MMA
#undef PG8_WAIT_V
#undef PG8_WAIT_L
#undef PG8_BAR
#undef PG8_SCHED
}
}

using pg8::bf16_t; using pg8::bf16x8; using pg8::f32x4; using pg8::u32x4;
typedef unsigned u32x2 __attribute__((ext_vector_type(2)));
typedef float f32x2 __attribute__((ext_vector_type(2)));
#define LDSP __attribute__((address_space(3)))

constexpr int DM = 1024, NB = 8, SEQ = 2048, NMETA = 16, LP = SEQ + NMETA, DB = 128, DS = 4;
constexpr int TPR = NB * LP;
constexpr int T = TPR + DB * DS;
constexpr int TPAD = 17152;
constexpr int S5W = 512, S5G = 32, S5P = 64;
constexpr int GH = 4, QKVW = 1536, DFF = 2816, INW = 4616;
constexpr float EPS = 1e-6f;
constexpr int NTHREADS = 512;
constexpr int LDS_BYTES = 163840;

constexpr size_t O_YP = 0, O_YS = 16777216, O_PRE = 17301504, O_PIM = 17317888, O_PGDN = 17334272, O_PCONV = 17858560,
                 O_SRE = 17895424, O_SIM = 18157568, O_SGDN = 18419712, O_SCONV = 26808320;
constexpr size_t DO_ON = 0, DO_GS = (size_t)TPAD * 512 * 2;
constexpr size_t MiB = 1u << 20;
constexpr size_t WS_W1 = 0, WS_WGLU = WS_W1 + (size_t)4608 * 1024 * 2, WS_WGO = WS_WGLU + (size_t)2048 * 512 * 2, WS_WO = WS_WGO + (size_t)1024 * 512 * 2,
                 WS_WGU = WS_WO + (size_t)1024 * 1024 * 2, WS_WD = WS_WGU + (size_t)5632 * 1024 * 2, WS_WEND = WS_WD + (size_t)1024 * 2816 * 2;
static_assert(WS_WEND <= 31 * MiB - 512 * 1024, "weights");
constexpr size_t WS_AB = 31 * MiB - 512 * 1024;
constexpr size_t WS_S5A = WS_AB + 640 * 1024;
constexpr size_t WS_S5C = WS_S5A + 262144;
constexpr size_t WS_S5K = WS_S5C + 131072;
constexpr size_t WS_S5ADV = WS_S5K + 1310720;
constexpr size_t WS_S5END = WS_S5ADV + 16384;
constexpr size_t WS_SSQ = WS_S5END + 1048576;
constexpr size_t WS_SSQ2 = WS_SSQ + 1089536;
constexpr size_t WS_BAR = 36 * MiB - 16384;
static_assert(WS_SSQ2 + 1089536 <= WS_BAR, "small region");
constexpr size_t WS_B = 36 * MiB;
constexpr size_t WS_C = 113 * MiB;
constexpr size_t WS_REC = WS_B, WS_SA = WS_B, WS_MIXIN = 70 * MiB, WS_FB = WS_B, WS_F2 = WS_B, WS_F2B = 70 * MiB;
constexpr size_t WS_QKV = WS_C, WS_SG = WS_C, WS_MIX = WS_C, WS_MIXB = WS_C + 34 * MiB, WS_H = WS_C;
constexpr size_t WS_U = 180 * MiB, WS_ZS = 197 * MiB, WS_HN = 214 * MiB;
static_assert(WS_SA + (size_t)T * 1024 * 2 <= WS_MIXIN && WS_MIXIN + (size_t)TPAD * 1024 * 2 <= WS_C, "B");
static_assert(WS_SG + (size_t)T * 2048 * 2 <= WS_U && WS_U + (size_t)T * 512 * 2 <= WS_ZS && WS_ZS + (size_t)T * 512 * 2 <= WS_HN, "C/D");
static_assert(WS_H + (size_t)TPAD * DFF * 2 <= WS_HN && WS_HN + (size_t)TPAD * 1024 * 2 <= 256 * MiB, "H/HN");

constexpr int CT = 32, NCH = 65;
constexpr int IMG_WN = 0, IMG_QD = 8704, IMG_KDT = 17408, IMG_QK = 27648, IMG_HDR = 30208, IMG_BYTES = 30272;
constexpr int REC_U = IMG_BYTES, REC_BYTES = IMG_BYTES + 8192 + 64;
constexpr int IMG_V4 = IMG_BYTES / 16;
static_assert(WS_REC + (size_t)32 * NCH * REC_BYTES <= WS_C, "rec");
constexpr int L_OPK = 0, L_OPKB = 8704, L_OPQ = 17408, L_MX = 30272, L_GC = 34880, L_BETA = 35008, L_EG = 35136, L_EGLK = 35264, L_SSQ = 35392,
              L_ULDS = 36864, L_PART = 45056, L_RED = 46080;
constexpr int LC_BUF0 = 0, LC_BUF1 = IMG_BYTES, LC_PART = 2 * IMG_BYTES;

struct Args { const float* in[31]; float* out; unsigned char* ws; int ph_lo, ph_hi; int rep3, pad_; };

typedef __bf16 bf16x2_t __attribute__((ext_vector_type(2)));
__device__ __forceinline__ unsigned pk2(float lo, float hi) { const f32x2 v = {lo, hi}; return __builtin_bit_cast(unsigned, __builtin_convertvector(v, bf16x2_t)); }
__device__ __forceinline__ unsigned short f2bf(float f) { return (unsigned short)(pk2(f, 0.f) & 0xffffu); }
__device__ __forceinline__ float bf2f(unsigned short b) { return __builtin_bit_cast(float, (unsigned)b << 16); }
__device__ __forceinline__ float bflo(unsigned w) { return __builtin_bit_cast(float, w << 16); }
__device__ __forceinline__ float bfhi(unsigned w) { return __builtin_bit_cast(float, w & 0xffff0000u); }
__device__ __forceinline__ float sigmoidf_(float x) { return 1.0f / (1.0f + __expf(-x)); }
__device__ __forceinline__ float siluf_(float x) { return x / (1.0f + __expf(-x)); }
__device__ __forceinline__ float geluf_(float x) { const float u = 1.5957691216057308f * (x + 0.044715f * x * x * x); return x / (1.0f + __expf(-u)); }
template <int CTRL> __device__ __forceinline__ float dpp0(float v) {
    return __builtin_bit_cast(float, __builtin_amdgcn_update_dpp(0, __builtin_bit_cast(int, v), CTRL, 0xF, 0xF, true));
}
__device__ __forceinline__ float row16_sum(float v) {
    v += dpp0<0xB1>(v); v += dpp0<0x4E>(v); v += dpp0<0x141>(v); v += dpp0<0x140>(v); return v;
}
__device__ __forceinline__ float wave_sum(float v) { v = row16_sum(v); v += __shfl_xor(v, 16); v += __shfl_xor(v, 32); return v; }
__device__ __forceinline__ bf16x8 pack8(const f32x4& a, const f32x4& b) {
    u32x4 w; w.x = pk2(a[0], a[1]); w.y = pk2(a[2], a[3]); w.z = pk2(b[0], b[1]); w.w = pk2(b[2], b[3]); return __builtin_bit_cast(bf16x8, w);
}
__device__ __forceinline__ int pos32(int d) { return (d >> 5) * 32 + ((d >> 2) & 3) * 8 + ((d >> 4) & 1) * 4 + (d & 3); }
__device__ __forceinline__ f32x4 mfma16(const bf16x8& a, const bf16x8& b, const f32x4& c) { return __builtin_amdgcn_mfma_f32_16x16x32_bf16(a, b, c, 0, 0, 0); }

__device__ __forceinline__ void lds_barrier() { asm volatile("s_waitcnt lgkmcnt(0)" ::: "memory"); __builtin_amdgcn_s_barrier(); asm volatile("" ::: "memory"); }
__device__ __forceinline__ const float* x_row_ptr(const Args& A, int r) {
    if (r < TPR) { const int b = r / LP, t = r - b * LP; return t < NMETA ? A.in[6] + (size_t)t * DM : A.in[0] + ((size_t)b * SEQ + (t - NMETA)) * DM; }
    return A.in[1] + (size_t)(r - TPR) * DM;
}
__device__ __forceinline__ float* y_row_ptr(const Args& A, int r) {
    if (r < TPR) { const int b = r / LP, t = r - b * LP; return t < NMETA ? nullptr : A.out + O_YP + ((size_t)b * SEQ + (t - NMETA)) * DM; }
    return A.out + O_YS + (size_t)(r - TPR) * DM;
}

#define EPI_LOOP4 _Pragma("unroll") for (int ai = 0; ai < 2; ++ai) _Pragma("unroll") for (int m = 0; m < 4; ++m)
struct EpiIn {
    static constexpr bool PERM = false, AFTER_DRAIN = false;
    bf16_t* U; bf16_t* QKV; bf16_t* ZS; float* out;
    __device__ __forceinline__ void operator()(const f32x4 (&acc)[2][2][4][2], const pg8::Unit& u, int wr, int wc, int fr, int fq) const {
        const int pn = u.pn;
        EPI_LOOP4 {
            const int r = u.pm * 256 + ai * 128 + wr * 64 + m * 16 + fr;
            if (r >= T) continue;
            float* cdst = nullptr;
            if (pn >= 2 && pn < 8) {
                if (r < TPR) { const int b = r / LP, t = r - b * LP; if (t >= LP - 3) cdst = out + O_PCONV + ((size_t)b * 3 + (t - (LP - 3))) * QKVW; }
                else { const int rr = r - TPR, b = rr >> 2, t = rr & 3; if (t >= 1) cdst = out + O_SCONV + ((size_t)b * 3 + (t - 1)) * QKVW; }
            }
#pragma unroll
            for (int bj = 0; bj < 2; ++bj)
#pragma unroll
                for (int n = 0; n < 2; ++n) {
                    const int c = pn * 256 + bj * 128 + wc * 32 + n * 16 + fq * 4; const f32x4 v = acc[ai][bj][m][n];
                    if (pn < 2) { u32x2 w; w.x = pk2(v[0], v[1]); w.y = pk2(v[2], v[3]); *(u32x2*)(U + (size_t)r * 512 + c) = w; }
                    else if (pn < 8) { u32x2 w; w.x = pk2(v[0], v[1]); w.y = pk2(v[2], v[3]); *(u32x2*)(QKV + (size_t)r * QKVW + (c - 512)) = w;
                        if (cdst) *(f32x4*)(cdst + (c - 512)) = v; }
                    else { u32x2 w; w.x = pk2(siluf_(v[0]), siluf_(v[1])); w.y = pk2(siluf_(v[2]), siluf_(v[3])); *(u32x2*)(ZS + (size_t)r * 512 + (c - 2048)) = w; }
                }
        }
    }
};
struct EpiGates {
    static constexpr bool PERM = false, AFTER_DRAIN = false;
    bf16_t* SG;
    __device__ __forceinline__ void operator()(const f32x4 (&acc)[2][2][4][2], const pg8::Unit& u, int wr, int wc, int fr, int fq) const {
        EPI_LOOP4 {
            const int r = u.pm * 256 + ai * 128 + wr * 64 + m * 16 + fr;
            if (r >= T) continue;
#pragma unroll
            for (int bj = 0; bj < 2; ++bj)
#pragma unroll
                for (int n = 0; n < 2; ++n) {
                    const int c = u.pn * 256 + bj * 128 + wc * 32 + n * 16 + fq * 4; const f32x4 v = acc[ai][bj][m][n];
                    u32x2 w; w.x = pk2(sigmoidf_(v[0]), sigmoidf_(v[1])); w.y = pk2(sigmoidf_(v[2]), sigmoidf_(v[3])); *(u32x2*)(SG + (size_t)r * 2048 + c) = w;
                }
        }
    }
};
struct EpiGlu {
    static constexpr bool PERM = false, AFTER_DRAIN = false;
    const bf16_t* SG; bf16_t* SA;
    __device__ __forceinline__ void operator()(const f32x4 (&acc)[2][2][4][2], const pg8::Unit& u, int wr, int wc, int fr, int fq) const {
        EPI_LOOP4 {
            const int r = u.pm * 256 + ai * 128 + wr * 64 + m * 16 + fr;
            if (r >= T) continue;
#pragma unroll
            for (int n = 0; n < 2; ++n) {
                const int c = u.pn * 128 + wc * 32 + n * 16 + fq * 4; const f32x4 a = acc[ai][0][m][n], b = acc[ai][1][m][n];
                const u32x2 g = *(const u32x2*)(SG + (size_t)r * 2048 + c);
                u32x2 w; w.x = pk2(bflo(g.x) * a[0] * sigmoidf_(b[0]), bfhi(g.x) * a[1] * sigmoidf_(b[1]));
                w.y = pk2(bflo(g.y) * a[2] * sigmoidf_(b[2]), bfhi(g.y) * a[3] * sigmoidf_(b[3]));
                *(u32x2*)(SA + (size_t)r * 1024 + c) = w;
            }
        }
    }
};
struct EpiGdnOut {
    static constexpr bool PERM = false, AFTER_DRAIN = false;
    const bf16_t* SG; const bf16_t* SA; bf16_t* MIXIN;
    __device__ __forceinline__ void operator()(const f32x4 (&acc)[2][2][4][2], const pg8::Unit& u, int wr, int wc, int fr, int fq) const {
        EPI_LOOP4 {
            const int r = u.pm * 256 + ai * 128 + wr * 64 + m * 16 + fr;
            if (r >= T) continue;
#pragma unroll
            for (int bj = 0; bj < 2; ++bj)
#pragma unroll
                for (int n = 0; n < 2; ++n) {
                    const int c = u.pn * 256 + bj * 128 + wc * 32 + n * 16 + fq * 4; const f32x4 v = acc[ai][bj][m][n];
                    const u32x2 g = *(const u32x2*)(SG + (size_t)r * 2048 + 1024 + c); const u32x2 s = *(const u32x2*)(SA + (size_t)r * 1024 + c);
                    u32x2 w; w.x = pk2(bflo(s.x) + bflo(g.x) * v[0], bfhi(s.x) + bfhi(g.x) * v[1]); w.y = pk2(bflo(s.y) + bflo(g.y) * v[2], bfhi(s.y) + bfhi(g.y) * v[3]);
                    *(u32x2*)(MIXIN + (size_t)r * 1024 + c) = w;
                }
        }
    }
};
struct EpiF32Ssq {
    static constexpr bool PERM = false, AFTER_DRAIN = false;
    float* O; float* SSQ;
    __device__ __forceinline__ void operator()(const f32x4 (&acc)[2][2][4][2], const pg8::Unit& u, int wr, int wc, int fr, int fq) const {
        EPI_LOOP4 {
            const int r = u.pm * 256 + ai * 128 + wr * 64 + m * 16 + fr;
            float ss = 0.f;
#pragma unroll
            for (int bj = 0; bj < 2; ++bj)
#pragma unroll
                for (int n = 0; n < 2; ++n) {
                    const int c = u.pn * 256 + bj * 128 + wc * 32 + n * 16 + fq * 4; const f32x4 v = acc[ai][bj][m][n];
                    ss += (v[0] * v[0] + v[1] * v[1]) + (v[2] * v[2] + v[3] * v[3]);
                    if (r < T) *(f32x4*)(O + (size_t)r * 1024 + c) = v;
                }
            ss += __shfl_xor(ss, 16); ss += __shfl_xor(ss, 32);
            if (fq == 0 && r < T) SSQ[((size_t)u.pn * T + r) * 4 + wc] = ss;
        }
    }
};
struct EpiBf16Part {
    static constexpr bool PERM = false, AFTER_DRAIN = false;
    bf16_t* O0; bf16_t* O1;
    __device__ __forceinline__ void operator()(const f32x4 (&acc)[2][2][4][2], const pg8::Unit& u, int wr, int wc, int fr, int fq) const {
        bf16_t* O = u.ks ? O1 : O0;
        EPI_LOOP4 {
            const int r = u.pm * 256 + ai * 128 + wr * 64 + m * 16 + fr;
            if (r >= T) continue;
#pragma unroll
            for (int bj = 0; bj < 2; ++bj)
#pragma unroll
                for (int n = 0; n < 2; ++n) {
                    const int c = u.pn * 256 + bj * 128 + wc * 32 + n * 16 + fq * 4; const f32x4 v = acc[ai][bj][m][n];
                    u32x2 w; w.x = pk2(v[0], v[1]); w.y = pk2(v[2], v[3]); *(u32x2*)(O + (size_t)r * 1024 + c) = w;
                }
        }
    }
};
struct EpiFfnUp {
    static constexpr bool PERM = false, AFTER_DRAIN = false;
    bf16_t* H;
    __device__ __forceinline__ void operator()(const f32x4 (&acc)[2][2][4][2], const pg8::Unit& u, int wr, int wc, int fr, int fq) const {
        EPI_LOOP4 {
            const int r = u.pm * 256 + ai * 128 + wr * 64 + m * 16 + fr;
            if (r >= T) continue;
#pragma unroll
            for (int n = 0; n < 2; ++n) {
                const int c = u.pn * 128 + wc * 32 + n * 16 + fq * 4; const f32x4 g = acc[ai][0][m][n], v = acc[ai][1][m][n];
                u32x2 w; w.x = pk2(siluf_(g[0]) * v[0], siluf_(g[1]) * v[1]); w.y = pk2(siluf_(g[2]) * v[2], siluf_(g[3]) * v[3]);
                *(u32x2*)(H + (size_t)r * DFF + c) = w;
            }
        }
    }
};
#define LAS __attribute__((address_space(3)))
#define XB_TMO      128
#define XB_XCNT(j)  (256  + 64 * (j))
#define XB_XSUB(j)  (1280 + 64 * (j))
#define XB_XGEN(j)  (2304 + 64 * (j))
#define XB_TOP      3328
#define XB_TOPGEN   3392
#define XCD_BAR_WORDS 3456
#define XB_SPIN_CAP (1u << 18)

__device__ __forceinline__ unsigned xb_ld(unsigned* p)              { return __hip_atomic_load(p, __ATOMIC_RELAXED, __HIP_MEMORY_SCOPE_AGENT); }
__device__ __forceinline__ unsigned xb_add(unsigned* p, unsigned v) { return __hip_atomic_fetch_add(p, v, __ATOMIC_RELAXED, __HIP_MEMORY_SCOPE_AGENT); }
__device__ __forceinline__ unsigned xb_xcc_id() { return (unsigned)__builtin_amdgcn_s_getreg((3 << 11) | 20) & 0xFu; }
#define XB_SPIN(cond, bar) do { unsigned _sp = 0; while (cond) { __builtin_amdgcn_s_sleep(1); \
    if ((++_sp & 255u) == 0u) { if (xb_ld(&(bar)[XB_TMO])) break; if (_sp > XB_SPIN_CAP) { atomicAdd(&(bar)[XB_TMO], 1u); break; } } } } while (0)

struct XcdBarrier {
    unsigned* bar; unsigned x;
    volatile LAS unsigned* st;
};

__device__ __forceinline__ XcdBarrier xcd_barrier_post(unsigned* bar, volatile LAS unsigned* st) {
    XcdBarrier b; b.bar = bar; b.x = xb_xcc_id(); b.st = st;
    if (threadIdx.x == 0) (void)xb_add(&bar[XB_XCNT(b.x)], 1u);
    return b;
}
__device__ __forceinline__ void xcd_barrier_complete(unsigned* bar, unsigned x, unsigned& nloc, unsigned& nx) {
    const unsigned G = gridDim.x * gridDim.y * gridDim.z;
    unsigned sum, cnt, mine, sp = 0u;
    for (;;) {
        sum = 0u; cnt = 0u; mine = 0u;
#pragma unroll
        for (unsigned j = 0; j < 16; ++j) { const unsigned c = xb_ld(&bar[XB_XCNT(j)]); sum += c; cnt += (c > 0u) ? 1u : 0u; mine = (j == x) ? c : mine; }
        if (sum == G) break;
        __builtin_amdgcn_s_sleep(1);
        if ((++sp & 255u) == 0u) { if (xb_ld(&bar[XB_TMO])) break; if (sp > XB_SPIN_CAP) { atomicAdd(&bar[XB_TMO], 1u); break; } }
    }
    nloc = mine > 0u ? mine : 1u; nx = cnt > 0u ? cnt : 1u;
}

__device__ __forceinline__ void xcd_barrier(const XcdBarrier& b) {
    asm volatile("s_waitcnt vmcnt(0)" ::: "memory");
    __syncthreads();
    if (threadIdx.x == 0) {
        unsigned* bar = b.bar;
        __builtin_amdgcn_s_waitcnt(0);
        unsigned nloc = b.st[0], nx = b.st[1];
        if (nloc == 0u) { xcd_barrier_complete(bar, b.x, nloc, nx); b.st[0] = nloc; b.st[1] = nx; }
        const unsigned old = xb_add(&bar[XB_XSUB(b.x)], 1u);
        const unsigned gen = old / nloc;
        if (old + 1u == (gen + 1u) * nloc) {
            __builtin_amdgcn_fence(__ATOMIC_RELEASE, "agent");
            asm volatile("s_waitcnt vmcnt(0)" ::: "memory");
            const unsigned og = xb_add(&bar[XB_TOP], 1u);
            const unsigned tg = og / nx;
            if (og + 1u == (tg + 1u) * nx) xb_add(&bar[XB_TOPGEN], 1u);
            else XB_SPIN(xb_ld(&bar[XB_TOPGEN]) == tg, bar);
            __builtin_amdgcn_fence(__ATOMIC_ACQUIRE, "agent");
            xb_add(&bar[XB_XGEN(b.x)], 1u);
            asm volatile("s_waitcnt vmcnt(0)" ::: "memory");
        } else {
            XB_SPIN(xb_ld(&bar[XB_XGEN(b.x)]) == gen, bar);
            __builtin_amdgcn_fence(__ATOMIC_ACQUIRE, "agent");
            asm volatile("s_waitcnt vmcnt(0)" ::: "memory");
        }
    }
    __syncthreads();
}

__device__ __forceinline__ void transpose_item(const float* src, int ld, int col0, int k0, bf16_t* dst, int K, int drow0, float* tile, int tid) {
    {
        const int k = tid >> 3, n8 = (tid & 7) * 8;
        const f32x4 a = *(const f32x4*)(src + (size_t)(k0 + k) * ld + col0 + n8), b = *(const f32x4*)(src + (size_t)(k0 + k) * ld + col0 + n8 + 4);
        float* tp = tile + k * 65 + n8;
        tp[0] = a[0]; tp[1] = a[1]; tp[2] = a[2]; tp[3] = a[3]; tp[4] = b[0]; tp[5] = b[1]; tp[6] = b[2]; tp[7] = b[3];
    }
    __syncthreads();
    {
        const int n = tid >> 3, k8 = (tid & 7) * 8; const float* tp = tile + k8 * 65 + n;
        u32x4 w; w.x = pk2(tp[0], tp[65]); w.y = pk2(tp[130], tp[195]); w.z = pk2(tp[260], tp[325]); w.w = pk2(tp[390], tp[455]);
        *(u32x4*)(dst + (size_t)(drow0 + n) * K + k0 + k8) = w;
    }
    __syncthreads();
}

__device__ __forceinline__ void cpow_(float lr, float li, float dt, int k, float& re, float& im) {
    const float mag = expf((float)k * lr * dt);
    double rev = (double)k * (double)li * (double)dt * 0.15915494309189535; rev -= rint(rev);
    const float rf = (float)rev;
    re = mag * __builtin_amdgcn_cosf(rf); im = mag * __builtin_amdgcn_sinf(rf);
}

__device__ __forceinline__ void p0_transposes(const Args& A, unsigned char* lds, int tid, int it_lo, int it_hi, int blk0, int nblk) {
    unsigned char* ws = A.ws;
    const int bid = (int)blockIdx.x - blk0; if (bid < 0 || bid >= nblk) return;
    const int G = nblk;
    float* tile = (float*)lds;
    constexpr int I1 = 72 * 16, I2 = 32 * 8, I3 = 16 * 8, I4 = 16 * 16, I5 = 88 * 16;
    struct TI { const float* src; int ld, col0, k0; bf16_t* dst; int K, drow0; };
    auto item = [&](int it) -> TI {
        int r = it;
        if (r < I1) { const int nb = r >> 4, kb = r & 15, n0 = nb * 64; return TI{A.in[11], INW, n0 < 2560 ? n0 : n0 + 8, kb * 64, (bf16_t*)(ws + WS_W1), 1024, n0}; } r -= I1;
        if (r < I2) { const int nb = r >> 3, kb = r & 7, n0 = nb * 64, pn = n0 >> 8, j = n0 & 255; return TI{j < 128 ? A.in[20] : A.in[21], 1024, pn * 128 + (j & 127), kb * 64, (bf16_t*)(ws + WS_WGLU), 512, n0}; } r -= I2;
        if (r < I3) { const int nb = r >> 3, kb = r & 7; return TI{A.in[26], 1024, nb * 64, kb * 64, (bf16_t*)(ws + WS_WGO), 512, nb * 64}; } r -= I3;
        if (r < I4) { const int nb = r >> 4, kb = r & 15; return TI{A.in[27], 1024, nb * 64, kb * 64, (bf16_t*)(ws + WS_WO), 1024, nb * 64}; } r -= I4;
        if (r < I5) { const int nb = r >> 4, kb = r & 15, n0 = nb * 64, pn = n0 >> 8, j = n0 & 255; return TI{j < 128 ? A.in[28] : A.in[29], DFF, pn * 128 + (j & 127), kb * 64, (bf16_t*)(ws + WS_WGU), 1024, n0}; } r -= I5;
        const int nb = r / 44, kb = r - nb * 44; return TI{A.in[30], 1024, nb * 64, kb * 64, (bf16_t*)(ws + WS_WD), DFF, nb * 64};
    };
    float* tile2 = (float*)(lds + 65536);
    for (int it = it_lo + bid; it < it_hi; it += 2 * G) {
        const bool two = it + G < it_hi;
        const TI t0 = item(it), t1 = item(two ? it + G : it);
        {
            const int k = tid >> 3, n8 = (tid & 7) * 8;
            const f32x4 a0 = *(const f32x4*)(t0.src + (size_t)(t0.k0 + k) * t0.ld + t0.col0 + n8), b0 = *(const f32x4*)(t0.src + (size_t)(t0.k0 + k) * t0.ld + t0.col0 + n8 + 4);
            const f32x4 a1 = *(const f32x4*)(t1.src + (size_t)(t1.k0 + k) * t1.ld + t1.col0 + n8), b1 = *(const f32x4*)(t1.src + (size_t)(t1.k0 + k) * t1.ld + t1.col0 + n8 + 4);
            float* tp = tile + k * 65 + n8; tp[0] = a0[0]; tp[1] = a0[1]; tp[2] = a0[2]; tp[3] = a0[3]; tp[4] = b0[0]; tp[5] = b0[1]; tp[6] = b0[2]; tp[7] = b0[3];
            float* tq = tile2 + k * 65 + n8; tq[0] = a1[0]; tq[1] = a1[1]; tq[2] = a1[2]; tq[3] = a1[3]; tq[4] = b1[0]; tq[5] = b1[1]; tq[6] = b1[2]; tq[7] = b1[3];
        }
        __syncthreads();
        {
            const int n = tid >> 3, k8 = (tid & 7) * 8; const float* tp = tile + k8 * 65 + n; const float* tq = tile2 + k8 * 65 + n;
            u32x4 w; w.x = pk2(tp[0], tp[65]); w.y = pk2(tp[130], tp[195]); w.z = pk2(tp[260], tp[325]); w.w = pk2(tp[390], tp[455]);
            *(u32x4*)(t0.dst + (size_t)(t0.drow0 + n) * t0.K + t0.k0 + k8) = w;
            if (two) { u32x4 v; v.x = pk2(tq[0], tq[65]); v.y = pk2(tq[130], tq[195]); v.z = pk2(tq[260], tq[325]); v.w = pk2(tq[390], tq[455]);
                *(u32x4*)(t1.dst + (size_t)(t1.drow0 + n) * t1.K + t1.k0 + k8) = v; }
        }
        __syncthreads();
    }
}
constexpr int TR_I1 = 72 * 16, TR_ITOT = 72 * 16 + 32 * 8 + 16 * 8 + 16 * 16 + 88 * 16 + 16 * 44;

__device__ __forceinline__ void p0_prologue(const Args& A, unsigned char* lds, int tid, int tr_hi) {
    unsigned char* ws = A.ws;
    const int G = gridDim.x, bid = blockIdx.x;
    float* wab = (float*)(lds + 20480);
    p0_transposes(A, lds, tid, 0, tr_hi, 0, G);
    {
        const int gt = bid * NTHREADS + tid, NT = G * NTHREADS;
        const float* Are = A.in[12]; const float* Aim = A.in[13]; const float* Bre = A.in[14]; const float* Bim = A.in[15];
        const float* Cre = A.in[16]; const float* Cim = A.in[17]; const float* ldt = A.in[18];
        for (int e = gt; e < 32 * 8 * 64; e += NT) {
            const int g = e >> 9, tile_ = (e >> 6) & 7, lane = e & 63, q = lane >> 4, r = lane & 15;
            const float dt = expf(ldt[g]);
            {
                const int pp = tile_ * 16 + r, st = pp >> 1, part = pp & 1;
                const float lr = Are[g * 64 + st], li = Aim[g * 64 + st];
                float ar, ai; cpow_(lr, li, dt, 1, ar, ai);
                const float nr = ar - 1.f, ni = ai, den = 1.f / (lr * lr + li * li);
                const float cr = (nr * lr + ni * li) * den, ci = (ni * lr - nr * li) * den;
                float v[8];
#pragma unroll
                for (int j = 0; j < 8; ++j) {
                    if (q < 2) { const int c = q * 8 + j; const float br = Bre[(g * 64 + st) * 16 + c], bi = Bim[(g * 64 + st) * 16 + c];
                        v[j] = part == 0 ? (cr * br - ci * bi) : (cr * bi + ci * br); } else v[j] = 0.f;
                }
                u32x4 w; w.x = pk2(v[0], v[1]); w.y = pk2(v[2], v[3]); w.z = pk2(v[4], v[5]); w.w = pk2(v[6], v[7]);
                *(u32x4*)(ws + WS_S5A + (size_t)e * 16) = w;
            }
            {
                float* kd = (float*)(ws + WS_S5K) + (size_t)e * 20;
#pragma unroll
                for (int s = 0; s < 2; ++s) {
                    const int st = tile_ * 8 + q * 2 + s; const float lr = Are[g * 64 + st], li = Aim[g * 64 + st];
                    float re, im;
                    cpow_(lr, li, dt, -r, re, im); kd[s * 6 + 0] = re; kd[s * 6 + 1] = im;
                    cpow_(lr, li, dt, r, re, im); kd[s * 6 + 2] = re; kd[s * 6 + 3] = im;
                    cpow_(lr, li, dt, r + 1, re, im); kd[s * 6 + 4] = re; kd[s * 6 + 5] = im;
                }
            }
            if (r == 0) {
                f32x4 o;
                { const int st = tile_ * 8 + q * 2; float re, im; cpow_(Are[g * 64 + st], Aim[g * 64 + st], dt, 256, re, im); o[0] = re; o[1] = im; }
                { const int st = tile_ * 8 + q * 2 + 1; float re, im; cpow_(Are[g * 64 + st], Aim[g * 64 + st], dt, 256, re, im); o[2] = re; o[3] = im; }
                *(f32x4*)(ws + WS_S5ADV + (size_t)((g * 8 + tile_) * 4 + q) * 16) = o;
            }
            if (tile_ < 4) {
                const int pair = tile_; float v[8];
#pragma unroll
                for (int jj = 0; jj < 8; ++jj) { const int pp = (2 * pair + (jj >> 2)) * 16 + q * 4 + (jj & 3), st = pp >> 1;
                    v[jj] = (pp & 1) ? -Cim[(g * 16 + r) * 64 + st] : Cre[(g * 16 + r) * 64 + st]; }
                u32x4 w; w.x = pk2(v[0], v[1]); w.y = pk2(v[2], v[3]); w.z = pk2(v[4], v[5]); w.w = pk2(v[6], v[7]);
                *(u32x4*)(ws + WS_S5C + (size_t)((g * 4 + pair) * 64 + lane) * 16) = w;
            }
        }
    }
    {
        for (int idx = tid; idx < 8192; idx += NTHREADS) { const int k = idx >> 3, o = idx & 7; wab[o * 1024 + k] = A.in[11][(size_t)k * INW + 2560 + o]; }
        __syncthreads();
        const int wave = tid >> 6, lane = tid & 63;
        bf16_t* HN = (bf16_t*)(A.ws + WS_HN); float* AB = (float*)(ws + WS_AB);
        const float* gw = A.in[7];
        f32x4 gv[4];
#pragma unroll
        for (int j = 0; j < 4; ++j) gv[j] = *(const f32x4*)(gw + 4 * lane + 256 * j);
        for (int r = bid * 8 + wave; r < T; r += G * 8) {
            const float* xr = x_row_ptr(A, r);
            f32x4 v[4]; float s = 0.f;
#pragma unroll
            for (int j = 0; j < 4; ++j) { v[j] = *(const f32x4*)(xr + 4 * lane + 256 * j); s += (v[j][0] * v[j][0] + v[j][1] * v[j][1]) + (v[j][2] * v[j][2] + v[j][3] * v[j][3]); }
            const float rs = rsqrtf(wave_sum(s) * (1.f / 1024.f) + EPS);
#pragma unroll
            for (int j = 0; j < 4; ++j) { v[j] = v[j] * rs * gv[j]; u32x2 w; w.x = pk2(v[j][0], v[j][1]); w.y = pk2(v[j][2], v[j][3]); *(u32x2*)(HN + (size_t)r * 1024 + 4 * lane + 256 * j) = w; }
            float ab[8];
#pragma unroll
            for (int o = 0; o < 8; ++o) { float d = 0.f;
#pragma unroll
                for (int j = 0; j < 4; ++j) { const f32x4 w4 = *(const f32x4*)(wab + o * 1024 + 4 * lane + 256 * j); d += (v[j][0] * w4[0] + v[j][1] * w4[1]) + (v[j][2] * w4[2] + v[j][3] * w4[3]); }
                ab[o] = wave_sum(d); }
            if (lane == 0) { *(f32x4*)(AB + (size_t)r * 8) = (f32x4){ab[0], ab[1], ab[2], ab[3]}; *(f32x4*)(AB + (size_t)r * 8 + 4) = (f32x4){ab[4], ab[5], ab[6], ab[7]}; }
        }
        __syncthreads();
    }
}

__device__ __forceinline__ void s5_scan_tile(f32x4& h, const f32x4& k0, const f32x4& k1, const f32x4& k2, const f32x4&, const f32x4&) {
    const float n0r = k0[0], n0i = k0[1], t0r = k0[2], t0i = k0[3], n1r = k1[2], n1i = k1[3], t1r = k2[0], t1i = k2[1];
    float g0 = n0r * h[0] - n0i * h[1], g1 = n0r * h[1] + n0i * h[0], g2 = n1r * h[2] - n1i * h[3], g3 = n1r * h[3] + n1i * h[2];
#define S5_PFX(CTRL) { g0 += dpp0<CTRL>(g0); g1 += dpp0<CTRL>(g1); g2 += dpp0<CTRL>(g2); g3 += dpp0<CTRL>(g3); }
    S5_PFX(0x111) S5_PFX(0x112) S5_PFX(0x114) S5_PFX(0x118)
#undef S5_PFX
    h[0] = t0r * g0 - t0i * g1; h[1] = t0r * g1 + t0i * g0; h[2] = t1r * g2 - t1i * g3; h[3] = t1r * g3 + t1i * g2;
}
__device__ __forceinline__ void s5_add_carry(f32x4& h, const f32x4& cr, const f32x4& k1, const f32x4& k2) {
    const float p0r = k1[0], p0i = k1[1], p1r = k2[2], p1i = k2[3];
    h[0] += p0r * cr[0] - p0i * cr[1]; h[1] += p0r * cr[1] + p0i * cr[0];
    h[2] += p1r * cr[2] - p1i * cr[3]; h[3] += p1r * cr[3] + p1i * cr[2];
}

template <int MODE> __device__ __forceinline__ void s5_unit(const Args& A, int g, int b, int run, int lane) {
    unsigned char* ws = A.ws;
    asm volatile("" : "+v"(lane));
    const int q = lane >> 4, t = lane & 15;
    const bf16_t* U = (const bf16_t*)(ws + WS_U);
    bf16_t* GS = (bf16_t*)((unsigned char*)A.out + DO_GS);
    constexpr int NSMAX = (MODE == 2) ? 16 : 17;
    constexpr int NV = (MODE == 2) ? 4 : 16;
    int nsub, row0, rstride;
    if (MODE == 2) { nsub = 16; row0 = TPR + b * 16 * DS; rstride = DS; }
    else { const int sc0 = run == 0 ? 0 : 17 + (run - 1) * 16; nsub = run == 0 ? 17 : 16; row0 = b * LP + sc0 * 16; rstride = 16; }
    f32x4 Y[NSMAX];
#pragma unroll
    for (int sc = 0; sc < NSMAX; ++sc) Y[sc] = (f32x4){0.f, 0.f, 0.f, 0.f};
    const bool uvalid = (q < 2) && (t < NV);
    for (int pair = 0; pair < 4; ++pair) {
        const int t0 = 2 * pair, t1 = 2 * pair + 1;
        const f32x4* kp0 = (const f32x4*)(ws + WS_S5K) + ((size_t)(g * 8 + t0) * 64 + lane) * 5;
        const f32x4* kp1 = (const f32x4*)(ws + WS_S5K) + ((size_t)(g * 8 + t1) * 64 + lane) * 5;
        const f32x4 ka0 = kp0[0], ka1 = kp0[1], ka2 = kp0[2], ka3 = ka0, ka4 = ka0;
        const f32x4 kb0 = kp1[0], kb1 = kp1[1], kb2 = kp1[2], kb3 = kb0, kb4 = kb0;
        const bf16x8 A0 = *(const bf16x8*)(ws + WS_S5A + ((size_t)(g * 8 + t0) * 64 + lane) * 16);
        const bf16x8 A1 = *(const bf16x8*)(ws + WS_S5A + ((size_t)(g * 8 + t1) * 64 + lane) * 16);
        const bf16x8 Cop = *(const bf16x8*)(ws + WS_S5C + ((size_t)(g * 4 + pair) * 64 + lane) * 16);
        f32x4 c0 = (f32x4){0.f, 0.f, 0.f, 0.f}, c1 = c0;
        const bf16_t* up = U + (size_t)(row0 + t) * 512 + g * 16 + q * 8;
        const bf16x8 bzero = (bf16x8){0, 0, 0, 0, 0, 0, 0, 0};
        bf16x8 bq[NSMAX + 2];
        bq[0] = uvalid ? *(const bf16x8*)up : bzero; up += rstride * 512; asm volatile("" : "+v"(up));
        bq[1] = (uvalid && 1 < nsub) ? *(const bf16x8*)up : bzero; up += rstride * 512; asm volatile("" : "+v"(up));
        if (MODE == 1) {
            const f32x4 ad0 = *(const f32x4*)(ws + WS_S5ADV + (size_t)((g * 8 + t0) * 4 + q) * 16), ad1 = *(const f32x4*)(ws + WS_S5ADV + (size_t)((g * 8 + t1) * 4 + q) * 16);
            const float* endp = (const float*)(ws + WS_S5END) + ((size_t)(b * 32 + g) * 8) * 128;
            for (int rp = 0; rp < run; ++rp) {
                const f32x4 e0 = *(const f32x4*)(endp + rp * 128 + t0 * 16 + q * 4), e1 = *(const f32x4*)(endp + rp * 128 + t1 * 16 + q * 4);
                f32x4 n0, n1;
                n0[0] = ad0[0] * c0[0] - ad0[1] * c0[1] + e0[0]; n0[1] = ad0[0] * c0[1] + ad0[1] * c0[0] + e0[1];
                n0[2] = ad0[2] * c0[2] - ad0[3] * c0[3] + e0[2]; n0[3] = ad0[2] * c0[3] + ad0[3] * c0[2] + e0[3];
                n1[0] = ad1[0] * c1[0] - ad1[1] * c1[1] + e1[0]; n1[1] = ad1[0] * c1[1] + ad1[1] * c1[0] + e1[1];
                n1[2] = ad1[2] * c1[2] - ad1[3] * c1[3] + e1[2]; n1[3] = ad1[2] * c1[3] + ad1[3] * c1[2] + e1[3];
                c0 = n0; c1 = n1;
            }
        }
#pragma unroll
        for (int sc = 0; sc < NSMAX; ++sc) {
            if (sc < nsub) {
                if (sc + 2 < NSMAX) { bq[sc + 2] = (uvalid && sc + 2 < nsub) ? *(const bf16x8*)up : bzero; up += rstride * 512; asm volatile("" : "+v"(up)); }
                const bf16x8 Bop = bq[sc];
                const f32x4 z = (f32x4){0.f, 0.f, 0.f, 0.f};
                f32x4 h0 = mfma16(A0, Bop, z), h1 = mfma16(A1, Bop, z);
                s5_scan_tile(h0, ka0, ka1, ka2, ka3, ka4);
                s5_scan_tile(h1, kb0, kb1, kb2, kb3, kb4);
                if (MODE == 2) {
                    const int bb = b * 16 + sc; const float* sre = A.in[2] + ((size_t)bb * 32 + g) * 64; const float* sim = A.in[3] + ((size_t)bb * 32 + g) * 64;
                    const int s0 = t0 * 8 + q * 2, s1 = t1 * 8 + q * 2;
                    c0 = (f32x4){sre[s0], sim[s0], sre[s0 + 1], sim[s0 + 1]}; c1 = (f32x4){sre[s1], sim[s1], sre[s1 + 1], sim[s1 + 1]};
                }
                s5_add_carry(h0, c0, ka1, ka2); s5_add_carry(h1, c1, kb1, kb2);
                const int src = (lane & 48) | (NV - 1);
#pragma unroll
                for (int k = 0; k < 4; ++k) { c0[k] = __shfl(h0[k], src); c1[k] = __shfl(h1[k], src); }
                if (MODE == 2) {
                    if (t == NV - 1) { const int bb = b * 16 + sc; float* ore = A.out + O_SRE + ((size_t)bb * 32 + g) * 64; float* oim = A.out + O_SIM + ((size_t)bb * 32 + g) * 64;
                        const int s0 = t0 * 8 + q * 2, s1 = t1 * 8 + q * 2;
                        ore[s0] = h0[0]; oim[s0] = h0[1]; ore[s0 + 1] = h0[2]; oim[s0 + 1] = h0[3];
                        ore[s1] = h1[0]; oim[s1] = h1[1]; ore[s1 + 1] = h1[2]; oim[s1 + 1] = h1[3]; }
                }
                if (MODE != 0) Y[sc] = mfma16(Cop, pack8(h0, h1), Y[sc]);
                asm volatile("" ::: "memory");
            }
        }
        if (MODE == 0) {
            if (t == 15) { float* endp = (float*)(ws + WS_S5END) + ((size_t)((b * 32 + g) * 8 + run)) * 128;
                *(f32x4*)(endp + t0 * 16 + q * 4) = c0; *(f32x4*)(endp + t1 * 16 + q * 4) = c1; }
        }
        if (MODE == 1) {
            if (run == 7 && t == 15) { float* ore = A.out + O_PRE + ((size_t)b * 32 + g) * 64; float* oim = A.out + O_PIM + ((size_t)b * 32 + g) * 64;
                const int s0 = t0 * 8 + q * 2, s1 = t1 * 8 + q * 2;
                ore[s0] = c0[0]; oim[s0] = c0[1]; ore[s0 + 1] = c0[2]; oim[s0 + 1] = c0[3];
                ore[s1] = c1[0]; oim[s1] = c1[1]; ore[s1 + 1] = c1[2]; oim[s1 + 1] = c1[3]; }
        }
    }
    if (MODE != 0) {
        const f32x4 Dv = *(const f32x4*)(A.in[19] + g * 16 + q * 4);
        size_t eoff = (size_t)(row0 + t) * 512 + g * 16 + q * 4;
#pragma unroll
        for (int sc = 0; sc < NSMAX; ++sc) {
            if (sc < nsub && t < NV) {
                const u32x2 uu = *(const u32x2*)(U + eoff);
                const float y0 = Y[sc][0] + Dv[0] * bflo(uu.x), y1 = Y[sc][1] + Dv[1] * bfhi(uu.x), y2 = Y[sc][2] + Dv[2] * bflo(uu.y), y3 = Y[sc][3] + Dv[3] * bfhi(uu.y);
                u32x2 w; w.x = pk2(geluf_(y0), geluf_(y1)); w.y = pk2(geluf_(y2), geluf_(y3));
                *(u32x2*)(GS + eoff) = w;
            }
            eoff += rstride * 512; asm volatile("" : "+v"(eoff));
        }
    }
}

__device__ __forceinline__ void s5_decode(const Args& A, int g, int bg, int lane) {
    unsigned char* ws = A.ws;
    asm volatile("" : "+v"(lane));
    const int q = lane >> 4, t = lane & 15;
    const bf16_t* U = (const bf16_t*)(ws + WS_U);
    bf16_t* GS = (bf16_t*)((unsigned char*)A.out + DO_GS);
    const bool uvalid = (q < 2) && (t < DS);
    const f32x4 Dv = *(const f32x4*)(A.in[19] + g * 16 + q * 4);
#pragma unroll 1
    for (int sc = 0; sc < 16; ++sc) {
        const int bb = bg * 16 + sc, row = TPR + bb * DS + t;
        bf16x8 Bop = (bf16x8){0, 0, 0, 0, 0, 0, 0, 0};
        if (uvalid) Bop = *(const bf16x8*)(U + (size_t)row * 512 + g * 16 + q * 8);
        const float* sre = A.in[2] + ((size_t)bb * 32 + g) * 64; const float* sim = A.in[3] + ((size_t)bb * 32 + g) * 64;
        float* ore = A.out + O_SRE + ((size_t)bb * 32 + g) * 64; float* oim = A.out + O_SIM + ((size_t)bb * 32 + g) * 64;
        f32x4 Y = (f32x4){0.f, 0.f, 0.f, 0.f};
#pragma unroll 1
        for (int pair = 0; pair < 4; ++pair) {
            const int t0 = 2 * pair, t1 = 2 * pair + 1;
            const f32x4* kp0 = (const f32x4*)(ws + WS_S5K) + ((size_t)(g * 8 + t0) * 64 + lane) * 5;
            const f32x4* kp1 = (const f32x4*)(ws + WS_S5K) + ((size_t)(g * 8 + t1) * 64 + lane) * 5;
            const f32x4 ka0 = kp0[0], ka1 = kp0[1], ka2 = kp0[2], ka3 = ka0, ka4 = ka0;
            const f32x4 kb0 = kp1[0], kb1 = kp1[1], kb2 = kp1[2], kb3 = kb0, kb4 = kb0;
            const bf16x8 A0 = *(const bf16x8*)(ws + WS_S5A + ((size_t)(g * 8 + t0) * 64 + lane) * 16);
            const bf16x8 A1 = *(const bf16x8*)(ws + WS_S5A + ((size_t)(g * 8 + t1) * 64 + lane) * 16);
            const bf16x8 Cop = *(const bf16x8*)(ws + WS_S5C + ((size_t)(g * 4 + pair) * 64 + lane) * 16);
            const f32x4 z = (f32x4){0.f, 0.f, 0.f, 0.f};
            f32x4 h0 = mfma16(A0, Bop, z), h1 = mfma16(A1, Bop, z);
            s5_scan_tile(h0, ka0, ka1, ka2, ka3, ka4);
            s5_scan_tile(h1, kb0, kb1, kb2, kb3, kb4);
            const int s0 = t0 * 8 + q * 2, s1 = t1 * 8 + q * 2;
            const f32x4 c0 = (f32x4){sre[s0], sim[s0], sre[s0 + 1], sim[s0 + 1]}, c1 = (f32x4){sre[s1], sim[s1], sre[s1 + 1], sim[s1 + 1]};
            s5_add_carry(h0, c0, ka1, ka2); s5_add_carry(h1, c1, kb1, kb2);
            if (t == DS - 1) { ore[s0] = h0[0]; oim[s0] = h0[1]; ore[s0 + 1] = h0[2]; oim[s0 + 1] = h0[3];
                               ore[s1] = h1[0]; oim[s1] = h1[1]; ore[s1 + 1] = h1[2]; oim[s1 + 1] = h1[3]; }
            Y = mfma16(Cop, pack8(h0, h1), Y);
        }
        if (t < DS) {
            const u32x2 uu = *(const u32x2*)(U + (size_t)row * 512 + g * 16 + q * 4);
            const float y0 = Y[0] + Dv[0] * bflo(uu.x), y1 = Y[1] + Dv[1] * bfhi(uu.x), y2 = Y[2] + Dv[2] * bflo(uu.y), y3 = Y[3] + Dv[3] * bfhi(uu.y);
            u32x2 w; w.x = pk2(geluf_(y0), geluf_(y1)); w.y = pk2(geluf_(y2), geluf_(y3));
            *(u32x2*)(GS + (size_t)row * 512 + g * 16 + q * 4) = w;
        }
    }
}

__device__ __forceinline__ void gdn_step(const LDSP unsigned char* img, const u32x2 (&uw)[2], f32x4 (&S)[8], f32x4 (&o)[2], int lane) {
    const int q = lane >> 4, r = lane & 15;
    bf16x8 Sop[4];
#pragma unroll
    for (int i = 0; i < 4; ++i) Sop[i] = pack8(S[2 * i], S[2 * i + 1]);
    bf16x8 aw[2][4];
#pragma unroll
    for (int mt = 0; mt < 2; ++mt)
#pragma unroll
        for (int i = 0; i < 4; ++i) aw[mt][i] = *(const LDSP bf16x8*)(img + IMG_WN + (mt * 16 + r) * 272 + i * 64 + q * 16);
    bf16x8 aq[2][5];
#pragma unroll
    for (int mt = 0; mt < 2; ++mt) {
#pragma unroll
        for (int i = 0; i < 4; ++i) aq[mt][i] = *(const LDSP bf16x8*)(img + IMG_QD + (mt * 16 + r) * 272 + i * 64 + q * 16);
        aq[mt][4] = *(const LDSP bf16x8*)(img + IMG_QK + (mt * 16 + r) * 80 + q * 16);
    }
    f32x4 vn[2];
#pragma unroll
    for (int mt = 0; mt < 2; ++mt) vn[mt] = (f32x4){bflo(uw[mt].x), bfhi(uw[mt].x), bflo(uw[mt].y), bfhi(uw[mt].y)};
#pragma unroll
    for (int i = 0; i < 4; ++i)
#pragma unroll
        for (int mt = 0; mt < 2; ++mt) vn[mt] = mfma16(aw[mt][i], Sop[i], vn[mt]);
    bf16x8 ak[8];
#pragma unroll
    for (int dt = 0; dt < 8; ++dt) ak[dt] = *(const LDSP bf16x8*)(img + IMG_KDT + (dt * 16 + r) * 80 + q * 16);
    const float egl = *(const LDSP float*)(img + IMG_HDR);
#pragma unroll
    for (int mt = 0; mt < 2; ++mt) o[mt] = (f32x4){0.f, 0.f, 0.f, 0.f};
#pragma unroll
    for (int i = 0; i < 4; ++i)
#pragma unroll
        for (int mt = 0; mt < 2; ++mt) o[mt] = mfma16(aq[mt][i], Sop[i], o[mt]);
    const bf16x8 Vop = pack8(vn[0], vn[1]);
#pragma unroll
    for (int mt = 0; mt < 2; ++mt) o[mt] = mfma16(aq[mt][4], Vop, o[mt]);
#pragma unroll
    for (int dt = 0; dt < 8; ++dt) S[dt] = mfma16(ak[dt], Vop, S[dt] * egl);
}
__device__ __forceinline__ void gdn_zs_prefetch(const Args& A, unsigned (&zs)[8], int rowbase, int nvalid, int h, int wave, int lane) {
    const int q = lane >> 4, n = lane & 15; const bf16_t* ZS = (const bf16_t*)(A.ws + WS_ZS); const int e = h * 128 + wave * 16 + n;
#pragma unroll
    for (int mt = 0; mt < 2; ++mt)
#pragma unroll
        for (int jj = 0; jj < 4; ++jj) { const int tok = mt * 16 + q * 4 + jj; zs[mt * 4 + jj] = tok < nvalid ? (unsigned)ZS[(size_t)(rowbase + tok) * 512 + e] : 0u; }
}
__device__ __forceinline__ void gdn_norm_store(const Args& A, const f32x4 (&o)[2], unsigned (&zs)[8], float gn, LDSP float* part, int rowbase, int nvalid, int h, int wave, int lane) {
    const int q = lane >> 4, n = lane & 15;
#pragma unroll
    for (int mt = 0; mt < 2; ++mt)
#pragma unroll
        for (int jj = 0; jj < 4; ++jj) { const float s = row16_sum(o[mt][jj] * o[mt][jj]); if (n == 0) part[wave * 32 + mt * 16 + q * 4 + jj] = s; }
    lds_barrier();
#pragma unroll
    for (int k = 0; k < 8; ++k) asm volatile("" : "+v"(zs[k]));
    bf16_t* ON = (bf16_t*)((unsigned char*)A.out + DO_ON);
    const int e = h * 128 + wave * 16 + n;
#pragma unroll
    for (int mt = 0; mt < 2; ++mt)
#pragma unroll
        for (int jj = 0; jj < 4; ++jj) {
            const int tok = mt * 16 + q * 4 + jj;
            if (tok < nvalid) {
                float tot = 0.f;
#pragma unroll
                for (int w = 0; w < 8; ++w) tot += part[w * 32 + tok];
                const float rs = rsqrtf(tot * (1.f / 128.f) + EPS);
                const size_t row = (size_t)(rowbase + tok);
#ifndef NO_ONSTORE
                ON[row * 512 + e] = f2bf(o[mt][jj] * rs * gn * __builtin_bit_cast(float, zs[mt * 4 + jj] << 16));
#endif
            }
        }
}
__device__ __forceinline__ void gdn_store_state(float* dst, const f32x4 (&S)[8], int wave, int lane) {
    const int q = lane >> 4, n = lane & 15;
#pragma unroll
    for (int dt = 0; dt < 8; ++dt)
#pragma unroll
        for (int jj = 0; jj < 4; ++jj) {
#ifdef SANITIZE
            float v = S[dt][jj]; if (!(fabsf(v) < 1e30f)) v = 12345.f; dst[(size_t)(dt * 16 + q * 4 + jj) * 128 + wave * 16 + n] = v;
#else
            dst[(size_t)(dt * 16 + q * 4 + jj) * 128 + wave * 16 + n] = S[dt][jj];
#endif
        }
}

__device__ __forceinline__ void gdn_prep(const Args& A, unsigned char* lds, int kind, int b, int h, int nchunk, int tid) {
    unsigned char* ws = A.ws;
    asm volatile("" : "+v"(tid));
    const int wave = tid >> 6, lane = tid & 63, grp = tid >> 7, cc = tid & 127;
    int rowbase, nvalid; bool hist_rows;
    if (kind == 0) { const int t0 = nchunk == 0 ? 0 : NMETA + (nchunk - 1) * CT; nvalid = nchunk == 0 ? NMETA : CT; rowbase = b * LP + t0; hist_rows = nchunk > 0; }
    else { nvalid = DS; rowbase = TPR + b * DS; hist_rows = false; }
    LDSP unsigned char* l3 = (LDSP unsigned char*)lds; asm volatile("" : "+v"(l3));
    LDSP float* MX = (LDSP float*)(l3 + L_MX); LDSP float* GC = (LDSP float*)(l3 + L_GC); LDSP float* BETA = (LDSP float*)(l3 + L_BETA); LDSP float* EG = (LDSP float*)(l3 + L_EG);
    LDSP float* EGLK = (LDSP float*)(l3 + L_EGLK); LDSP float* SSQ = (LDSP float*)(l3 + L_SSQ); LDSP float* PART = (LDSP float*)(l3 + L_PART);
    float x[CT];
    if (grp < 3) {
        const int colq = (grp == 0 ? 1024 : grp == 1 ? 512 : 0) + h * 128 + cc;
        const float* cw = A.in[22];
        const float w0 = cw[colq], w1 = cw[QKVW + colq], w2 = cw[2 * QKVW + colq], w3 = cw[3 * QKVW + colq];
        const bf16_t* QKV = (const bf16_t*)(ws + WS_QKV);
        float p0 = 0.f, p1 = 0.f, p2 = 0.f;
        if (kind == 1) { const float* sc = A.in[5] + (size_t)b * 3 * QKVW + colq; p0 = sc[0]; p1 = sc[QKVW]; p2 = sc[2 * QKVW]; }
        else if (hist_rows) { p0 = bf2f(QKV[(size_t)(rowbase - 3) * QKVW + colq]); p1 = bf2f(QKV[(size_t)(rowbase - 2) * QKVW + colq]); p2 = bf2f(QKV[(size_t)(rowbase - 1) * QKVW + colq]); }
#pragma unroll
        for (int i = 0; i < CT; ++i) {
            float cur = 0.f, v = 0.f;
            if (i < nvalid) { cur = bf2f(QKV[(size_t)(rowbase + i) * QKVW + colq]); const float y = w0 * p0 + w1 * p1 + w2 * p2 + w3 * cur; v = siluf_(y); }
            x[i] = v; p0 = p1; p1 = p2; p2 = cur;
        }
        if (grp >= 1) {
            LDSP float* red = (LDSP float*)(l3 + L_RED) + (wave - 2) * (CT * 68);
#pragma unroll
            for (int i = 0; i < CT; ++i) red[i * 68 + lane] = x[i] * x[i];
            asm volatile("s_waitcnt lgkmcnt(0)" ::: "memory");
            if (lane < CT) {
                f32x4 acc4 = (f32x4){0.f, 0.f, 0.f, 0.f};
#pragma unroll
                for (int c4 = 0; c4 < 16; ++c4) acc4 += *(const LDSP f32x4*)(red + lane * 68 + c4 * 4);
                SSQ[(wave - 2) * CT + lane] = (acc4[0] + acc4[1]) + (acc4[2] + acc4[3]);
            }
        }
    } else if (wave == 7) {
        float gval = 0.f, beta = 0.f;
        if (lane < nvalid) {
            const float* ab = (const float*)(ws + WS_AB) + (size_t)(rowbase + lane) * 8;
            const float a = ab[h] + A.in[24][h];
            const float sp = a > 20.f ? a : log1pf(expf(a));
            gval = -expf(A.in[23][h]) * sp;
            beta = 1.0f / (1.0f + expf(-ab[4 + h]));
        }
        float gc = gval;
#pragma unroll
        for (int off = 1; off < 64; off <<= 1) { const float v = __shfl_up(gc, off); if (lane >= off) gc += v; }
        const float gl = __shfl(gc, 63);
        if (lane < CT) { GC[lane] = gc; BETA[lane] = beta; EG[lane] = expf(gc); EGLK[lane] = expf(gl - gc); }
        if (lane == 0) *(LDSP float*)(l3 + IMG_HDR) = expf(gl);
    }
    lds_barrier();
    if (grp == 1 || grp == 2) {
        const int g0 = (grp - 1) * 2; const float sc = grp == 2 ? 0.08838834764831845f : 1.0f;
        LDSP bf16_t* op0 = (LDSP bf16_t*)(l3 + (grp == 1 ? L_OPK : L_OPQ)); LDSP bf16_t* opkb = (LDSP bf16_t*)(l3 + L_OPKB);
#pragma unroll
        for (int i = 0; i < CT; ++i) {
            const float inv = rsqrtf(SSQ[g0 * CT + i] + SSQ[(g0 + 1) * CT + i] + EPS) * sc;
            x[i] *= inv;
            op0[i * 136 + cc] = f2bf(x[i]);
            if (grp == 1) opkb[i * 136 + cc] = f2bf(x[i] * BETA[i]);
        }
    }
    lds_barrier();
    if (wave < 4) {
        const int q = lane >> 4, r = lane & 15, mt = wave >> 1, nt = wave & 1;
        f32x4 am = (f32x4){0.f, 0.f, 0.f, 0.f}, aq = am;
        if (nt <= mt) {
#pragma unroll
            for (int ks = 0; ks < 4; ++ks) {
                const bf16x8 bk = *(const LDSP bf16x8*)(l3 + L_OPK + (nt * 16 + r) * 272 + ks * 64 + q * 16);
                const bf16x8 akb = *(const LDSP bf16x8*)(l3 + L_OPKB + (mt * 16 + r) * 272 + ks * 64 + q * 16);
                const bf16x8 aqn = *(const LDSP bf16x8*)(l3 + L_OPQ + (mt * 16 + r) * 272 + ks * 64 + q * 16);
                am = mfma16(akb, bk, am); aq = mfma16(aqn, bk, aq);
            }
        }
        const int j = nt * 16 + r; const float gj = GC[j];
        LDSP bf16_t* qk = (LDSP bf16_t*)(l3 + IMG_QK);
#pragma unroll
        for (int jj = 0; jj < 4; ++jj) {
            const int i = mt * 16 + q * 4 + jj;
            const float dec = (i >= j) ? __expf(GC[i] - gj) : 0.f;
            MX[i * 36 + j] = (i > j) ? am[jj] * dec : 0.f;
            qk[i * 40 + pos32(j)] = f2bf(aq[jj] * dec);
        }
    }
    lds_barrier();
    if (grp == 1) {
        LDSP bf16_t* kdt = (LDSP bf16_t*)(l3 + IMG_KDT);
#pragma unroll
        for (int i = 0; i < CT; ++i) { kdt[cc * 40 + pos32(i)] = f2bf(x[i] * EGLK[i]); x[i] *= BETA[i] * EG[i]; }
    } else if (grp == 2) {
        LDSP bf16_t* qd = (LDSP bf16_t*)(l3 + IMG_QD); const int pc = pos32(cc);
#pragma unroll
        for (int i = 0; i < CT; ++i) qd[i * 136 + pc] = f2bf(x[i] * EG[i]);
    } else if (grp == 0) {
#pragma unroll
        for (int i = 0; i < CT; ++i) x[i] *= BETA[i];
    }
    if (grp < 2) {
#pragma unroll
        for (int i = 1; i < CT; ++i) {
            float s = x[i];
#pragma unroll
            for (int j4 = 0; j4 < (i + 3) / 4; ++j4) {
                const f32x4 mv = *(const LDSP f32x4*)(MX + i * 36 + j4 * 4);
                if (j4 * 4 + 0 < i) s -= mv[0] * x[j4 * 4 + 0];
                if (j4 * 4 + 1 < i) s -= mv[1] * x[j4 * 4 + 1];
                if (j4 * 4 + 2 < i) s -= mv[2] * x[j4 * 4 + 2];
                if (j4 * 4 + 3 < i) s -= mv[3] * x[j4 * 4 + 3];
            }
            x[i] = s;
            if ((i & 1) == 1) asm volatile("" ::: "memory");
        }
    }
    if (grp == 1) {
        LDSP bf16_t* wn = (LDSP bf16_t*)(l3 + IMG_WN); const int pc = pos32(cc);
#pragma unroll
        for (int i = 0; i < CT; ++i) wn[i * 136 + pc] = f2bf(-x[i]);
    } else if (grp == 0) {
        unsigned char* ub = (kind == 0) ? (ws + WS_REC + (size_t)((b * GH + h) * NCH + nchunk) * REC_BYTES + REC_U) : (lds + L_ULDS);
        const int et = cc >> 4, n = cc & 15;
#pragma unroll
        for (int mt = 0; mt < 2; ++mt)
#pragma unroll
            for (int qq = 0; qq < 4; ++qq) {
                u32x2 w; w.x = pk2(x[mt * 16 + qq * 4 + 0], x[mt * 16 + qq * 4 + 1]); w.y = pk2(x[mt * 16 + qq * 4 + 2], x[mt * 16 + qq * 4 + 3]);
                *(u32x2*)(ub + ((size_t)((et * 2 + mt) * 64 + qq * 16 + n)) * 8) = w;
            }
    }
    lds_barrier();
    if (kind == 0) {
        u32x4* dst = (u32x4*)(ws + WS_REC + (size_t)((b * GH + h) * NCH + nchunk) * REC_BYTES);
        for (int i = tid; i < IMG_V4; i += NTHREADS) dst[i] = *(const LDSP u32x4*)(l3 + i * 16);
    } else {
        f32x4 S[8], o[2];
        const float* s0 = A.in[4] + (size_t)(b * GH + h) * 128 * 128;
        const int q = lane >> 4, n = lane & 15;
#pragma unroll
        for (int dt = 0; dt < 8; ++dt)
#pragma unroll
            for (int jj = 0; jj < 4; ++jj) S[dt][jj] = s0[(size_t)(dt * 16 + q * 4 + jj) * 128 + wave * 16 + n];
        const float gnw = A.in[25][wave * 16 + (lane & 15)];
        unsigned zs[8]; gdn_zs_prefetch(A, zs, rowbase, nvalid, h, wave, lane);
        u32x2 uw[2]; { const bf16_t* Uw = (const bf16_t*)(lds + L_ULDS) + (size_t)wave * 512; uw[0] = *(const u32x2*)(Uw + (size_t)lane * 4); uw[1] = *(const u32x2*)(Uw + ((size_t)64 + lane) * 4); }
        gdn_step(l3, uw, S, o, lane);
        gdn_norm_store(A, o, zs, gnw, PART, rowbase, nvalid, h, wave, lane);
        gdn_store_state(A.out + O_SGDN + (size_t)(b * GH + h) * 128 * 128, S, wave, lane);
    }
    lds_barrier();
}

__device__ __forceinline__ void gdn_chain2(const Args& A, unsigned char* lds, int b, int h, int half, int tid) {
    const int wave = tid >> 6, lane = tid & 63, q = lane >> 4, nn = lane & 15;
    const bool act = wave < 4; const int et = half * 4 + (wave & 3);
    const unsigned char* rec = A.ws + WS_REC + (size_t)((b * GH + h) * NCH) * REC_BYTES;
    LDSP unsigned char* l3 = (LDSP unsigned char*)lds; asm volatile("" : "+v"(l3));
    const int e = h * 128 + et * 16 + nn;
    const float gnw = A.in[25][et * 16 + nn];
    bf16_t* ON = (bf16_t*)((unsigned char*)A.out + DO_ON); float* PSS = (float*)(A.ws + WS_SSQ);
    f32x4 S[8], o[2];
#pragma unroll
    for (int dt = 0; dt < 8; ++dt) S[dt] = (f32x4){0.f, 0.f, 0.f, 0.f};
    for (int i = tid; i < IMG_V4; i += NTHREADS) *(LDSP u32x4*)(l3 + LC_BUF0 + i * 16) = ((const u32x4*)rec)[i];
    u32x4 pfa[4], pfb[4]; u32x2 uw[2], uwn[2]; unsigned zs[8], zsn[8];
#define CH_LOADIMG(dst, nn_) do { const u32x4* nx_ = (const u32x4*)(rec + (size_t)(nn_) * REC_BYTES); _Pragma("unroll") for (int k = 0; k < 4; ++k) { const int i = tid + k * NTHREADS; if (i < IMG_V4) dst[k] = nx_[i]; } } while (0)
#define CH_STOREIMG(src, bufoff) do { _Pragma("unroll") for (int k = 0; k < 4; ++k) { const int i = tid + k * NTHREADS; if (i < IMG_V4) *(LDSP u32x4*)(l3 + (bufoff) + i * 16) = src[k]; } } while (0)
#define CH_LOADU(dst, nn_) do { if (act) { const bf16_t* Uw_ = (const bf16_t*)(rec + (size_t)(nn_) * REC_BYTES + REC_U) + (size_t)et * 512; dst[0] = *(const u32x2*)(Uw_ + (size_t)lane * 4); dst[1] = *(const u32x2*)(Uw_ + ((size_t)64 + lane) * 4); } } while (0)
#define CH_ROWBASE(nn_) (b * LP + ((nn_) == 0 ? 0 : NMETA + ((nn_) - 1) * CT))
#define CH_ZS(dst, nn_, nv_) do { if (act) { const bf16_t* ZS_ = (const bf16_t*)(A.ws + WS_ZS); _Pragma("unroll") for (int mt = 0; mt < 2; ++mt) _Pragma("unroll") for (int jj = 0; jj < 4; ++jj) { const int tok = mt * 16 + q * 4 + jj; dst[mt * 4 + jj] = tok < (nv_) ? (unsigned)ZS_[(size_t)(CH_ROWBASE(nn_) + tok) * 512 + e] : 0u; } } } while (0)
#define CH_OUT(zz, nn_, nv_) do { if (act) { _Pragma("unroll") for (int k = 0; k < 8; ++k) asm volatile("" : "+v"(zz[k])); \
        _Pragma("unroll") for (int mt = 0; mt < 2; ++mt) _Pragma("unroll") for (int jj = 0; jj < 4; ++jj) { const int tok = mt * 16 + q * 4 + jj; \
            const float ssq = row16_sum(o[mt][jj] * o[mt][jj]); \
            if (tok < (nv_)) { const size_t row = (size_t)(CH_ROWBASE(nn_) + tok); \
                ON[row * 512 + e] = f2bf(o[mt][jj] * gnw * __builtin_bit_cast(float, zz[mt * 4 + jj] << 16)); \
                if (nn == 0) PSS[row * 32 + h * 8 + et] = ssq; } } } } while (0)
    CH_LOADIMG(pfa, 1); CH_LOADU(uw, 0); CH_ZS(zs, 0, NMETA);
    CH_STOREIMG(pfa, IMG_BYTES);
    lds_barrier();
    CH_LOADIMG(pfa, 2);
    for (int n = 0; n < NCH; n += 2) {
        if (n + 1 < NCH) { CH_LOADU(uwn, n + 1); CH_ZS(zsn, n + 1, CT); }
        if (n + 3 < NCH) CH_LOADIMG(pfb, n + 3);
        if (act) gdn_step(l3 + (n % 3) * IMG_BYTES, uw, S, o, lane);
        CH_OUT(zs, n, (n == 0 ? NMETA : CT));
        if (n + 2 < NCH) CH_STOREIMG(pfa, ((n + 2) % 3) * IMG_BYTES);
        lds_barrier();
        if (n + 1 >= NCH) break;
        if (n + 2 < NCH) { CH_LOADU(uw, n + 2); CH_ZS(zs, n + 2, CT); }
        if (n + 4 < NCH) CH_LOADIMG(pfa, n + 4);
        if (act) gdn_step(l3 + ((n + 1) % 3) * IMG_BYTES, uwn, S, o, lane);
        CH_OUT(zsn, n + 1, CT);
        if (n + 3 < NCH) CH_STOREIMG(pfb, (n % 3) * IMG_BYTES);
        lds_barrier();
    }
#undef CH_LOADIMG
#undef CH_STOREIMG
#undef CH_LOADU
#undef CH_ROWBASE
#undef CH_ZS
#undef CH_OUT
    if (act) gdn_store_state(A.out + O_PGDN + (size_t)(b * GH + h) * 128 * 128, S, et, lane);
}
__device__ __forceinline__ void gdn_finish_rows(const Args& A, int tid, int skip) {
    if ((int)blockIdx.x < skip) return;
    const int wave = tid >> 6, lane = tid & 63, G = gridDim.x - skip;
    bf16_t* ON = (bf16_t*)((unsigned char*)A.out + DO_ON); const float* PSS = (const float*)(A.ws + WS_SSQ);
    for (int r = ((int)blockIdx.x - skip) * 8 + wave; r < TPR; r += G * 8) {
        float ps = (lane < 32) ? PSS[(size_t)r * 32 + lane] : 0.f;
        ps += __shfl_xor(ps, 1); ps += __shfl_xor(ps, 2); ps += __shfl_xor(ps, 4);
        const float tot = __shfl(ps, (lane >> 4) * 8);
        const float rs = rsqrtf(tot * (1.f / 128.f) + EPS);
        u32x4* p = (u32x4*)(ON + (size_t)r * 512 + lane * 8); u32x4 w = *p;
        w.x = pk2(bflo(w.x) * rs, bfhi(w.x) * rs); w.y = pk2(bflo(w.y) * rs, bfhi(w.y) * rs); w.z = pk2(bflo(w.z) * rs, bfhi(w.z) * rs); w.w = pk2(bflo(w.w) * rs, bfhi(w.w) * rs);
        *p = w;
    }
}

template <int CHAIN_PASS> __device__ __forceinline__ void gdn_chain(const Args& A, unsigned char* lds, int b, int h, int tid) {
    const int wave = tid >> 6, lane = tid & 63;
    const unsigned char* rec = A.ws + WS_REC + (size_t)((b * GH + h) * NCH) * REC_BYTES;
    LDSP unsigned char* l3 = (LDSP unsigned char*)lds; asm volatile("" : "+v"(l3));
    LDSP float* PART = (LDSP float*)(l3 + LC_PART);
    const float gnw = A.in[25][wave * 16 + (lane & 15)];
    f32x4 S[8], o[2];
#ifdef CHAIN_HASH
    {
        float hs = 0.f; float* dstp = A.out + O_PGDN + (size_t)(b * GH + h) * 128 * 128;
        for (int n = 0; n < NCH; ++n) { const u32x4* rp = (const u32x4*)(rec + (size_t)n * REC_BYTES);
            for (int i = tid; i < REC_BYTES / 16; i += NTHREADS) {
                const bool used = (i * 16 >= IMG_HDR && i * 16 < IMG_HDR + 16) || (i * 16 >= REC_U) || (i * 16 < IMG_KDT && ((i * 16) % 272) < 256) || (i * 16 >= IMG_KDT && i * 16 < IMG_HDR && (((i * 16) - IMG_KDT) % 80) < 64);
                if (!used) continue;
                const u32x4 w = rp[i];
                if (i * 16 == IMG_HDR) { hs += __builtin_bit_cast(float, w.x); continue; }
                hs += bflo(w.x) + bfhi(w.x) + bflo(w.y) + bfhi(w.y) + bflo(w.z) + bfhi(w.z) + bflo(w.w) + bfhi(w.w); } }
        for (int i = tid; i < 128 * 128; i += NTHREADS) dstp[i] = (i < NTHREADS) ? hs : 0.f;
        return;
    }
#endif
#pragma unroll
    for (int dt = 0; dt < 8; ++dt) S[dt] = (f32x4){0.f, 0.f, 0.f, 0.f};
    for (int i = tid; i < IMG_V4; i += NTHREADS) *(LDSP u32x4*)(l3 + LC_BUF0 + i * 16) = ((const u32x4*)rec)[i];
    __syncthreads();
#ifdef CHAIN_SIMPLE
    for (int n = 0; n < NCH; ++n) {
        if (n > 0) { const u32x4* rp = (const u32x4*)(rec + (size_t)n * REC_BYTES);
            for (int i = tid; i < IMG_V4; i += NTHREADS) *(LDSP u32x4*)(l3 + LC_BUF0 + i * 16) = rp[i];
            __syncthreads(); }
        const int rowbase = b * LP + (n == 0 ? 0 : NMETA + (n - 1) * CT), nvalid = n == 0 ? NMETA : CT;
        unsigned zs[8]; gdn_zs_prefetch(A, zs, rowbase, nvalid, h, wave, lane);
        u32x2 uw[2]; { const bf16_t* Uw = (const bf16_t*)(rec + (size_t)n * REC_BYTES + REC_U) + (size_t)wave * 512; uw[0] = *(const u32x2*)(Uw + (size_t)lane * 4); uw[1] = *(const u32x2*)(Uw + ((size_t)64 + lane) * 4); }
        gdn_step(l3 + LC_BUF0, uw, S, o, lane);
        gdn_norm_store(A, o, zs, gnw, PART, rowbase, nvalid, h, wave, lane);
        __syncthreads();
    }
#else
    u32x4 pfa[4], pfb[4]; u32x2 uw[2], uwn[2]; unsigned zs[8], zsn[8];
#define CH_LOADIMG(dst, nn) do { const u32x4* nx_ = (const u32x4*)(rec + (size_t)(nn) * REC_BYTES); _Pragma("unroll") for (int k = 0; k < 4; ++k) { const int i = tid + k * NTHREADS; if (i < IMG_V4) dst[k] = nx_[i]; } } while (0)
#define CH_STOREIMG(src, bufoff) do { _Pragma("unroll") for (int k = 0; k < 4; ++k) { const int i = tid + k * NTHREADS; if (i < IMG_V4) *(LDSP u32x4*)(l3 + (bufoff) + i * 16) = src[k]; } } while (0)
#define CH_LOADU(dst, nn) do { const bf16_t* Uw_ = (const bf16_t*)(rec + (size_t)(nn) * REC_BYTES + REC_U) + (size_t)wave * 512; dst[0] = *(const u32x2*)(Uw_ + (size_t)lane * 4); dst[1] = *(const u32x2*)(Uw_ + ((size_t)64 + lane) * 4); } while (0)
#define CH_ROWBASE(nn) (b * LP + ((nn) == 0 ? 0 : NMETA + ((nn) - 1) * CT))
    CH_LOADIMG(pfa, 1); CH_LOADU(uw, 0); gdn_zs_prefetch(A, zs, CH_ROWBASE(0), NMETA, h, wave, lane);
    CH_STOREIMG(pfa, LC_BUF1);
    lds_barrier();
    CH_LOADIMG(pfa, 2);
    for (int n = 0; n < NCH; n += 2) {
        if (n + 1 < NCH) { CH_LOADU(uwn, n + 1); gdn_zs_prefetch(A, zsn, CH_ROWBASE(n + 1), CT, h, wave, lane); }
        if (n + 3 < NCH) CH_LOADIMG(pfb, n + 3);
        gdn_step(l3 + LC_BUF0, uw, S, o, lane);
        gdn_norm_store(A, o, zs, gnw, PART, CH_ROWBASE(n), n == 0 ? NMETA : CT, h, wave, lane);
        if (n + 2 < NCH) CH_STOREIMG(pfa, LC_BUF0);
        lds_barrier();
        if (n + 1 >= NCH) break;
        if (n + 2 < NCH) { CH_LOADU(uw, n + 2); gdn_zs_prefetch(A, zs, CH_ROWBASE(n + 2), CT, h, wave, lane); }
        if (n + 4 < NCH) CH_LOADIMG(pfa, n + 4);
        gdn_step(l3 + LC_BUF1, uwn, S, o, lane);
        gdn_norm_store(A, o, zsn, gnw, PART, CH_ROWBASE(n + 1), CT, h, wave, lane);
        if (n + 3 < NCH) CH_STOREIMG(pfb, LC_BUF1);
        lds_barrier();
    }
#undef CH_LOADIMG
#undef CH_STOREIMG
#undef CH_LOADU
#undef CH_ROWBASE
#endif
#ifdef CHAIN_TWICE
    {
        float* scr = (float*)(A.ws + WS_C) + (size_t)(b * GH + h) * 128 * 128;
        if (CHAIN_PASS == 0) gdn_store_state(scr, S, wave, lane);
        else { const int q = lane >> 4, n = lane & 15; int bad = 0;
#pragma unroll
            for (int dt = 0; dt < 8; ++dt)
#pragma unroll
                for (int jj = 0; jj < 4; ++jj) bad |= (scr[(size_t)(dt * 16 + q * 4 + jj) * 128 + wave * 16 + n] != S[dt][jj]) ? 1 : 0;
            float* flagout = A.out + O_PRE + (size_t)(b * GH + h) * 512 + tid;
            if (!bad) *flagout = 0.f; }
    }
#else
#ifndef NO_PGDN
    gdn_store_state(A.out + O_PGDN + (size_t)(b * GH + h) * 128 * 128, S, wave, lane);
#endif
#endif
}

__device__ __forceinline__ void p5b_rows(const Args& A, int tid) {
    const int wave = tid >> 6, lane = tid & 63, G = gridDim.x;
    const bf16_t* MA = (const bf16_t*)(A.ws + WS_MIX); const bf16_t* MB = (const bf16_t*)(A.ws + WS_MIXB); bf16_t* F = (bf16_t*)(A.ws + WS_FB);
    f32x4 g1[4], g2[4];
#pragma unroll
    for (int j = 0; j < 4; ++j) { g1[j] = *(const f32x4*)(A.in[8] + 4 * lane + 256 * j); g2[j] = *(const f32x4*)(A.in[9] + 4 * lane + 256 * j); }
    for (int r0 = blockIdx.x * 8 + wave; r0 < T; r0 += G * 16) {
        int rr[2] = {r0, r0 + G * 8}; const bool has[2] = {true, rr[1] < T}; if (!has[1]) rr[1] = r0;
        u32x2 pa[2][4], pb[2][4]; f32x4 xv[2][4];
#pragma unroll
        for (int k = 0; k < 2; ++k) { const float* xr = x_row_ptr(A, rr[k]);
#pragma unroll
            for (int j = 0; j < 4; ++j) { pa[k][j] = *(const u32x2*)(MA + (size_t)rr[k] * 1024 + 4 * lane + 256 * j); pb[k][j] = *(const u32x2*)(MB + (size_t)rr[k] * 1024 + 4 * lane + 256 * j);
                xv[k][j] = *(const f32x4*)(xr + 4 * lane + 256 * j); } }
#pragma unroll
        for (int k = 0; k < 2; ++k) {
            if (!has[k]) continue;
            const int r = rr[k]; float* yr = y_row_ptr(A, r);
            f32x4 mvv[4]; float ss = 0.f;
#pragma unroll
            for (int j = 0; j < 4; ++j) { const u32x2 a = pa[k][j], b = pb[k][j];
                mvv[j] = (f32x4){bflo(a.x) + bflo(b.x), bfhi(a.x) + bfhi(b.x), bflo(a.y) + bflo(b.y), bfhi(a.y) + bfhi(b.y)};
                ss += (mvv[j][0] * mvv[j][0] + mvv[j][1] * mvv[j][1]) + (mvv[j][2] * mvv[j][2] + mvv[j][3] * mvv[j][3]); }
            const float rs = rsqrtf(wave_sum(ss) * (1.f / 1024.f) + EPS);
            f32x4 v[4]; float s1 = 0.f;
#pragma unroll
            for (int j = 0; j < 4; ++j) { v[j] = xv[k][j] + mvv[j] * rs * g1[j]; s1 += (v[j][0] * v[j][0] + v[j][1] * v[j][1]) + (v[j][2] * v[j][2] + v[j][3] * v[j][3]); }
            const float rs1 = rsqrtf(wave_sum(s1) * (1.f / 1024.f) + EPS);
#pragma unroll
            for (int j = 0; j < 4; ++j) {
                if (yr) *(f32x4*)(yr + 4 * lane + 256 * j) = v[j];
                const f32x4 f = v[j] * rs1 * g2[j]; u32x2 w; w.x = pk2(f[0], f[1]); w.y = pk2(f[2], f[3]); *(u32x2*)(F + (size_t)r * 1024 + 4 * lane + 256 * j) = w;
            }
        }
    }
}
__device__ __forceinline__ void p8_rows(const Args& A, int tid) {
    const int wave = tid >> 6, lane = tid & 63, G = gridDim.x;
    const bf16_t* FA = (const bf16_t*)(A.ws + WS_F2); const bf16_t* FB = (const bf16_t*)(A.ws + WS_F2B);
    f32x4 g1[4];
#pragma unroll
    for (int j = 0; j < 4; ++j) g1[j] = *(const f32x4*)(A.in[10] + 4 * lane + 256 * j);
    for (int r0 = blockIdx.x * 8 + wave; r0 < T; r0 += G * 16) {
        int rr[2] = {r0, r0 + G * 8}; float* yp[2];
        yp[0] = y_row_ptr(A, rr[0]); yp[1] = rr[1] < T ? y_row_ptr(A, rr[1]) : nullptr; if (rr[1] >= T) rr[1] = r0;
        u32x2 pa[2][4], pb[2][4]; f32x4 xv[2][4];
#pragma unroll
        for (int k = 0; k < 2; ++k) { const float* yr = yp[k] ? yp[k] : (yp[0] ? yp[0] : A.out);
#pragma unroll
            for (int j = 0; j < 4; ++j) { pa[k][j] = *(const u32x2*)(FA + (size_t)rr[k] * 1024 + 4 * lane + 256 * j); pb[k][j] = *(const u32x2*)(FB + (size_t)rr[k] * 1024 + 4 * lane + 256 * j);
                xv[k][j] = *(const f32x4*)(yr + 4 * lane + 256 * j); } }
#pragma unroll
        for (int k = 0; k < 2; ++k) {
            float* yr = yp[k]; if (!yr) continue;
            f32x4 f[4]; float ss = 0.f;
#pragma unroll
            for (int j = 0; j < 4; ++j) { const u32x2 a = pa[k][j], b = pb[k][j];
                f[j] = (f32x4){bflo(a.x) + bflo(b.x), bfhi(a.x) + bfhi(b.x), bflo(a.y) + bflo(b.y), bfhi(a.y) + bfhi(b.y)};
                ss += (f[j][0] * f[j][0] + f[j][1] * f[j][1]) + (f[j][2] * f[j][2] + f[j][3] * f[j][3]); }
            const float rs = rsqrtf(wave_sum(ss) * (1.f / 1024.f) + EPS);
#pragma unroll
            for (int j = 0; j < 4; ++j) *(f32x4*)(yr + 4 * lane + 256 * j) = xv[k][j] + f[j] * rs * g1[j];
        }
    }
}

__global__ void __launch_bounds__(NTHREADS, 2) hybrid_fwd(Args A) {
    extern __shared__ __attribute__((aligned(16))) unsigned char lds[];
    cg::grid_group grid = cg::this_grid();
    const int tid = threadIdx.x, wave = __builtin_amdgcn_readfirstlane(tid >> 6), lane = tid & 63, bid = blockIdx.x, G = gridDim.x;
    unsigned char* ws = A.ws;
    PG8_LAS unsigned char* ldsg = (PG8_LAS unsigned char*)lds;
    bf16_t* HN = (bf16_t*)(A.ws + WS_HN); bf16_t* GS = (bf16_t*)((unsigned char*)A.out + DO_GS);
#ifndef PHMASK
#define PHMASK 0x7ff
#endif
#ifndef DUPMASK
#define DUPMASK 0
#endif
#define IN(k) (((PHMASK >> (k)) & 1) && A.ph_lo <= (k) && (k) < A.ph_hi)
#define DUP(k) for (int rep_ = 0; rep_ < 1 + ((DUPMASK >> (k)) & 1); ++rep_)
#define DUPBAR(k) do { if (((DUPMASK >> (k)) & 1) && rep_ == 0) xcd_barrier(xbar); } while (0)
    volatile LAS unsigned* bst = (volatile LAS unsigned*)((LDSP unsigned char*)lds + (LDS_BYTES - 64));
    if (tid < 16) bst[tid] = 0u;
    __syncthreads();
    XcdBarrier xbar = xcd_barrier_post((unsigned*)(ws + WS_BAR), bst);
#define SEAM(k) do { if (IN(k) && IN((k) + 1)) xcd_barrier(xbar); } while (0)
    if (A.ph_lo < 0) grid.sync();
#ifdef L2_THRASH
    {
        const u32x4* src = (const u32x4*)A.in[0] + (size_t)bid * (L2_THRASH * 64); u32x4 accv = {0u, 0u, 0u, 0u};
        for (int i = tid; i < L2_THRASH * 64; i += NTHREADS) { const u32x4 v = src[i]; accv.x ^= v.x; accv.y ^= v.y; accv.z ^= v.z; accv.w ^= v.w; }
        if ((accv.x ^ accv.y ^ accv.z ^ accv.w) == 0x12345679u) ((unsigned*)(ws + WS_BAR))[4000] = 1u;
    }
#endif
#ifdef EXTRA_BARS
    for (int eb_ = 0; eb_ < EXTRA_BARS; ++eb_) xcd_barrier(xbar);
#endif
    if (IN(0)) DUP(0) {
#ifdef ZERO_REC
        { u32x4* zp = (u32x4*)(ws + WS_REC); const size_t nz = (size_t)32 * NCH * REC_BYTES / 16; const u32x4 z4 = {0u, 0u, 0u, 0u};
          for (size_t i = (size_t)bid * NTHREADS + tid; i < nz; i += (size_t)G * NTHREADS) zp[i] = z4; }
#endif
        p0_prologue(A, lds, tid, (G == 256) ? TR_I1 : TR_ITOT);
        DUPBAR(0);
    }
    SEAM(0);
    if (IN(1)) DUP(1) {
        if (G == 256) { p0_transposes(A, lds, tid, TR_I1, TR_ITOT, 158, 98); __syncthreads(); }
        pg8::StaticOrder so; so.init(TPAD, 2560, G, bid);
        EpiIn e{(bf16_t*)(ws + WS_U), (bf16_t*)(ws + WS_QKV), (bf16_t*)(ws + WS_ZS), A.out};
        pg8::gemm_phase<EpiIn, pg8::StaticOrder, true, true>(ldsg, pg8::Gemm{HN, (const bf16_t*)(ws + WS_W1), TPAD, 2560, 1024}, so, e);
        DUPBAR(1);
    }
    SEAM(1);
    if (IN(2)) DUP(2) {
        for (int u = bid; u < 2880; u += G) {
#ifndef NO_GDNP2
#ifndef P2R_A
#define P2R_A 1
#endif
#ifndef P2R_B
#define P2R_B 1
#endif
#ifndef P2R_C
#define P2R_C 1
#endif
            if (u < 2080) { const int bh = u / NCH, n = u - bh * NCH; for (int rr_ = 0; rr_ < P2R_A; ++rr_) gdn_prep(A, lds, 0, bh >> 2, bh & 3, n, tid); }
            else if (u < 2592) { const int bh = u - 2080; for (int rr_ = 0; rr_ < P2R_B; ++rr_) gdn_prep(A, lds, 1, bh >> 2, bh & 3, 0, tid); }
#endif
#ifndef NO_S5A
            if (u >= 2592 && u < 2848) { const int v = u - 2592, g = v >> 3, b = v & 7; for (int rr_ = 0; rr_ < P2R_C; ++rr_) s5_unit<0>(A, g, b, wave, lane); }
#endif
#ifndef NO_S5D
            if (u >= 2848) { const int v = (u - 2848) * 8 + wave, g = v >> 3, bg = v & 7; s5_decode(A, g, bg, lane); }
#endif
        }
        DUPBAR(2);
    }
    SEAM(2);
    if (IN(3)) DUP(3) {
        const bool chainwg = (G >= 128) && (bid < 64);
        if (G >= 128) { if (chainwg) gdn_chain2(A, lds, bid >> 3, (bid >> 1) & 3, bid & 1, tid); }
        else if (bid < 32) { gdn_chain<0>(A, lds, bid >> 2, bid & 3, tid); }
        for (int u = bid; u < 256; u += G) { const int g = u >> 3, b = u & 7; s5_unit<1>(A, g, b, wave, lane); }
        __syncthreads();
#ifndef NO_GGEMM
        const bool skipg = chainwg;
        pg8::StaticOrder so; if (G >= 128) so.init(TPAD, 2048, G - 64, bid - 64); else so.init(TPAD, 2048, G, bid);
        EpiGates e{(bf16_t*)(ws + WS_SG)};
#ifndef P3R_GG
#define P3R_GG 1
#endif
        if (!skipg) for (int rr_ = 0; rr_ < P3R_GG; ++rr_) pg8::gemm_phase<EpiGates, pg8::StaticOrder, true, true>(ldsg, pg8::Gemm{HN, (const bf16_t*)(ws + WS_W1) + (size_t)2560 * 1024, TPAD, 2048, 1024}, so, e);
#endif
        DUPBAR(3);
    }
    SEAM(3);
    if (IN(4)) DUP(4) {
        pg8::StaticOrder so; so.init(TPAD, 2048, G, bid);
        if (G >= 128) gdn_finish_rows(A, tid, (67 * 8 > 2 * G && 67 * 8 < 3 * G) ? 67 * 8 - 2 * G : 0);
        EpiGlu e{(const bf16_t*)(ws + WS_SG), (bf16_t*)(ws + WS_SA)};
        pg8::gemm_phase<EpiGlu, pg8::StaticOrder, true, true>(ldsg, pg8::Gemm{GS, (const bf16_t*)(ws + WS_WGLU), TPAD, 2048, 512}, so, e);
        DUPBAR(4);
    }
    SEAM(4);
    if (IN(5)) DUP(5) {
        pg8::StaticOrder so; so.init(TPAD, 1024, G, bid);
        EpiGdnOut e{(const bf16_t*)(ws + WS_SG), (const bf16_t*)(ws + WS_SA), (bf16_t*)(ws + WS_MIXIN)};
        pg8::gemm_phase<EpiGdnOut, pg8::StaticOrder, true, true>(ldsg, pg8::Gemm{(const bf16_t*)((unsigned char*)A.out + DO_ON), (const bf16_t*)(ws + WS_WGO), TPAD, 1024, 512}, so, e);
        DUPBAR(5);
    }
    SEAM(5);
    if (IN(6)) DUP(6) {
        pg8::SplitK2Order so; so.init(TPAD, 1024, G, bid);
        EpiBf16Part e{(bf16_t*)(ws + WS_MIX), (bf16_t*)(ws + WS_MIXB)};
        pg8::gemm_phase<EpiBf16Part, pg8::SplitK2Order, true, true>(ldsg, pg8::Gemm{(const bf16_t*)(ws + WS_MIXIN), (const bf16_t*)(ws + WS_WO), TPAD, 1024, 512, 1024}, so, e);
    }
    SEAM(6);
    if (IN(7)) DUP(7) { p5b_rows(A, tid); DUPBAR(7); }
    SEAM(7);
    if (IN(8)) DUP(8) {
        pg8::StaticOrder so; so.init(TPAD, 5632, G, bid);
        EpiFfnUp e{(bf16_t*)(ws + WS_H)};
        pg8::gemm_phase<EpiFfnUp, pg8::StaticOrder, true, true>(ldsg, pg8::Gemm{(const bf16_t*)(ws + WS_FB), (const bf16_t*)(ws + WS_WGU), TPAD, 5632, 1024}, so, e);
        DUPBAR(8);
    }
    SEAM(8);
    if (IN(9)) DUP(9) {
        pg8::SplitK2Order so; so.init(TPAD, 1024, G, bid);
        EpiBf16Part e{(bf16_t*)(ws + WS_F2), (bf16_t*)(ws + WS_F2B)};
        pg8::gemm_phase<EpiBf16Part, pg8::SplitK2Order, true, true>(ldsg, pg8::Gemm{(const bf16_t*)(ws + WS_H), (const bf16_t*)(ws + WS_WD), TPAD, 1024, DFF / 2, DFF}, so, e);
    }
    SEAM(9);
    if (IN(10)) DUP(10) { p8_rows(A, tid); DUPBAR(10); }
#undef IN
#undef SEAM
}

extern "C" void kernel_launch(void* const* d_in, const int* in_sizes, int n_in, void* d_out, int out_size, void* d_ws, size_t ws_size, hipStream_t stream) {
    static int grid = 0;
    if (grid == 0) {
        int dev = 0, cus = 0, per_cu = 0;
        hipGetDevice(&dev);
        hipDeviceGetAttribute(&cus, hipDeviceAttributeMultiprocessorCount, dev);
        hipFuncSetAttribute((const void*)hybrid_fwd, hipFuncAttributeMaxDynamicSharedMemorySize, LDS_BYTES);
        hipOccupancyMaxActiveBlocksPerMultiprocessor(&per_cu, (const void*)hybrid_fwd, NTHREADS, LDS_BYTES);
        (void)hipGetLastError();
        if (per_cu < 1) per_cu = 1;
        grid = cus * per_cu;
        if (n_in != 31 || ws_size < 256 * MiB) fprintf(stderr, "kernel_launch: unexpected n_in %d / ws %zu\n", n_in, ws_size);
    }
    (void)hipMemsetAsync((unsigned char*)d_ws + WS_BAR, 0, 16384, stream);
    Args a{};
    for (int i = 0; i < 31; ++i) a.in[i] = (const float*)d_in[i];
    a.out = (float*)d_out; a.ws = (unsigned char*)d_ws; a.ph_lo = 0; a.ph_hi = 11;
#ifndef REP3
#define REP3 1
#endif
    a.rep3 = REP3; a.pad_ = 0;
    void* args[] = {&a};
    hipError_t e = hipLaunchCooperativeKernel((const void*)hybrid_fwd, dim3(grid), dim3(NTHREADS), args, LDS_BYTES, stream);
    if (e != hipSuccess) fprintf(stderr, "cooperative launch failed: %s (grid %d)\n", hipGetErrorString(e), grid);
}
```

```cpp
#include <hip/hip_runtime.h>
#include <hip/hip_cooperative_groups.h>
#include <cstdio>
#include <cstdint>
namespace cg = cooperative_groups;
namespace pg8 {
#define PG8_LAS __attribute__((address_space(3)))
typedef unsigned short bf16_t;
typedef short bf16x8 __attribute__((ext_vector_type(8)));
typedef float f32x4 __attribute__((ext_vector_type(4)));
typedef unsigned u32x4 __attribute__((ext_vector_type(4)));
constexpr int BM = 256, BK = 64, HALF = 128, HTB = HALF * BK * 2  , STAGE_BYTES = 8 * HTB, NXCD = 8, WGM = 8;

__host__ __device__ __forceinline__ int lds_byte(int r, int c) { const int st = (r >> 4) * 2 + (c >> 5), rr = r & 15, cc = c & 31, ob = rr * 64 + cc * 2; return st * 1024 + (ob ^ (((ob >> 9) & 1) << 5)); }
__host__ __device__ __forceinline__ void stage_rc(int b, int& R, int& C) { const int st = b / 1024, sb = b % 1024, swz = sb ^ (((sb >> 9) & 1) << 5); R = (st >> 1) * 16 + swz / 64; C = (st & 1) * 32 + (swz % 64) / 2; }
__host__ __device__ __forceinline__ int perm32(int rho) { const int n = rho >> 4, i = rho & 15; return 8 * (i >> 2) + 4 * n + (i & 3); }

struct Unit { int pm, pn, ks; };
struct SplitK2Order {
    int nM, nN, nwg, G, c;
    __host__ __device__ void init(int M, int N, int G_, int c_) { nM = M / BM; nN = N / BM; nwg = nM * nN; G = G_; c = c_; }
    __host__ __device__ bool next(int i, Unit& u) const {
        const long L = (long)i * G + c; if (L >= 2L * nwg) return false;
        int wgid = (int)(L >> 1); { const int q = nwg / NXCD, r = nwg % NXCD, xcd = wgid % NXCD, off = wgid / NXCD; wgid = (xcd < r ? xcd * (q + 1) : r * (q + 1) + (xcd - r) * q) + off; }
        const int nig = WGM * nN, gid = wgid / nig, fm = gid * WGM, gsz = (nM - fm) < WGM ? (nM - fm) : WGM;
        u.pm = fm + ((wgid % nig) % gsz); u.pn = (wgid % nig) / gsz; u.ks = (int)(L & 1); return true;
    }
    __device__ __forceinline__ void a_ready(const Unit&) const {}
    __device__ __forceinline__ void done(const Unit&) const {}
};
struct Gemm { const bf16_t* A; const bf16_t* Bt; int M, N, K; int ld; };
struct StaticOrder {
    int nM, nN, nwg, G, c;
    __host__ __device__ void init(int M, int N, int G_, int c_) { nM = M / BM; nN = N / BM; nwg = nM * nN; G = G_; c = c_; }
    __host__ __device__ bool next(int i, Unit& u) const {
        const long L = (long)i * G + c; if (L >= nwg) return false;
        int wgid = (int)L; { const int q = nwg / NXCD, r = nwg % NXCD, xcd = wgid % NXCD, off = wgid / NXCD; wgid = (xcd < r ? xcd * (q + 1) : r * (q + 1) + (xcd - r) * q) + off; }
        const int nig = WGM * nN, gid = wgid / nig, fm = gid * WGM, gsz = (nM - fm) < WGM ? (nM - fm) : WGM;
        u.pm = fm + ((wgid % nig) % gsz); u.pn = (wgid % nig) / gsz; u.ks = 0; return true;
    }
    __device__ __forceinline__ void a_ready(const Unit&) const {}
    __device__ __forceinline__ void done(const Unit&) const {}
};
__device__ __forceinline__ unsigned cvt_pk_bf16(float lo, float hi) { unsigned r; asm volatile("v_cvt_pk_bf16_f32 %0, %1, %2" : "=v"(r) : "v"(lo), "v"(hi)); return r; }
template <class Epi, class Sched, bool ALIGN_EPI = false, bool SP2 = false>
__device__ __forceinline__ void gemm_phase(PG8_LAS unsigned char* lds, const Gemm g, const Sched& S, const Epi& E) {
    const int tid = threadIdx.x, wid = __builtin_amdgcn_readfirstlane(tid >> 6), lane = tid & 63, wr = wid >> 2, wc = wid & 3, fr = lane & 15, fq = lane >> 4;
    const int K = g.K, nt = K / BK, LD = g.ld ? g.ld : g.K;
    unsigned voffA[2], voffB[2];
#pragma unroll
    for (int i = 0; i < 2; ++i) { int R, C; stage_rc(tid * 16 + i * 8192, R, C); const int Rb = Epi::PERM ? ((R & ~31) + perm32(R & 31)) : R;
        voffA[i] = (unsigned)(R * LD + C) * 2u; voffB[i] = (unsigned)(Rb * LD + C) * 2u; }
    const size_t kstep = (size_t)(BK * 2);
    const size_t hstep = (size_t)HALF * LD * 2;
    const size_t tstep = 2 * hstep;
    const unsigned ldsw = (unsigned)wid * 1024u;
    const int aoff = lds_byte(wr * 64 + fr, fq * 8), boff = lds_byte(wc * 32 + fr, fq * 8);
#define PG8_SA(b, h) (((b) * 2 + (h)) * HTB)
#define PG8_SB(b, h) ((4 + (b) * 2 + (h)) * HTB)
#define PG8_STAGE(bufoff, gbase, voff) do { _Pragma("unroll") for (int _i = 0; _i < 2; ++_i) \
        __builtin_amdgcn_global_load_lds((const unsigned*)((const char*)(gbase) + (voff)[_i]), (PG8_LAS unsigned*)(lds + (bufoff) + ldsw + _i * 8192), 16, 0, 0); } while (0)
#define PG8_LDA(dst, b, h) do { _Pragma("unroll") for (int m = 0; m < 4; ++m) _Pragma("unroll") for (int k = 0; k < 2; ++k) dst[m][k] = *(const PG8_LAS bf16x8*)(lds + PG8_SA(b, h) + aoff + m * 2048 + k * 1024); } while (0)
#define PG8_LDB(dst, b, h) do { _Pragma("unroll") for (int n = 0; n < 2; ++n) _Pragma("unroll") for (int k = 0; k < 2; ++k) dst[n][k] = *(const PG8_LAS bf16x8*)(lds + PG8_SB(b, h) + boff + n * 2048 + k * 1024); } while (0)
#define PG8_MMA(ai, bj, At, Bt) do { __builtin_amdgcn_s_setprio(1); _Pragma("unroll") for (int m = 0; m < 4; ++m) _Pragma("unroll") for (int n = 0; n < 2; ++n) _Pragma("unroll") for (int k = 0; k < 2; ++k) \
        acc[ai][bj][m][n] = __builtin_amdgcn_mfma_f32_16x16x32_bf16(Bt[n][k], At[m][k], acc[ai][bj][m][n], 0, 0, 0); __builtin_amdgcn_s_setprio(0); } while (0)
#define PG8_WAIT_V(n) asm volatile("s_waitcnt vmcnt(" #n ")" ::: "memory")
#define PG8_WAIT_L(n) asm volatile("s_waitcnt lgkmcnt(" #n ")" ::: "memory")
#define PG8_BAR __builtin_amdgcn_s_barrier()
#define PG8_SCHED __builtin_amdgcn_sched_barrier(0)
    Unit cur, nxt; int ui = 0;
    if (!S.next(0, cur)) return;
    f32x4 acc[2][2][4][2];
#pragma unroll
    for (int a = 0; a < 2; ++a)
#pragma unroll
        for (int b = 0; b < 2; ++b)
#pragma unroll
            for (int m = 0; m < 4; ++m)
#pragma unroll
                for (int n = 0; n < 2; ++n) acc[a][b][m][n] = (f32x4){0.f, 0.f, 0.f, 0.f};
    bf16x8 At[4][2], B0[2][2], B1[2][2];
    const size_t kslice = (size_t)K * 2;
    const char* cA = (const char*)g.A + (size_t)cur.pm * tstep + (size_t)cur.ks * kslice; const char* cB = (const char*)g.Bt + (size_t)cur.pn * tstep + (size_t)cur.ks * kslice;
    S.a_ready(cur);
    if constexpr (SP2) {
        PG8_STAGE(PG8_SB(0, 0), cB, voffB); PG8_STAGE(PG8_SB(0, 1), cB + hstep, voffB); PG8_STAGE(PG8_SA(0, 0), cA, voffA); PG8_STAGE(PG8_SA(0, 1), cA + hstep, voffA);
        if (wr == 1) PG8_BAR;
        PG8_WAIT_V(2); PG8_BAR;
        PG8_STAGE(PG8_SB(1, 0), cB + kstep, voffB); PG8_STAGE(PG8_SA(1, 0), cA + kstep, voffA); PG8_STAGE(PG8_SB(1, 1), cB + hstep + kstep, voffB);
        PG8_WAIT_V(6); PG8_BAR;
    } else {
        PG8_STAGE(PG8_SB(0, 0), cB, voffB); PG8_STAGE(PG8_SA(0, 0), cA, voffA); PG8_STAGE(PG8_SB(0, 1), cB + hstep, voffB); PG8_STAGE(PG8_SA(0, 1), cA + hstep, voffA);
        if (wr == 1) PG8_BAR;
        PG8_WAIT_V(4); PG8_BAR;
        PG8_STAGE(PG8_SB(1, 0), cB + kstep, voffB); PG8_STAGE(PG8_SA(1, 0), cA + kstep, voffA); PG8_STAGE(PG8_SB(1, 1), cB + hstep + kstep, voffB);
        PG8_WAIT_V(6); PG8_BAR;
    }
    for (;;) {
        const bool has_next = S.next(ui + 1, nxt);
        const char* nA = has_next ? (const char*)g.A + (size_t)nxt.pm * tstep + (size_t)nxt.ks * kslice : cA; const char* nB = has_next ? (const char*)g.Bt + (size_t)nxt.pn * tstep + (size_t)nxt.ks * kslice : cB;
        for (int t = 0; t < nt; t += 2) {
            const bool last = (t == nt - 2);
            const char* a1 = cA + (size_t)(t + 1) * kstep;
            const char* a2 = last ? nA : cA + (size_t)(t + 2) * kstep; const char* b2 = last ? nB : cB + (size_t)(t + 2) * kstep;
            const char* a3 = a2 + kstep; const char* b3 = b2 + kstep;
            if (last && has_next) S.a_ready(nxt);
            if constexpr (SP2) {
            PG8_LDB(B0, 0, 0); PG8_LDB(B1, 0, 1); PG8_SCHED; PG8_LDA(At, 0, 0); PG8_STAGE(PG8_SA(1, 1), a1 + hstep, voffA);
            PG8_WAIT_V(8); PG8_WAIT_L(0); PG8_BAR; PG8_MMA(0, 0, At, B0); PG8_MMA(0, 1, At, B1); PG8_BAR; PG8_SCHED;
            PG8_LDA(At, 0, 1); PG8_STAGE(PG8_SB(0, 0), b2, voffB); PG8_STAGE(PG8_SB(0, 1), b2 + hstep, voffB); PG8_STAGE(PG8_SA(0, 0), a2, voffA);
            PG8_WAIT_V(8); PG8_WAIT_L(0); PG8_BAR; PG8_MMA(1, 0, At, B0); PG8_MMA(1, 1, At, B1); PG8_BAR; PG8_SCHED;
            PG8_LDB(B0, 1, 0); PG8_LDB(B1, 1, 1); PG8_SCHED; PG8_LDA(At, 1, 0); PG8_STAGE(PG8_SA(0, 1), a2 + hstep, voffA);
            PG8_WAIT_V(8); PG8_WAIT_L(0); PG8_BAR; PG8_MMA(0, 0, At, B0); PG8_MMA(0, 1, At, B1); PG8_BAR; PG8_SCHED;
            PG8_LDA(At, 1, 1); PG8_STAGE(PG8_SB(1, 0), b3, voffB); PG8_STAGE(PG8_SB(1, 1), b3 + hstep, voffB); PG8_STAGE(PG8_SA(1, 0), a3, voffA);
            PG8_WAIT_V(8); PG8_WAIT_L(0); PG8_BAR; PG8_MMA(1, 0, At, B0); PG8_MMA(1, 1, At, B1); PG8_BAR; PG8_SCHED;
            } else {
            PG8_LDB(B0, 0, 0); PG8_SCHED; PG8_LDA(At, 0, 0); PG8_STAGE(PG8_SA(1, 1), a1 + hstep, voffA);
            PG8_WAIT_L(8); PG8_BAR; PG8_WAIT_L(0); PG8_MMA(0, 0, At, B0); PG8_BAR; PG8_SCHED;
            PG8_LDB(B1, 0, 1); PG8_STAGE(PG8_SB(0, 0), b2, voffB);
            PG8_BAR; PG8_WAIT_L(0); PG8_MMA(0, 1, At, B1); PG8_BAR;
            PG8_LDA(At, 0, 1); PG8_STAGE(PG8_SA(0, 0), a2, voffA);
            PG8_BAR; PG8_WAIT_L(0); PG8_MMA(1, 0, At, B0); PG8_BAR; PG8_SCHED;
            PG8_STAGE(PG8_SB(0, 1), b2 + hstep, voffB);
            PG8_WAIT_V(6); PG8_BAR; PG8_MMA(1, 1, At, B1); PG8_BAR;
            PG8_LDB(B0, 1, 0); PG8_SCHED; PG8_LDA(At, 1, 0); PG8_STAGE(PG8_SA(0, 1), a2 + hstep, voffA);
            PG8_WAIT_L(8); PG8_BAR; PG8_WAIT_L(0); PG8_MMA(0, 0, At, B0); PG8_BAR; PG8_SCHED;
            PG8_LDB(B1, 1, 1); PG8_STAGE(PG8_SB(1, 0), b3, voffB);
            PG8_BAR; PG8_WAIT_L(0); PG8_MMA(0, 1, At, B1); PG8_BAR;
            PG8_LDA(At, 1, 1); PG8_STAGE(PG8_SA(1, 0), a3, voffA);
            PG8_BAR; PG8_WAIT_L(0); PG8_MMA(1, 0, At, B0); PG8_BAR; PG8_SCHED;
            PG8_STAGE(PG8_SB(1, 1), b3 + hstep, voffB);
            PG8_WAIT_V(6); PG8_BAR; PG8_MMA(1, 1, At, B1); PG8_BAR;
            }
        }
        if constexpr (ALIGN_EPI) { if (wr == 0) PG8_BAR; }
        if constexpr (!Epi::AFTER_DRAIN) { E(acc, cur, wr, wc, fr, fq); S.done(cur); }
        if (!has_next) break;
#pragma unroll
        for (int a = 0; a < 2; ++a)
#pragma unroll
            for (int b = 0; b < 2; ++b)
#pragma unroll
                for (int m = 0; m < 4; ++m)
#pragma unroll
                    for (int n = 0; n < 2; ++n) acc[a][b][m][n] = (f32x4){0.f, 0.f, 0.f, 0.f};
        cur = nxt; cA = nA; cB = nB; ++ui;
        if constexpr (ALIGN_EPI) { if (wr == 1) PG8_BAR; }
    }
    PG8_WAIT_V(0);
    if constexpr (!ALIGN_EPI) { if (wr == 0) PG8_BAR; }
    PG8_BAR;
    if constexpr (Epi::AFTER_DRAIN) { E.fused(acc, cur, wr, wc, fr, fq, lds, wid, lane); S.done(cur); }
#undef PG8_SA
#undef PG8_SB
#undef PG8_STAGE
#undef PG8_LDA
#undef PG8_LDB
#undef PG8_MMA
#undef PG8_WAIT_V
#undef PG8_WAIT_L
#undef PG8_BAR
#undef PG8_SCHED
}
}

using pg8::bf16_t; using pg8::bf16x8; using pg8::f32x4; using pg8::u32x4;
typedef unsigned u32x2 __attribute__((ext_vector_type(2)));
typedef float f32x2 __attribute__((ext_vector_type(2)));
#define LDSP __attribute__((address_space(3)))

constexpr int DM = 1024, NB = 8, SEQ = 2048, NMETA = 16, LP = SEQ + NMETA, DB = 128, DS = 4;
constexpr int TPR = NB * LP;
constexpr int T = TPR + DB * DS;
constexpr int TPAD = 17152;
constexpr int S5W = 512, S5G = 32, S5P = 64;
constexpr int GH = 4, QKVW = 1536, DFF = 2816, INW = 4616;
constexpr float EPS = 1e-6f;
constexpr int NTHREADS = 512;
constexpr int LDS_BYTES = 163840;

constexpr size_t O_YP = 0, O_YS = 16777216, O_PRE = 17301504, O_PIM = 17317888, O_PGDN = 17334272, O_PCONV = 17858560,
                 O_SRE = 17895424, O_SIM = 18157568, O_SGDN = 18419712, O_SCONV = 26808320;
constexpr size_t DO_ON = 0, DO_GS = (size_t)TPAD * 512 * 2;
constexpr size_t MiB = 1u << 20;
constexpr size_t WS_W1 = 0, WS_WGLU = WS_W1 + (size_t)4608 * 1024 * 2, WS_WGO = WS_WGLU + (size_t)2048 * 512 * 2, WS_WO = WS_WGO + (size_t)1024 * 512 * 2,
                 WS_WGU = WS_WO + (size_t)1024 * 1024 * 2, WS_WD = WS_WGU + (size_t)5632 * 1024 * 2, WS_WEND = WS_WD + (size_t)1024 * 2816 * 2;
static_assert(WS_WEND <= 31 * MiB - 512 * 1024, "weights");
constexpr size_t WS_AB = 31 * MiB - 512 * 1024;
constexpr size_t WS_S5A = WS_AB + 640 * 1024;
constexpr size_t WS_S5C = WS_S5A + 262144;
constexpr size_t WS_S5K = WS_S5C + 131072;
constexpr size_t WS_S5ADV = WS_S5K + 1310720;
constexpr size_t WS_S5END = WS_S5ADV + 16384;
constexpr size_t WS_SSQ = WS_S5END + 1048576;
constexpr size_t WS_SSQ2 = WS_SSQ + 1089536;
constexpr size_t WS_BAR = 36 * MiB - 16384;
static_assert(WS_SSQ2 + 1089536 <= WS_BAR, "small region");
constexpr size_t WS_B = 36 * MiB;
constexpr size_t WS_C = 113 * MiB;
constexpr size_t WS_REC = WS_B, WS_SA = WS_B, WS_MIXIN = 70 * MiB, WS_FB = WS_B, WS_F2 = WS_B, WS_F2B = 70 * MiB;
constexpr size_t WS_QKV = WS_C, WS_SG = WS_C, WS_MIX = WS_C, WS_MIXB = WS_C + 34 * MiB, WS_H = WS_C;
constexpr size_t WS_U = 180 * MiB, WS_ZS = 197 * MiB, WS_HN = 214 * MiB;
static_assert(WS_SA + (size_t)T * 1024 * 2 <= WS_MIXIN && WS_MIXIN + (size_t)TPAD * 1024 * 2 <= WS_C, "B");
static_assert(WS_SG + (size_t)T * 2048 * 2 <= WS_U && WS_U + (size_t)T * 512 * 2 <= WS_ZS && WS_ZS + (size_t)T * 512 * 2 <= WS_HN, "C/D");
static_assert(WS_H + (size_t)TPAD * DFF * 2 <= WS_HN && WS_HN + (size_t)TPAD * 1024 * 2 <= 256 * MiB, "H/HN");

constexpr int CT = 32, NCH = 65;
constexpr int IMG_WN = 0, IMG_QD = 8704, IMG_KDT = 17408, IMG_QK = 27648, IMG_HDR = 30208, IMG_BYTES = 30272;
constexpr int REC_U = IMG_BYTES, REC_BYTES = IMG_BYTES + 8192 + 64;
constexpr int IMG_V4 = IMG_BYTES / 16;
static_assert(WS_REC + (size_t)32 * NCH * REC_BYTES <= WS_C, "rec");
constexpr int L_OPK = 0, L_OPKB = 8704, L_OPQ = 17408, L_MX = 30272, L_GC = 34880, L_BETA = 35008, L_EG = 35136, L_EGLK = 35264, L_SSQ = 35392,
              L_ULDS = 36864, L_PART = 45056, L_RED = 46080;
constexpr int LC_BUF0 = 0, LC_BUF1 = IMG_BYTES, LC_PART = 2 * IMG_BYTES;

struct Args { const float* in[31]; float* out; unsigned char* ws; int ph_lo, ph_hi; int rep3, pad_; };

typedef __bf16 bf16x2_t __attribute__((ext_vector_type(2)));
__device__ __forceinline__ unsigned pk2(float lo, float hi) { const f32x2 v = {lo, hi}; return __builtin_bit_cast(unsigned, __builtin_convertvector(v, bf16x2_t)); }
__device__ __forceinline__ unsigned short f2bf(float f) { return (unsigned short)(pk2(f, 0.f) & 0xffffu); }
__device__ __forceinline__ float bf2f(unsigned short b) { return __builtin_bit_cast(float, (unsigned)b << 16); }
__device__ __forceinline__ float bflo(unsigned w) { return __builtin_bit_cast(float, w << 16); }
__device__ __forceinline__ float bfhi(unsigned w) { return __builtin_bit_cast(float, w & 0xffff0000u); }
__device__ __forceinline__ float sigmoidf_(float x) { return 1.0f / (1.0f + __expf(-x)); }
__device__ __forceinline__ float siluf_(float x) { return x / (1.0f + __expf(-x)); }
__device__ __forceinline__ float geluf_(float x) { const float u = 1.5957691216057308f * (x + 0.044715f * x * x * x); return x / (1.0f + __expf(-u)); }
template <int CTRL> __device__ __forceinline__ float dpp0(float v) {
    return __builtin_bit_cast(float, __builtin_amdgcn_update_dpp(0, __builtin_bit_cast(int, v), CTRL, 0xF, 0xF, true));
}
__device__ __forceinline__ float row16_sum(float v) {
    v += dpp0<0xB1>(v); v += dpp0<0x4E>(v); v += dpp0<0x141>(v); v += dpp0<0x140>(v); return v;
}
__device__ __forceinline__ float wave_sum(float v) { v = row16_sum(v); v += __shfl_xor(v, 16); v += __shfl_xor(v, 32); return v; }
__device__ __forceinline__ bf16x8 pack8(const f32x4& a, const f32x4& b) {
    u32x4 w; w.x = pk2(a[0], a[1]); w.y = pk2(a[2], a[3]); w.z = pk2(b[0], b[1]); w.w = pk2(b[2], b[3]); return __builtin_bit_cast(bf16x8, w);
}
__device__ __forceinline__ int pos32(int d) { return (d >> 5) * 32 + ((d >> 2) & 3) * 8 + ((d >> 4) & 1) * 4 + (d & 3); }
__device__ __forceinline__ f32x4 mfma16(const bf16x8& a, const bf16x8& b, const f32x4& c) { return __builtin_amdgcn_mfma_f32_16x16x32_bf16(a, b, c, 0, 0, 0); }

__device__ __forceinline__ void lds_barrier() { asm volatile("s_waitcnt lgkmcnt(0)" ::: "memory"); __builtin_amdgcn_s_barrier(); asm volatile("" ::: "memory"); }
__device__ __forceinline__ const float* x_row_ptr(const Args& A, int r) {
    if (r < TPR) { const int b = r / LP, t = r - b * LP; return t < NMETA ? A.in[6] + (size_t)t * DM : A.in[0] + ((size_t)b * SEQ + (t - NMETA)) * DM; }
    return A.in[1] + (size_t)(r - TPR) * DM;
}
__device__ __forceinline__ float* y_row_ptr(const Args& A, int r) {
    if (r < TPR) { const int b = r / LP, t = r - b * LP; return t < NMETA ? nullptr : A.out + O_YP + ((size_t)b * SEQ + (t - NMETA)) * DM; }
    return A.out + O_YS + (size_t)(r - TPR) * DM;
}

#define EPI_LOOP4 _Pragma("unroll") for (int ai = 0; ai < 2; ++ai) _Pragma("unroll") for (int m = 0; m < 4; ++m)
struct EpiIn {
    static constexpr bool PERM = false, AFTER_DRAIN = false;
    bf16_t* U; bf16_t* QKV; bf16_t* ZS; float* out;
    __device__ __forceinline__ void operator()(const f32x4 (&acc)[2][2][4][2], const pg8::Unit& u, int wr, int wc, int fr, int fq) const {
        const int pn = u.pn;
        EPI_LOOP4 {
            const int r = u.pm * 256 + ai * 128 + wr * 64 + m * 16 + fr;
            if (r >= T) continue;
            float* cdst = nullptr;
            if (pn >= 2 && pn < 8) {
                if (r < TPR) { const int b = r / LP, t = r - b * LP; if (t >= LP - 3) cdst = out + O_PCONV + ((size_t)b * 3 + (t - (LP - 3))) * QKVW; }
                else { const int rr = r - TPR, b = rr >> 2, t = rr & 3; if (t >= 1) cdst = out + O_SCONV + ((size_t)b * 3 + (t - 1)) * QKVW; }
            }
#pragma unroll
            for (int bj = 0; bj < 2; ++bj)
#pragma unroll
                for (int n = 0; n < 2; ++n) {
                    const int c = pn * 256 + bj * 128 + wc * 32 + n * 16 + fq * 4; const f32x4 v = acc[ai][bj][m][n];
                    if (pn < 2) { u32x2 w; w.x = pk2(v[0], v[1]); w.y = pk2(v[2], v[3]); *(u32x2*)(U + (size_t)r * 512 + c) = w; }
                    else if (pn < 8) { u32x2 w; w.x = pk2(v[0], v[1]); w.y = pk2(v[2], v[3]); *(u32x2*)(QKV + (size_t)r * QKVW + (c - 512)) = w;
                        if (cdst) *(f32x4*)(cdst + (c - 512)) = v; }
                    else { u32x2 w; w.x = pk2(siluf_(v[0]), siluf_(v[1])); w.y = pk2(siluf_(v[2]), siluf_(v[3])); *(u32x2*)(ZS + (size_t)r * 512 + (c - 2048)) = w; }
                }
        }
    }
};
struct EpiGates {
    static constexpr bool PERM = false, AFTER_DRAIN = false;
    bf16_t* SG;
    __device__ __forceinline__ void operator()(const f32x4 (&acc)[2][2][4][2], const pg8::Unit& u, int wr, int wc, int fr, int fq) const {
        EPI_LOOP4 {
            const int r = u.pm * 256 + ai * 128 + wr * 64 + m * 16 + fr;
            if (r >= T) continue;
#pragma unroll
            for (int bj = 0; bj < 2; ++bj)
#pragma unroll
                for (int n = 0; n < 2; ++n) {
                    const int c = u.pn * 256 + bj * 128 + wc * 32 + n * 16 + fq * 4; const f32x4 v = acc[ai][bj][m][n];
                    u32x2 w; w.x = pk2(sigmoidf_(v[0]), sigmoidf_(v[1])); w.y = pk2(sigmoidf_(v[2]), sigmoidf_(v[3])); *(u32x2*)(SG + (size_t)r * 2048 + c) = w;
                }
        }
    }
};
struct EpiGlu {
    static constexpr bool PERM = false, AFTER_DRAIN = false;
    const bf16_t* SG; bf16_t* SA;
    __device__ __forceinline__ void operator()(const f32x4 (&acc)[2][2][4][2], const pg8::Unit& u, int wr, int wc, int fr, int fq) const {
        EPI_LOOP4 {
            const int r = u.pm * 256 + ai * 128 + wr * 64 + m * 16 + fr;
            if (r >= T) continue;
#pragma unroll
            for (int n = 0; n < 2; ++n) {
                const int c = u.pn * 128 + wc * 32 + n * 16 + fq * 4; const f32x4 a = acc[ai][0][m][n], b = acc[ai][1][m][n];
                const u32x2 g = *(const u32x2*)(SG + (size_t)r * 2048 + c);
                u32x2 w; w.x = pk2(bflo(g.x) * a[0] * sigmoidf_(b[0]), bfhi(g.x) * a[1] * sigmoidf_(b[1]));
                w.y = pk2(bflo(g.y) * a[2] * sigmoidf_(b[2]), bfhi(g.y) * a[3] * sigmoidf_(b[3]));
                *(u32x2*)(SA + (size_t)r * 1024 + c) = w;
            }
        }
    }
};
struct EpiGdnOut {
    static constexpr bool PERM = false, AFTER_DRAIN = false;
    const bf16_t* SG; const bf16_t* SA; bf16_t* MIXIN;
    __device__ __forceinline__ void operator()(const f32x4 (&acc)[2][2][4][2], const pg8::Unit& u, int wr, int wc, int fr, int fq) const {
        EPI_LOOP4 {
            const int r = u.pm * 256 + ai * 128 + wr * 64 + m * 16 + fr;
            if (r >= T) continue;
#pragma unroll
            for (int bj = 0; bj < 2; ++bj)
#pragma unroll
                for (int n = 0; n < 2; ++n) {
                    const int c = u.pn * 256 + bj * 128 + wc * 32 + n * 16 + fq * 4; const f32x4 v = acc[ai][bj][m][n];
                    const u32x2 g = *(const u32x2*)(SG + (size_t)r * 2048 + 1024 + c); const u32x2 s = *(const u32x2*)(SA + (size_t)r * 1024 + c);
                    u32x2 w; w.x = pk2(bflo(s.x) + bflo(g.x) * v[0], bfhi(s.x) + bfhi(g.x) * v[1]); w.y = pk2(bflo(s.y) + bflo(g.y) * v[2], bfhi(s.y) + bfhi(g.y) * v[3]);
                    *(u32x2*)(MIXIN + (size_t)r * 1024 + c) = w;
                }
        }
    }
};
struct EpiF32Ssq {
    static constexpr bool PERM = false, AFTER_DRAIN = false;
    float* O; float* SSQ;
    __device__ __forceinline__ void operator()(const f32x4 (&acc)[2][2][4][2], const pg8::Unit& u, int wr, int wc, int fr, int fq) const {
        EPI_LOOP4 {
            const int r = u.pm * 256 + ai * 128 + wr * 64 + m * 16 + fr;
            float ss = 0.f;
#pragma unroll
            for (int bj = 0; bj < 2; ++bj)
#pragma unroll
                for (int n = 0; n < 2; ++n) {
                    const int c = u.pn * 256 + bj * 128 + wc * 32 + n * 16 + fq * 4; const f32x4 v = acc[ai][bj][m][n];
                    ss += (v[0] * v[0] + v[1] * v[1]) + (v[2] * v[2] + v[3] * v[3]);
                    if (r < T) *(f32x4*)(O + (size_t)r * 1024 + c) = v;
                }
            ss += __shfl_xor(ss, 16); ss += __shfl_xor(ss, 32);
            if (fq == 0 && r < T) SSQ[((size_t)u.pn * T + r) * 4 + wc] = ss;
        }
    }
};
struct EpiBf16Part {
    static constexpr bool PERM = false, AFTER_DRAIN = false;
    bf16_t* O0; bf16_t* O1;
    __device__ __forceinline__ void operator()(const f32x4 (&acc)[2][2][4][2], const pg8::Unit& u, int wr, int wc, int fr, int fq) const {
        bf16_t* O = u.ks ? O1 : O0;
        EPI_LOOP4 {
            const int r = u.pm * 256 + ai * 128 + wr * 64 + m * 16 + fr;
            if (r >= T) continue;
#pragma unroll
            for (int bj = 0; bj < 2; ++bj)
#pragma unroll
                for (int n = 0; n < 2; ++n) {
                    const int c = u.pn * 256 + bj * 128 + wc * 32 + n * 16 + fq * 4; const f32x4 v = acc[ai][bj][m][n];
                    u32x2 w; w.x = pk2(v[0], v[1]); w.y = pk2(v[2], v[3]); *(u32x2*)(O + (size_t)r * 1024 + c) = w;
                }
        }
    }
};
struct EpiFfnUp {
    static constexpr bool PERM = false, AFTER_DRAIN = false;
    bf16_t* H;
    __device__ __forceinline__ void operator()(const f32x4 (&acc)[2][2][4][2], const pg8::Unit& u, int wr, int wc, int fr, int fq) const {
        EPI_LOOP4 {
            const int r = u.pm * 256 + ai * 128 + wr * 64 + m * 16 + fr;
            if (r >= T) continue;
#pragma unroll
            for (int n = 0; n < 2; ++n) {
                const int c = u.pn * 128 + wc * 32 + n * 16 + fq * 4; const f32x4 g = acc[ai][0][m][n], v = acc[ai][1][m][n];
                u32x2 w; w.x = pk2(siluf_(g[0]) * v[0], siluf_(g[1]) * v[1]); w.y = pk2(siluf_(g[2]) * v[2], siluf_(g[3]) * v[3]);
                *(u32x2*)(H + (size_t)r * DFF + c) = w;
            }
        }
    }
};
#define LAS __attribute__((address_space(3)))
#define XB_TMO      128
#define XB_XCNT(j)  (256  + 64 * (j))
#define XB_XSUB(j)  (1280 + 64 * (j))
#define XB_XGEN(j)  (2304 + 64 * (j))
#define XB_TOP      3328
#define XB_TOPGEN   3392
#define XCD_BAR_WORDS 3456
#define XB_SPIN_CAP (1u << 18)

__device__ __forceinline__ unsigned xb_ld(unsigned* p)              { return __hip_atomic_load(p, __ATOMIC_RELAXED, __HIP_MEMORY_SCOPE_AGENT); }
__device__ __forceinline__ unsigned xb_add(unsigned* p, unsigned v) { return __hip_atomic_fetch_add(p, v, __ATOMIC_RELAXED, __HIP_MEMORY_SCOPE_AGENT); }
__device__ __forceinline__ unsigned xb_xcc_id() { return (unsigned)__builtin_amdgcn_s_getreg((3 << 11) | 20) & 0xFu; }
#define XB_SPIN(cond, bar) do { unsigned _sp = 0; while (cond) { __builtin_amdgcn_s_sleep(1); \
    if ((++_sp & 255u) == 0u) { if (xb_ld(&(bar)[XB_TMO])) break; if (_sp > XB_SPIN_CAP) { atomicAdd(&(bar)[XB_TMO], 1u); break; } } } } while (0)

struct XcdBarrier {
    unsigned* bar; unsigned x;
    volatile LAS unsigned* st;
};

__device__ __forceinline__ XcdBarrier xcd_barrier_post(unsigned* bar, volatile LAS unsigned* st) {
    XcdBarrier b; b.bar = bar; b.x = xb_xcc_id(); b.st = st;
    if (threadIdx.x == 0) (void)xb_add(&bar[XB_XCNT(b.x)], 1u);
    return b;
}
__device__ __forceinline__ void xcd_barrier_complete(unsigned* bar, unsigned x, unsigned& nloc, unsigned& nx) {
    const unsigned G = gridDim.x * gridDim.y * gridDim.z;
    unsigned sum, cnt, mine, sp = 0u;
    for (;;) {
        sum = 0u; cnt = 0u; mine = 0u;
#pragma unroll
        for (unsigned j = 0; j < 16; ++j) { const unsigned c = xb_ld(&bar[XB_XCNT(j)]); sum += c; cnt += (c > 0u) ? 1u : 0u; mine = (j == x) ? c : mine; }
        if (sum == G) break;
        __builtin_amdgcn_s_sleep(1);
        if ((++sp & 255u) == 0u) { if (xb_ld(&bar[XB_TMO])) break; if (sp > XB_SPIN_CAP) { atomicAdd(&bar[XB_TMO], 1u); break; } }
    }
    nloc = mine > 0u ? mine : 1u; nx = cnt > 0u ? cnt : 1u;
}

__device__ __forceinline__ void xcd_barrier(const XcdBarrier& b) {
    asm volatile("s_waitcnt vmcnt(0)" ::: "memory");
    __syncthreads();
    if (threadIdx.x == 0) {
        unsigned* bar = b.bar;
        __builtin_amdgcn_s_waitcnt(0);
        unsigned nloc = b.st[0], nx = b.st[1];
        if (nloc == 0u) { xcd_barrier_complete(bar, b.x, nloc, nx); b.st[0] = nloc; b.st[1] = nx; }
        const unsigned old = xb_add(&bar[XB_XSUB(b.x)], 1u);
        const unsigned gen = old / nloc;
        if (old + 1u == (gen + 1u) * nloc) {
            __builtin_amdgcn_fence(__ATOMIC_RELEASE, "agent");
            asm volatile("s_waitcnt vmcnt(0)" ::: "memory");
            const unsigned og = xb_add(&bar[XB_TOP], 1u);
            const unsigned tg = og / nx;
            if (og + 1u == (tg + 1u) * nx) xb_add(&bar[XB_TOPGEN], 1u);
            else XB_SPIN(xb_ld(&bar[XB_TOPGEN]) == tg, bar);
            __builtin_amdgcn_fence(__ATOMIC_ACQUIRE, "agent");
            xb_add(&bar[XB_XGEN(b.x)], 1u);
            asm volatile("s_waitcnt vmcnt(0)" ::: "memory");
        } else {
            XB_SPIN(xb_ld(&bar[XB_XGEN(b.x)]) == gen, bar);
            __builtin_amdgcn_fence(__ATOMIC_ACQUIRE, "agent");
            asm volatile("s_waitcnt vmcnt(0)" ::: "memory");
        }
    }
    __syncthreads();
}

__device__ __forceinline__ void transpose_item(const float* src, int ld, int col0, int k0, bf16_t* dst, int K, int drow0, float* tile, int tid) {
    {
        const int k = tid >> 3, n8 = (tid & 7) * 8;
        const f32x4 a = *(const f32x4*)(src + (size_t)(k0 + k) * ld + col0 + n8), b = *(const f32x4*)(src + (size_t)(k0 + k) * ld + col0 + n8 + 4);
        float* tp = tile + k * 65 + n8;
        tp[0] = a[0]; tp[1] = a[1]; tp[2] = a[2]; tp[3] = a[3]; tp[4] = b[0]; tp[5] = b[1]; tp[6] = b[2]; tp[7] = b[3];
    }
    __syncthreads();
    {
        const int n = tid >> 3, k8 = (tid & 7) * 8; const float* tp = tile + k8 * 65 + n;
        u32x4 w; w.x = pk2(tp[0], tp[65]); w.y = pk2(tp[130], tp[195]); w.z = pk2(tp[260], tp[325]); w.w = pk2(tp[390], tp[455]);
        *(u32x4*)(dst + (size_t)(drow0 + n) * K + k0 + k8) = w;
    }
    __syncthreads();
}

__device__ __forceinline__ void cpow_(float lr, float li, float dt, int k, float& re, float& im) {
    const float mag = expf((float)k * lr * dt);
    double rev = (double)k * (double)li * (double)dt * 0.15915494309189535; rev -= rint(rev);
    const float rf = (float)rev;
    re = mag * __builtin_amdgcn_cosf(rf); im = mag * __builtin_amdgcn_sinf(rf);
}

__device__ __forceinline__ void p0_transposes(const Args& A, unsigned char* lds, int tid, int it_lo, int it_hi, int blk0, int nblk) {
    unsigned char* ws = A.ws;
    const int bid = (int)blockIdx.x - blk0; if (bid < 0 || bid >= nblk) return;
    const int G = nblk;
    float* tile = (float*)lds;
    constexpr int I1 = 72 * 16, I2 = 32 * 8, I3 = 16 * 8, I4 = 16 * 16, I5 = 88 * 16;
    struct TI { const float* src; int ld, col0, k0; bf16_t* dst; int K, drow0; };
    auto item = [&](int it) -> TI {
        int r = it;
        if (r < I1) { const int nb = r >> 4, kb = r & 15, n0 = nb * 64; return TI{A.in[11], INW, n0 < 2560 ? n0 : n0 + 8, kb * 64, (bf16_t*)(ws + WS_W1), 1024, n0}; } r -= I1;
        if (r < I2) { const int nb = r >> 3, kb = r & 7, n0 = nb * 64, pn = n0 >> 8, j = n0 & 255; return TI{j < 128 ? A.in[20] : A.in[21], 1024, pn * 128 + (j & 127), kb * 64, (bf16_t*)(ws + WS_WGLU), 512, n0}; } r -= I2;
        if (r < I3) { const int nb = r >> 3, kb = r & 7; return TI{A.in[26], 1024, nb * 64, kb * 64, (bf16_t*)(ws + WS_WGO), 512, nb * 64}; } r -= I3;
        if (r < I4) { const int nb = r >> 4, kb = r & 15; return TI{A.in[27], 1024, nb * 64, kb * 64, (bf16_t*)(ws + WS_WO), 1024, nb * 64}; } r -= I4;
        if (r < I5) { const int nb = r >> 4, kb = r & 15, n0 = nb * 64, pn = n0 >> 8, j = n0 & 255; return TI{j < 128 ? A.in[28] : A.in[29], DFF, pn * 128 + (j & 127), kb * 64, (bf16_t*)(ws + WS_WGU), 1024, n0}; } r -= I5;
        const int nb = r / 44, kb = r - nb * 44; return TI{A.in[30], 1024, nb * 64, kb * 64, (bf16_t*)(ws + WS_WD), DFF, nb * 64};
    };
    float* tile2 = (float*)(lds + 65536);
    for (int it = it_lo + bid; it < it_hi; it += 2 * G) {
        const bool two = it + G < it_hi;
        const TI t0 = item(it), t1 = item(two ? it + G : it);
        {
            const int k = tid >> 3, n8 = (tid & 7) * 8;
            const f32x4 a0 = *(const f32x4*)(t0.src + (size_t)(t0.k0 + k) * t0.ld + t0.col0 + n8), b0 = *(const f32x4*)(t0.src + (size_t)(t0.k0 + k) * t0.ld + t0.col0 + n8 + 4);
            const f32x4 a1 = *(const f32x4*)(t1.src + (size_t)(t1.k0 + k) * t1.ld + t1.col0 + n8), b1 = *(const f32x4*)(t1.src + (size_t)(t1.k0 + k) * t1.ld + t1.col0 + n8 + 4);
            float* tp = tile + k * 65 + n8; tp[0] = a0[0]; tp[1] = a0[1]; tp[2] = a0[2]; tp[3] = a0[3]; tp[4] = b0[0]; tp[5] = b0[1]; tp[6] = b0[2]; tp[7] = b0[3];
            float* tq = tile2 + k * 65 + n8; tq[0] = a1[0]; tq[1] = a1[1]; tq[2] = a1[2]; tq[3] = a1[3]; tq[4] = b1[0]; tq[5] = b1[1]; tq[6] = b1[2]; tq[7] = b1[3];
        }
        __syncthreads();
        {
            const int n = tid >> 3, k8 = (tid & 7) * 8; const float* tp = tile + k8 * 65 + n; const float* tq = tile2 + k8 * 65 + n;
            u32x4 w; w.x = pk2(tp[0], tp[65]); w.y = pk2(tp[130], tp[195]); w.z = pk2(tp[260], tp[325]); w.w = pk2(tp[390], tp[455]);
            *(u32x4*)(t0.dst + (size_t)(t0.drow0 + n) * t0.K + t0.k0 + k8) = w;
            if (two) { u32x4 v; v.x = pk2(tq[0], tq[65]); v.y = pk2(tq[130], tq[195]); v.z = pk2(tq[260], tq[325]); v.w = pk2(tq[390], tq[455]);
                *(u32x4*)(t1.dst + (size_t)(t1.drow0 + n) * t1.K + t1.k0 + k8) = v; }
        }
        __syncthreads();
    }
}
constexpr int TR_I1 = 72 * 16, TR_ITOT = 72 * 16 + 32 * 8 + 16 * 8 + 16 * 16 + 88 * 16 + 16 * 44;

__device__ __forceinline__ void p0_prologue(const Args& A, unsigned char* lds, int tid, int tr_hi) {
    unsigned char* ws = A.ws;
    const int G = gridDim.x, bid = blockIdx.x;
    float* wab = (float*)(lds + 20480);
    p0_transposes(A, lds, tid, 0, tr_hi, 0, G);
    {
        const int gt = bid * NTHREADS + tid, NT = G * NTHREADS;
        const float* Are = A.in[12]; const float* Aim = A.in[13]; const float* Bre = A.in[14]; const float* Bim = A.in[15];
        const float* Cre = A.in[16]; const float* Cim = A.in[17]; const float* ldt = A.in[18];
        for (int e = gt; e < 32 * 8 * 64; e += NT) {
            const int g = e >> 9, tile_ = (e >> 6) & 7, lane = e & 63, q = lane >> 4, r = lane & 15;
            const float dt = expf(ldt[g]);
            {
                const int pp = tile_ * 16 + r, st = pp >> 1, part = pp & 1;
                const float lr = Are[g * 64 + st], li = Aim[g * 64 + st];
                float ar, ai; cpow_(lr, li, dt, 1, ar, ai);
                const float nr = ar - 1.f, ni = ai, den = 1.f / (lr * lr + li * li);
                const float cr = (nr * lr + ni * li) * den, ci = (ni * lr - nr * li) * den;
                float v[8];
#pragma unroll
                for (int j = 0; j < 8; ++j) {
                    if (q < 2) { const int c = q * 8 + j; const float br = Bre[(g * 64 + st) * 16 + c], bi = Bim[(g * 64 + st) * 16 + c];
                        v[j] = part == 0 ? (cr * br - ci * bi) : (cr * bi + ci * br); } else v[j] = 0.f;
                }
                u32x4 w; w.x = pk2(v[0], v[1]); w.y = pk2(v[2], v[3]); w.z = pk2(v[4], v[5]); w.w = pk2(v[6], v[7]);
                *(u32x4*)(ws + WS_S5A + (size_t)e * 16) = w;
            }
            {
                float* kd = (float*)(ws + WS_S5K) + (size_t)e * 20;
#pragma unroll
                for (int s = 0; s < 2; ++s) {
                    const int st = tile_ * 8 + q * 2 + s; const float lr = Are[g * 64 + st], li = Aim[g * 64 + st];
                    float re, im;
                    cpow_(lr, li, dt, -r, re, im); kd[s * 6 + 0] = re; kd[s * 6 + 1] = im;
                    cpow_(lr, li, dt, r, re, im); kd[s * 6 + 2] = re; kd[s * 6 + 3] = im;
                    cpow_(lr, li, dt, r + 1, re, im); kd[s * 6 + 4] = re; kd[s * 6 + 5] = im;
                }
            }
            if (r == 0) {
                f32x4 o;
                { const int st = tile_ * 8 + q * 2; float re, im; cpow_(Are[g * 64 + st], Aim[g * 64 + st], dt, 256, re, im); o[0] = re; o[1] = im; }
                { const int st = tile_ * 8 + q * 2 + 1; float re, im; cpow_(Are[g * 64 + st], Aim[g * 64 + st], dt, 256, re, im); o[2] = re; o[3] = im; }
                *(f32x4*)(ws + WS_S5ADV + (size_t)((g * 8 + tile_) * 4 + q) * 16) = o;
            }
            if (tile_ < 4) {
                const int pair = tile_; float v[8];
#pragma unroll
                for (int jj = 0; jj < 8; ++jj) { const int pp = (2 * pair + (jj >> 2)) * 16 + q * 4 + (jj & 3), st = pp >> 1;
                    v[jj] = (pp & 1) ? -Cim[(g * 16 + r) * 64 + st] : Cre[(g * 16 + r) * 64 + st]; }
                u32x4 w; w.x = pk2(v[0], v[1]); w.y = pk2(v[2], v[3]); w.z = pk2(v[4], v[5]); w.w = pk2(v[6], v[7]);
                *(u32x4*)(ws + WS_S5C + (size_t)((g * 4 + pair) * 64 + lane) * 16) = w;
            }
        }
    }
    {
        for (int idx = tid; idx < 8192; idx += NTHREADS) { const int k = idx >> 3, o = idx & 7; wab[o * 1024 + k] = A.in[11][(size_t)k * INW + 2560 + o]; }
        __syncthreads();
        const int wave = tid >> 6, lane = tid & 63;
        bf16_t* HN = (bf16_t*)(A.ws + WS_HN); float* AB = (float*)(ws + WS_AB);
        const float* gw = A.in[7];
        f32x4 gv[4];
#pragma unroll
        for (int j = 0; j < 4; ++j) gv[j] = *(const f32x4*)(gw + 4 * lane + 256 * j);
        for (int r0 = bid * 8 + wave; r0 < T; r0 += G * 16) {
            int rr[2] = {r0, r0 + G * 8}; const bool has1 = rr[1] < T; if (!has1) rr[1] = r0;
            f32x4 vv[2][4];
#pragma unroll
            for (int k = 0; k < 2; ++k) { const float* xr = x_row_ptr(A, rr[k]);
#pragma unroll
                for (int j = 0; j < 4; ++j) vv[k][j] = *(const f32x4*)(xr + 4 * lane + 256 * j); }
#pragma unroll
            for (int k = 0; k < 2; ++k) {
                if (k == 1 && !has1) continue;
                const int r = rr[k]; f32x4 v[4]; float s = 0.f;
#pragma unroll
                for (int j = 0; j < 4; ++j) { v[j] = vv[k][j]; s += (v[j][0] * v[j][0] + v[j][1] * v[j][1]) + (v[j][2] * v[j][2] + v[j][3] * v[j][3]); }
                const float rs = rsqrtf(wave_sum(s) * (1.f / 1024.f) + EPS);
#pragma unroll
                for (int j = 0; j < 4; ++j) { v[j] = v[j] * rs * gv[j]; u32x2 w; w.x = pk2(v[j][0], v[j][1]); w.y = pk2(v[j][2], v[j][3]); *(u32x2*)(HN + (size_t)r * 1024 + 4 * lane + 256 * j) = w; }
                float ab[8];
#pragma unroll
                for (int o = 0; o < 8; ++o) { float d = 0.f;
#pragma unroll
                    for (int j = 0; j < 4; ++j) { const f32x4 w4 = *(const f32x4*)(wab + o * 1024 + 4 * lane + 256 * j); d += (v[j][0] * w4[0] + v[j][1] * w4[1]) + (v[j][2] * w4[2] + v[j][3] * w4[3]); }
                    ab[o] = wave_sum(d); }
                if (lane == 0) { *(f32x4*)(AB + (size_t)r * 8) = (f32x4){ab[0], ab[1], ab[2], ab[3]}; *(f32x4*)(AB + (size_t)r * 8 + 4) = (f32x4){ab[4], ab[5], ab[6], ab[7]}; }
            }
        }
        __syncthreads();
    }
}

__device__ __forceinline__ void s5_scan_tile(f32x4& h, const f32x4& k0, const f32x4& k1, const f32x4& k2, const f32x4&, const f32x4&) {
    const float n0r = k0[0], n0i = k0[1], t0r = k0[2], t0i = k0[3], n1r = k1[2], n1i = k1[3], t1r = k2[0], t1i = k2[1];
    float g0 = n0r * h[0] - n0i * h[1], g1 = n0r * h[1] + n0i * h[0], g2 = n1r * h[2] - n1i * h[3], g3 = n1r * h[3] + n1i * h[2];
#define S5_PFX(CTRL) { g0 += dpp0<CTRL>(g0); g1 += dpp0<CTRL>(g1); g2 += dpp0<CTRL>(g2); g3 += dpp0<CTRL>(g3); }
    S5_PFX(0x111) S5_PFX(0x112) S5_PFX(0x114) S5_PFX(0x118)
#undef S5_PFX
    h[0] = t0r * g0 - t0i * g1; h[1] = t0r * g1 + t0i * g0; h[2] = t1r * g2 - t1i * g3; h[3] = t1r * g3 + t1i * g2;
}
__device__ __forceinline__ void s5_add_carry(f32x4& h, const f32x4& cr, const f32x4& k1, const f32x4& k2) {
    const float p0r = k1[0], p0i = k1[1], p1r = k2[2], p1i = k2[3];
    h[0] += p0r * cr[0] - p0i * cr[1]; h[1] += p0r * cr[1] + p0i * cr[0];
    h[2] += p1r * cr[2] - p1i * cr[3]; h[3] += p1r * cr[3] + p1i * cr[2];
}

template <int MODE> __device__ __forceinline__ void s5_unit(const Args& A, int g, int b, int run, int lane) {
    unsigned char* ws = A.ws;
    asm volatile("" : "+v"(lane));
    const int q = lane >> 4, t = lane & 15;
    const bf16_t* U = (const bf16_t*)(ws + WS_U);
    bf16_t* GS = (bf16_t*)((unsigned char*)A.out + DO_GS);
    constexpr int NSMAX = (MODE == 2) ? 16 : 17;
    constexpr int NV = (MODE == 2) ? 4 : 16;
    int nsub, row0, rstride;
    if (MODE == 2) { nsub = 16; row0 = TPR + b * 16 * DS; rstride = DS; }
    else { const int sc0 = run == 0 ? 0 : 17 + (run - 1) * 16; nsub = run == 0 ? 17 : 16; row0 = b * LP + sc0 * 16; rstride = 16; }
    f32x4 Y[NSMAX];
#pragma unroll
    for (int sc = 0; sc < NSMAX; ++sc) Y[sc] = (f32x4){0.f, 0.f, 0.f, 0.f};
    const bool uvalid = (q < 2) && (t < NV);
    for (int pair = 0; pair < 4; ++pair) {
        const int t0 = 2 * pair, t1 = 2 * pair + 1;
        const f32x4* kp0 = (const f32x4*)(ws + WS_S5K) + ((size_t)(g * 8 + t0) * 64 + lane) * 5;
        const f32x4* kp1 = (const f32x4*)(ws + WS_S5K) + ((size_t)(g * 8 + t1) * 64 + lane) * 5;
        const f32x4 ka0 = kp0[0], ka1 = kp0[1], ka2 = kp0[2], ka3 = ka0, ka4 = ka0;
        const f32x4 kb0 = kp1[0], kb1 = kp1[1], kb2 = kp1[2], kb3 = kb0, kb4 = kb0;
        const bf16x8 A0 = *(const bf16x8*)(ws + WS_S5A + ((size_t)(g * 8 + t0) * 64 + lane) * 16);
        const bf16x8 A1 = *(const bf16x8*)(ws + WS_S5A + ((size_t)(g * 8 + t1) * 64 + lane) * 16);
        const bf16x8 Cop = *(const bf16x8*)(ws + WS_S5C + ((size_t)(g * 4 + pair) * 64 + lane) * 16);
        f32x4 c0 = (f32x4){0.f, 0.f, 0.f, 0.f}, c1 = c0;
        const bf16_t* up = U + (size_t)(row0 + t) * 512 + g * 16 + q * 8;
        const bf16x8 bzero = (bf16x8){0, 0, 0, 0, 0, 0, 0, 0};
        bf16x8 bq[NSMAX + 2];
        bq[0] = uvalid ? *(const bf16x8*)up : bzero; up += rstride * 512; asm volatile("" : "+v"(up));
        bq[1] = (uvalid && 1 < nsub) ? *(const bf16x8*)up : bzero; up += rstride * 512; asm volatile("" : "+v"(up));
        if (MODE == 1) {
            const f32x4 ad0 = *(const f32x4*)(ws + WS_S5ADV + (size_t)((g * 8 + t0) * 4 + q) * 16), ad1 = *(const f32x4*)(ws + WS_S5ADV + (size_t)((g * 8 + t1) * 4 + q) * 16);
            const float* endp = (const float*)(ws + WS_S5END) + ((size_t)(b * 32 + g) * 8) * 128;
            for (int rp = 0; rp < run; ++rp) {
                const f32x4 e0 = *(const f32x4*)(endp + rp * 128 + t0 * 16 + q * 4), e1 = *(const f32x4*)(endp + rp * 128 + t1 * 16 + q * 4);
                f32x4 n0, n1;
                n0[0] = ad0[0] * c0[0] - ad0[1] * c0[1] + e0[0]; n0[1] = ad0[0] * c0[1] + ad0[1] * c0[0] + e0[1];
                n0[2] = ad0[2] * c0[2] - ad0[3] * c0[3] + e0[2]; n0[3] = ad0[2] * c0[3] + ad0[3] * c0[2] + e0[3];
                n1[0] = ad1[0] * c1[0] - ad1[1] * c1[1] + e1[0]; n1[1] = ad1[0] * c1[1] + ad1[1] * c1[0] + e1[1];
                n1[2] = ad1[2] * c1[2] - ad1[3] * c1[3] + e1[2]; n1[3] = ad1[2] * c1[3] + ad1[3] * c1[2] + e1[3];
                c0 = n0; c1 = n1;
            }
        }
#pragma unroll
        for (int sc = 0; sc < NSMAX; ++sc) {
            if (sc < nsub) {
                if (sc + 2 < NSMAX) { bq[sc + 2] = (uvalid && sc + 2 < nsub) ? *(const bf16x8*)up : bzero; up += rstride * 512; asm volatile("" : "+v"(up)); }
                const bf16x8 Bop = bq[sc];
                const f32x4 z = (f32x4){0.f, 0.f, 0.f, 0.f};
                f32x4 h0 = mfma16(A0, Bop, z), h1 = mfma16(A1, Bop, z);
                s5_scan_tile(h0, ka0, ka1, ka2, ka3, ka4);
                s5_scan_tile(h1, kb0, kb1, kb2, kb3, kb4);
                if (MODE == 2) {
                    const int bb = b * 16 + sc; const float* sre = A.in[2] + ((size_t)bb * 32 + g) * 64; const float* sim = A.in[3] + ((size_t)bb * 32 + g) * 64;
                    const int s0 = t0 * 8 + q * 2, s1 = t1 * 8 + q * 2;
                    c0 = (f32x4){sre[s0], sim[s0], sre[s0 + 1], sim[s0 + 1]}; c1 = (f32x4){sre[s1], sim[s1], sre[s1 + 1], sim[s1 + 1]};
                }
                s5_add_carry(h0, c0, ka1, ka2); s5_add_carry(h1, c1, kb1, kb2);
                const int src = (lane & 48) | (NV - 1);
#pragma unroll
                for (int k = 0; k < 4; ++k) { c0[k] = __shfl(h0[k], src); c1[k] = __shfl(h1[k], src); }
                if (MODE == 2) {
                    if (t == NV - 1) { const int bb = b * 16 + sc; float* ore = A.out + O_SRE + ((size_t)bb * 32 + g) * 64; float* oim = A.out + O_SIM + ((size_t)bb * 32 + g) * 64;
                        const int s0 = t0 * 8 + q * 2, s1 = t1 * 8 + q * 2;
                        ore[s0] = h0[0]; oim[s0] = h0[1]; ore[s0 + 1] = h0[2]; oim[s0 + 1] = h0[3];
                        ore[s1] = h1[0]; oim[s1] = h1[1]; ore[s1 + 1] = h1[2]; oim[s1 + 1] = h1[3]; }
                }
                if (MODE != 0) Y[sc] = mfma16(Cop, pack8(h0, h1), Y[sc]);
                asm volatile("" ::: "memory");
            }
        }
        if (MODE == 0) {
            if (t == 15) { float* endp = (float*)(ws + WS_S5END) + ((size_t)((b * 32 + g) * 8 + run)) * 128;
                *(f32x4*)(endp + t0 * 16 + q * 4) = c0; *(f32x4*)(endp + t1 * 16 + q * 4) = c1; }
        }
        if (MODE == 1) {
            if (run == 7 && t == 15) { float* ore = A.out + O_PRE + ((size_t)b * 32 + g) * 64; float* oim = A.out + O_PIM + ((size_t)b * 32 + g) * 64;
                const int s0 = t0 * 8 + q * 2, s1 = t1 * 8 + q * 2;
                ore[s0] = c0[0]; oim[s0] = c0[1]; ore[s0 + 1] = c0[2]; oim[s0 + 1] = c0[3];
                ore[s1] = c1[0]; oim[s1] = c1[1]; ore[s1 + 1] = c1[2]; oim[s1 + 1] = c1[3]; }
        }
    }
    if (MODE != 0) {
        const f32x4 Dv = *(const f32x4*)(A.in[19] + g * 16 + q * 4);
        size_t eoff = (size_t)(row0 + t) * 512 + g * 16 + q * 4;
#pragma unroll
        for (int sc = 0; sc < NSMAX; ++sc) {
            if (sc < nsub && t < NV) {
                const u32x2 uu = *(const u32x2*)(U + eoff);
                const float y0 = Y[sc][0] + Dv[0] * bflo(uu.x), y1 = Y[sc][1] + Dv[1] * bfhi(uu.x), y2 = Y[sc][2] + Dv[2] * bflo(uu.y), y3 = Y[sc][3] + Dv[3] * bfhi(uu.y);
                u32x2 w; w.x = pk2(geluf_(y0), geluf_(y1)); w.y = pk2(geluf_(y2), geluf_(y3));
                *(u32x2*)(GS + eoff) = w;
            }
            eoff += rstride * 512; asm volatile("" : "+v"(eoff));
        }
    }
}

__device__ __forceinline__ void s5_decode(const Args& A, int g, int seq0, int nseq, int lane) {
    unsigned char* ws = A.ws;
    asm volatile("" : "+v"(lane));
    const int q = lane >> 4, t = lane & 15;
    const bf16_t* U = (const bf16_t*)(ws + WS_U);
    bf16_t* GS = (bf16_t*)((unsigned char*)A.out + DO_GS);
    const bool uvalid = (q < 2) && (t < DS);
    const f32x4 Dv = *(const f32x4*)(A.in[19] + g * 16 + q * 4);
#pragma unroll 1
    for (int sc = 0; sc < nseq; ++sc) {
        const int bb = seq0 + sc, row = TPR + bb * DS + t;
        bf16x8 Bop = (bf16x8){0, 0, 0, 0, 0, 0, 0, 0};
        if (uvalid) Bop = *(const bf16x8*)(U + (size_t)row * 512 + g * 16 + q * 8);
        const float* sre = A.in[2] + ((size_t)bb * 32 + g) * 64; const float* sim = A.in[3] + ((size_t)bb * 32 + g) * 64;
        float* ore = A.out + O_SRE + ((size_t)bb * 32 + g) * 64; float* oim = A.out + O_SIM + ((size_t)bb * 32 + g) * 64;
        f32x4 Y = (f32x4){0.f, 0.f, 0.f, 0.f};
#pragma unroll 1
        for (int pair = 0; pair < 4; ++pair) {
            const int t0 = 2 * pair, t1 = 2 * pair + 1;
            const f32x4* kp0 = (const f32x4*)(ws + WS_S5K) + ((size_t)(g * 8 + t0) * 64 + lane) * 5;
            const f32x4* kp1 = (const f32x4*)(ws + WS_S5K) + ((size_t)(g * 8 + t1) * 64 + lane) * 5;
            const f32x4 ka0 = kp0[0], ka1 = kp0[1], ka2 = kp0[2], ka3 = ka0, ka4 = ka0;
            const f32x4 kb0 = kp1[0], kb1 = kp1[1], kb2 = kp1[2], kb3 = kb0, kb4 = kb0;
            const bf16x8 A0 = *(const bf16x8*)(ws + WS_S5A + ((size_t)(g * 8 + t0) * 64 + lane) * 16);
            const bf16x8 A1 = *(const bf16x8*)(ws + WS_S5A + ((size_t)(g * 8 + t1) * 64 + lane) * 16);
            const bf16x8 Cop = *(const bf16x8*)(ws + WS_S5C + ((size_t)(g * 4 + pair) * 64 + lane) * 16);
            const f32x4 z = (f32x4){0.f, 0.f, 0.f, 0.f};
            f32x4 h0 = mfma16(A0, Bop, z), h1 = mfma16(A1, Bop, z);
            s5_scan_tile(h0, ka0, ka1, ka2, ka3, ka4);
            s5_scan_tile(h1, kb0, kb1, kb2, kb3, kb4);
            const int s0 = t0 * 8 + q * 2, s1 = t1 * 8 + q * 2;
            const f32x4 c0 = (f32x4){sre[s0], sim[s0], sre[s0 + 1], sim[s0 + 1]}, c1 = (f32x4){sre[s1], sim[s1], sre[s1 + 1], sim[s1 + 1]};
            s5_add_carry(h0, c0, ka1, ka2); s5_add_carry(h1, c1, kb1, kb2);
            if (t == DS - 1) { ore[s0] = h0[0]; oim[s0] = h0[1]; ore[s0 + 1] = h0[2]; oim[s0 + 1] = h0[3];
                               ore[s1] = h1[0]; oim[s1] = h1[1]; ore[s1 + 1] = h1[2]; oim[s1 + 1] = h1[3]; }
            Y = mfma16(Cop, pack8(h0, h1), Y);
        }
        if (t < DS) {
            const u32x2 uu = *(const u32x2*)(U + (size_t)row * 512 + g * 16 + q * 4);
            const float y0 = Y[0] + Dv[0] * bflo(uu.x), y1 = Y[1] + Dv[1] * bfhi(uu.x), y2 = Y[2] + Dv[2] * bflo(uu.y), y3 = Y[3] + Dv[3] * bfhi(uu.y);
            u32x2 w; w.x = pk2(geluf_(y0), geluf_(y1)); w.y = pk2(geluf_(y2), geluf_(y3));
            *(u32x2*)(GS + (size_t)row * 512 + g * 16 + q * 4) = w;
        }
    }
}

__device__ __forceinline__ void gdn_step(const LDSP unsigned char* img, const u32x2 (&uw)[2], f32x4 (&S)[8], f32x4 (&o)[2], int lane) {
    const int q = lane >> 4, r = lane & 15;
    bf16x8 Sop[4];
#pragma unroll
    for (int i = 0; i < 4; ++i) Sop[i] = pack8(S[2 * i], S[2 * i + 1]);
    bf16x8 aw[2][4];
#pragma unroll
    for (int mt = 0; mt < 2; ++mt)
#pragma unroll
        for (int i = 0; i < 4; ++i) aw[mt][i] = *(const LDSP bf16x8*)(img + IMG_WN + (mt * 16 + r) * 272 + i * 64 + q * 16);
    bf16x8 aq[2][5];
#pragma unroll
    for (int mt = 0; mt < 2; ++mt) {
#pragma unroll
        for (int i = 0; i < 4; ++i) aq[mt][i] = *(const LDSP bf16x8*)(img + IMG_QD + (mt * 16 + r) * 272 + i * 64 + q * 16);
        aq[mt][4] = *(const LDSP bf16x8*)(img + IMG_QK + (mt * 16 + r) * 80 + q * 16);
    }
    f32x4 vn[2];
#pragma unroll
    for (int mt = 0; mt < 2; ++mt) vn[mt] = (f32x4){bflo(uw[mt].x), bfhi(uw[mt].x), bflo(uw[mt].y), bfhi(uw[mt].y)};
#pragma unroll
    for (int i = 0; i < 4; ++i)
#pragma unroll
        for (int mt = 0; mt < 2; ++mt) vn[mt] = mfma16(aw[mt][i], Sop[i], vn[mt]);
    bf16x8 ak[8];
#pragma unroll
    for (int dt = 0; dt < 8; ++dt) ak[dt] = *(const LDSP bf16x8*)(img + IMG_KDT + (dt * 16 + r) * 80 + q * 16);
    const float egl = *(const LDSP float*)(img + IMG_HDR);
#pragma unroll
    for (int mt = 0; mt < 2; ++mt) o[mt] = (f32x4){0.f, 0.f, 0.f, 0.f};
#pragma unroll
    for (int i = 0; i < 4; ++i)
#pragma unroll
        for (int mt = 0; mt < 2; ++mt) o[mt] = mfma16(aq[mt][i], Sop[i], o[mt]);
    const bf16x8 Vop = pack8(vn[0], vn[1]);
#pragma unroll
    for (int mt = 0; mt < 2; ++mt) o[mt] = mfma16(aq[mt][4], Vop, o[mt]);
#pragma unroll
    for (int dt = 0; dt < 8; ++dt) S[dt] = mfma16(ak[dt], Vop, S[dt] * egl);
}
__device__ __forceinline__ void gdn_zs_prefetch(const Args& A, unsigned (&zs)[8], int rowbase, int nvalid, int h, int wave, int lane) {
    const int q = lane >> 4, n = lane & 15; const bf16_t* ZS = (const bf16_t*)(A.ws + WS_ZS); const int e = h * 128 + wave * 16 + n;
#pragma unroll
    for (int mt = 0; mt < 2; ++mt)
#pragma unroll
        for (int jj = 0; jj < 4; ++jj) { const int tok = mt * 16 + q * 4 + jj; zs[mt * 4 + jj] = tok < nvalid ? (unsigned)ZS[(size_t)(rowbase + tok) * 512 + e] : 0u; }
}
__device__ __forceinline__ void gdn_norm_store(const Args& A, const f32x4 (&o)[2], unsigned (&zs)[8], float gn, LDSP float* part, int rowbase, int nvalid, int h, int wave, int lane) {
    const int q = lane >> 4, n = lane & 15;
#pragma unroll
    for (int mt = 0; mt < 2; ++mt)
#pragma unroll
        for (int jj = 0; jj < 4; ++jj) { const float s = row16_sum(o[mt][jj] * o[mt][jj]); if (n == 0) part[wave * 32 + mt * 16 + q * 4 + jj] = s; }
    lds_barrier();
#pragma unroll
    for (int k = 0; k < 8; ++k) asm volatile("" : "+v"(zs[k]));
    bf16_t* ON = (bf16_t*)((unsigned char*)A.out + DO_ON);
    const int e = h * 128 + wave * 16 + n;
#pragma unroll
    for (int mt = 0; mt < 2; ++mt)
#pragma unroll
        for (int jj = 0; jj < 4; ++jj) {
            const int tok = mt * 16 + q * 4 + jj;
            if (tok < nvalid) {
                float tot = 0.f;
#pragma unroll
                for (int w = 0; w < 8; ++w) tot += part[w * 32 + tok];
                const float rs = rsqrtf(tot * (1.f / 128.f) + EPS);
                const size_t row = (size_t)(rowbase + tok);
#ifndef NO_ONSTORE
                ON[row * 512 + e] = f2bf(o[mt][jj] * rs * gn * __builtin_bit_cast(float, zs[mt * 4 + jj] << 16));
#endif
            }
        }
}
__device__ __forceinline__ void gdn_store_state(float* dst, const f32x4 (&S)[8], int wave, int lane) {
    const int q = lane >> 4, n = lane & 15;
#pragma unroll
    for (int dt = 0; dt < 8; ++dt)
#pragma unroll
        for (int jj = 0; jj < 4; ++jj) {
#ifdef SANITIZE
            float v = S[dt][jj]; if (!(fabsf(v) < 1e30f)) v = 12345.f; dst[(size_t)(dt * 16 + q * 4 + jj) * 128 + wave * 16 + n] = v;
#else
            dst[(size_t)(dt * 16 + q * 4 + jj) * 128 + wave * 16 + n] = S[dt][jj];
#endif
        }
}

__device__ __forceinline__ void gdn_prep(const Args& A, unsigned char* lds, int kind, int b, int h, int nchunk, int tid) {
    unsigned char* ws = A.ws;
    asm volatile("" : "+v"(tid));
    const int wave = tid >> 6, lane = tid & 63, grp = tid >> 7, cc = tid & 127;
    int rowbase, nvalid; bool hist_rows;
    if (kind == 0) { const int t0 = nchunk == 0 ? 0 : NMETA + (nchunk - 1) * CT; nvalid = nchunk == 0 ? NMETA : CT; rowbase = b * LP + t0; hist_rows = nchunk > 0; }
    else { nvalid = DS; rowbase = TPR + b * DS; hist_rows = false; }
    LDSP unsigned char* l3 = (LDSP unsigned char*)lds; asm volatile("" : "+v"(l3));
    LDSP float* MX = (LDSP float*)(l3 + L_MX); LDSP float* GC = (LDSP float*)(l3 + L_GC); LDSP float* BETA = (LDSP float*)(l3 + L_BETA); LDSP float* EG = (LDSP float*)(l3 + L_EG);
    LDSP float* EGLK = (LDSP float*)(l3 + L_EGLK); LDSP float* SSQ = (LDSP float*)(l3 + L_SSQ); LDSP float* PART = (LDSP float*)(l3 + L_PART);
    float x[CT];
    if (grp < 3) {
        const int colq = (grp == 0 ? 1024 : grp == 1 ? 512 : 0) + h * 128 + cc;
        const float* cw = A.in[22];
        const float w0 = cw[colq], w1 = cw[QKVW + colq], w2 = cw[2 * QKVW + colq], w3 = cw[3 * QKVW + colq];
        const bf16_t* QKV = (const bf16_t*)(ws + WS_QKV);
        float p0 = 0.f, p1 = 0.f, p2 = 0.f;
        if (kind == 1) { const float* sc = A.in[5] + (size_t)b * 3 * QKVW + colq; p0 = sc[0]; p1 = sc[QKVW]; p2 = sc[2 * QKVW]; }
        else if (hist_rows) { p0 = bf2f(QKV[(size_t)(rowbase - 3) * QKVW + colq]); p1 = bf2f(QKV[(size_t)(rowbase - 2) * QKVW + colq]); p2 = bf2f(QKV[(size_t)(rowbase - 1) * QKVW + colq]); }
#pragma unroll
        for (int i = 0; i < CT; ++i) {
            float cur = 0.f, v = 0.f;
            if (i < nvalid) { cur = bf2f(QKV[(size_t)(rowbase + i) * QKVW + colq]); const float y = w0 * p0 + w1 * p1 + w2 * p2 + w3 * cur; v = siluf_(y); }
            x[i] = v; p0 = p1; p1 = p2; p2 = cur;
        }
        if (grp >= 1) {
            LDSP float* red = (LDSP float*)(l3 + L_RED) + (wave - 2) * (CT * 68);
#pragma unroll
            for (int i = 0; i < CT; ++i) red[i * 68 + lane] = x[i] * x[i];
            asm volatile("s_waitcnt lgkmcnt(0)" ::: "memory");
            if (lane < CT) {
                f32x4 acc4 = (f32x4){0.f, 0.f, 0.f, 0.f};
#pragma unroll
                for (int c4 = 0; c4 < 16; ++c4) acc4 += *(const LDSP f32x4*)(red + lane * 68 + c4 * 4);
                SSQ[(wave - 2) * CT + lane] = (acc4[0] + acc4[1]) + (acc4[2] + acc4[3]);
            }
        }
    } else if (wave == 7) {
        float gval = 0.f, beta = 0.f;
        if (lane < nvalid) {
            const float* ab = (const float*)(ws + WS_AB) + (size_t)(rowbase + lane) * 8;
            const float a = ab[h] + A.in[24][h];
            const float sp = a > 20.f ? a : log1pf(expf(a));
            gval = -expf(A.in[23][h]) * sp;
            beta = 1.0f / (1.0f + expf(-ab[4 + h]));
        }
        float gc = gval;
#pragma unroll
        for (int off = 1; off < 64; off <<= 1) { const float v = __shfl_up(gc, off); if (lane >= off) gc += v; }
        const float gl = __shfl(gc, 63);
        if (lane < CT) { GC[lane] = gc; BETA[lane] = beta; EG[lane] = expf(gc); EGLK[lane] = expf(gl - gc); }
        if (lane == 0) *(LDSP float*)(l3 + IMG_HDR) = expf(gl);
    }
    lds_barrier();
    if (grp == 1 || grp == 2) {
        const int g0 = (grp - 1) * 2; const float sc = grp == 2 ? 0.08838834764831845f : 1.0f;
        LDSP bf16_t* op0 = (LDSP bf16_t*)(l3 + (grp == 1 ? L_OPK : L_OPQ)); LDSP bf16_t* opkb = (LDSP bf16_t*)(l3 + L_OPKB);
#pragma unroll
        for (int i = 0; i < CT; ++i) {
            const float inv = rsqrtf(SSQ[g0 * CT + i] + SSQ[(g0 + 1) * CT + i] + EPS) * sc;
            x[i] *= inv;
            op0[i * 136 + cc] = f2bf(x[i]);
            if (grp == 1) opkb[i * 136 + cc] = f2bf(x[i] * BETA[i]);
        }
    }
    lds_barrier();
    if (wave < 4) {
        const int q = lane >> 4, r = lane & 15, mt = wave >> 1, nt = wave & 1;
        f32x4 am = (f32x4){0.f, 0.f, 0.f, 0.f}, aq = am;
        if (nt <= mt) {
#pragma unroll
            for (int ks = 0; ks < 4; ++ks) {
                const bf16x8 bk = *(const LDSP bf16x8*)(l3 + L_OPK + (nt * 16 + r) * 272 + ks * 64 + q * 16);
                const bf16x8 akb = *(const LDSP bf16x8*)(l3 + L_OPKB + (mt * 16 + r) * 272 + ks * 64 + q * 16);
                const bf16x8 aqn = *(const LDSP bf16x8*)(l3 + L_OPQ + (mt * 16 + r) * 272 + ks * 64 + q * 16);
                am = mfma16(akb, bk, am); aq = mfma16(aqn, bk, aq);
            }
        }
        const int j = nt * 16 + r; const float gj = GC[j];
        LDSP bf16_t* qk = (LDSP bf16_t*)(l3 + IMG_QK);
#pragma unroll
        for (int jj = 0; jj < 4; ++jj) {
            const int i = mt * 16 + q * 4 + jj;
            const float dec = (i >= j) ? __expf(GC[i] - gj) : 0.f;
            MX[i * 36 + j] = (i > j) ? am[jj] * dec : 0.f;
            qk[i * 40 + pos32(j)] = f2bf(aq[jj] * dec);
        }
    }
    lds_barrier();
    if (grp == 1) {
        LDSP bf16_t* kdt = (LDSP bf16_t*)(l3 + IMG_KDT);
#pragma unroll
        for (int i = 0; i < CT; ++i) { kdt[cc * 40 + pos32(i)] = f2bf(x[i] * EGLK[i]); x[i] *= BETA[i] * EG[i]; }
    } else if (grp == 2) {
        LDSP bf16_t* qd = (LDSP bf16_t*)(l3 + IMG_QD); const int pc = pos32(cc);
#pragma unroll
        for (int i = 0; i < CT; ++i) qd[i * 136 + pc] = f2bf(x[i] * EG[i]);
    } else if (grp == 0) {
#pragma unroll
        for (int i = 0; i < CT; ++i) x[i] *= BETA[i];
    }
    if (grp < 2) {
#pragma unroll
        for (int i = 1; i < CT; ++i) {
            float s = x[i];
#pragma unroll
            for (int j4 = 0; j4 < (i + 3) / 4; ++j4) {
                const f32x4 mv = *(const LDSP f32x4*)(MX + i * 36 + j4 * 4);
                if (j4 * 4 + 0 < i) s -= mv[0] * x[j4 * 4 + 0];
                if (j4 * 4 + 1 < i) s -= mv[1] * x[j4 * 4 + 1];
                if (j4 * 4 + 2 < i) s -= mv[2] * x[j4 * 4 + 2];
                if (j4 * 4 + 3 < i) s -= mv[3] * x[j4 * 4 + 3];
            }
            x[i] = s;
            if ((i & 1) == 1) asm volatile("" ::: "memory");
        }
    }
    if (grp == 1) {
        LDSP bf16_t* wn = (LDSP bf16_t*)(l3 + IMG_WN); const int pc = pos32(cc);
#pragma unroll
        for (int i = 0; i < CT; ++i) wn[i * 136 + pc] = f2bf(-x[i]);
    } else if (grp == 0) {
        unsigned char* ub = (kind == 0) ? (ws + WS_REC + (size_t)((b * GH + h) * NCH + nchunk) * REC_BYTES + REC_U) : (lds + L_ULDS);
        const int et = cc >> 4, n = cc & 15;
#pragma unroll
        for (int mt = 0; mt < 2; ++mt)
#pragma unroll
            for (int qq = 0; qq < 4; ++qq) {
                u32x2 w; w.x = pk2(x[mt * 16 + qq * 4 + 0], x[mt * 16 + qq * 4 + 1]); w.y = pk2(x[mt * 16 + qq * 4 + 2], x[mt * 16 + qq * 4 + 3]);
                *(u32x2*)(ub + ((size_t)((et * 2 + mt) * 64 + qq * 16 + n)) * 8) = w;
            }
    }
    lds_barrier();
    if (kind == 0) {
        u32x4* dst = (u32x4*)(ws + WS_REC + (size_t)((b * GH + h) * NCH + nchunk) * REC_BYTES);
        for (int i = tid; i < IMG_V4; i += NTHREADS) dst[i] = *(const LDSP u32x4*)(l3 + i * 16);
    } else {
        f32x4 S[8], o[2];
        const float* s0 = A.in[4] + (size_t)(b * GH + h) * 128 * 128;
        const int q = lane >> 4, n = lane & 15;
#pragma unroll
        for (int dt = 0; dt < 8; ++dt)
#pragma unroll
            for (int jj = 0; jj < 4; ++jj) S[dt][jj] = s0[(size_t)(dt * 16 + q * 4 + jj) * 128 + wave * 16 + n];
        const float gnw = A.in[25][wave * 16 + (lane & 15)];
        unsigned zs[8]; gdn_zs_prefetch(A, zs, rowbase, nvalid, h, wave, lane);
        u32x2 uw[2]; { const bf16_t* Uw = (const bf16_t*)(lds + L_ULDS) + (size_t)wave * 512; uw[0] = *(const u32x2*)(Uw + (size_t)lane * 4); uw[1] = *(const u32x2*)(Uw + ((size_t)64 + lane) * 4); }
        gdn_step(l3, uw, S, o, lane);
        gdn_norm_store(A, o, zs, gnw, PART, rowbase, nvalid, h, wave, lane);
        gdn_store_state(A.out + O_SGDN + (size_t)(b * GH + h) * 128 * 128, S, wave, lane);
    }
    lds_barrier();
}

__device__ __forceinline__ void gdn_chain2(const Args& A, unsigned char* lds, int b, int h, int half, int tid) {
    const int wave = tid >> 6, lane = tid & 63, q = lane >> 4, nn = lane & 15;
    const bool act = wave < 4; const int et = half * 4 + (wave & 3);
    const unsigned char* rec = A.ws + WS_REC + (size_t)((b * GH + h) * NCH) * REC_BYTES;
    LDSP unsigned char* l3 = (LDSP unsigned char*)lds; asm volatile("" : "+v"(l3));
    const int e = h * 128 + et * 16 + nn;
    const float gnw = A.in[25][et * 16 + nn];
    bf16_t* ON = (bf16_t*)((unsigned char*)A.out + DO_ON); float* PSS = (float*)(A.ws + WS_SSQ);
    f32x4 S[8], o[2];
#pragma unroll
    for (int dt = 0; dt < 8; ++dt) S[dt] = (f32x4){0.f, 0.f, 0.f, 0.f};
    for (int i = tid; i < IMG_V4; i += NTHREADS) *(LDSP u32x4*)(l3 + LC_BUF0 + i * 16) = ((const u32x4*)rec)[i];
    u32x4 pfa[4], pfb[4]; u32x2 uw[2], uwn[2]; unsigned zs[8], zsn[8];
#define CH_LOADIMG(dst, nn_) do { const u32x4* nx_ = (const u32x4*)(rec + (size_t)(nn_) * REC_BYTES); _Pragma("unroll") for (int k = 0; k < 4; ++k) { const int i = tid + k * NTHREADS; if (i < IMG_V4) dst[k] = nx_[i]; } } while (0)
#define CH_STOREIMG(src, bufoff) do { _Pragma("unroll") for (int k = 0; k < 4; ++k) { const int i = tid + k * NTHREADS; if (i < IMG_V4) *(LDSP u32x4*)(l3 + (bufoff) + i * 16) = src[k]; } } while (0)
#define CH_LOADU(dst, nn_) do { if (act) { const bf16_t* Uw_ = (const bf16_t*)(rec + (size_t)(nn_) * REC_BYTES + REC_U) + (size_t)et * 512; dst[0] = *(const u32x2*)(Uw_ + (size_t)lane * 4); dst[1] = *(const u32x2*)(Uw_ + ((size_t)64 + lane) * 4); } } while (0)
#define CH_ROWBASE(nn_) (b * LP + ((nn_) == 0 ? 0 : NMETA + ((nn_) - 1) * CT))
#define CH_ZS(dst, nn_, nv_) do { if (act) { const bf16_t* ZS_ = (const bf16_t*)(A.ws + WS_ZS); _Pragma("unroll") for (int mt = 0; mt < 2; ++mt) _Pragma("unroll") for (int jj = 0; jj < 4; ++jj) { const int tok = mt * 16 + q * 4 + jj; dst[mt * 4 + jj] = tok < (nv_) ? (unsigned)ZS_[(size_t)(CH_ROWBASE(nn_) + tok) * 512 + e] : 0u; } } } while (0)
#define CH_OUT(zz, nn_, nv_) do { if (act) { _Pragma("unroll") for (int k = 0; k < 8; ++k) asm volatile("" : "+v"(zz[k])); \
        _Pragma("unroll") for (int mt = 0; mt < 2; ++mt) _Pragma("unroll") for (int jj = 0; jj < 4; ++jj) { const int tok = mt * 16 + q * 4 + jj; \
            const float ssq = row16_sum(o[mt][jj] * o[mt][jj]); \
            if (tok < (nv_)) { const size_t row = (size_t)(CH_ROWBASE(nn_) + tok); \
                ON[row * 512 + e] = f2bf(o[mt][jj] * gnw * __builtin_bit_cast(float, zz[mt * 4 + jj] << 16)); \
                if (nn == 0) PSS[row * 32 + h * 8 + et] = ssq; } } } } while (0)
    CH_LOADIMG(pfa, 1); CH_LOADU(uw, 0); CH_ZS(zs, 0, NMETA);
    CH_STOREIMG(pfa, IMG_BYTES);
    lds_barrier();
    CH_LOADIMG(pfa, 2);
    for (int n = 0; n < NCH; n += 2) {
        if (n + 1 < NCH) { CH_LOADU(uwn, n + 1); CH_ZS(zsn, n + 1, CT); }
        if (n + 3 < NCH) CH_LOADIMG(pfb, n + 3);
        if (act) gdn_step(l3 + (n % 3) * IMG_BYTES, uw, S, o, lane);
        CH_OUT(zs, n, (n == 0 ? NMETA : CT));
        if (n + 2 < NCH) CH_STOREIMG(pfa, ((n + 2) % 3) * IMG_BYTES);
        lds_barrier();
        if (n + 1 >= NCH) break;
        if (n + 2 < NCH) { CH_LOADU(uw, n + 2); CH_ZS(zs, n + 2, CT); }
        if (n + 4 < NCH) CH_LOADIMG(pfa, n + 4);
        if (act) gdn_step(l3 + ((n + 1) % 3) * IMG_BYTES, uwn, S, o, lane);
        CH_OUT(zsn, n + 1, CT);
        if (n + 3 < NCH) CH_STOREIMG(pfb, (n % 3) * IMG_BYTES);
        lds_barrier();
    }
#undef CH_LOADIMG
#undef CH_STOREIMG
#undef CH_LOADU
#undef CH_ROWBASE
#undef CH_ZS
#undef CH_OUT
    if (act) gdn_store_state(A.out + O_PGDN + (size_t)(b * GH + h) * 128 * 128, S, et, lane);
}
__device__ __forceinline__ void gdn_finish_rows(const Args& A, int tid, int skip) {
    if ((int)blockIdx.x < skip) return;
    const int wave = tid >> 6, lane = tid & 63, G = gridDim.x - skip;
    bf16_t* ON = (bf16_t*)((unsigned char*)A.out + DO_ON); const float* PSS = (const float*)(A.ws + WS_SSQ);
    for (int r = ((int)blockIdx.x - skip) * 8 + wave; r < TPR; r += G * 8) {
        float ps = (lane < 32) ? PSS[(size_t)r * 32 + lane] : 0.f;
        ps += __shfl_xor(ps, 1); ps += __shfl_xor(ps, 2); ps += __shfl_xor(ps, 4);
        const float tot = __shfl(ps, (lane >> 4) * 8);
        const float rs = rsqrtf(tot * (1.f / 128.f) + EPS);
        u32x4* p = (u32x4*)(ON + (size_t)r * 512 + lane * 8); u32x4 w = *p;
        w.x = pk2(bflo(w.x) * rs, bfhi(w.x) * rs); w.y = pk2(bflo(w.y) * rs, bfhi(w.y) * rs); w.z = pk2(bflo(w.z) * rs, bfhi(w.z) * rs); w.w = pk2(bflo(w.w) * rs, bfhi(w.w) * rs);
        *p = w;
    }
}

template <int CHAIN_PASS> __device__ __forceinline__ void gdn_chain(const Args& A, unsigned char* lds, int b, int h, int tid) {
    const int wave = tid >> 6, lane = tid & 63;
    const unsigned char* rec = A.ws + WS_REC + (size_t)((b * GH + h) * NCH) * REC_BYTES;
    LDSP unsigned char* l3 = (LDSP unsigned char*)lds; asm volatile("" : "+v"(l3));
    LDSP float* PART = (LDSP float*)(l3 + LC_PART);
    const float gnw = A.in[25][wave * 16 + (lane & 15)];
    f32x4 S[8], o[2];
#ifdef CHAIN_HASH
    {
        float hs = 0.f; float* dstp = A.out + O_PGDN + (size_t)(b * GH + h) * 128 * 128;
        for (int n = 0; n < NCH; ++n) { const u32x4* rp = (const u32x4*)(rec + (size_t)n * REC_BYTES);
            for (int i = tid; i < REC_BYTES / 16; i += NTHREADS) {
                const bool used = (i * 16 >= IMG_HDR && i * 16 < IMG_HDR + 16) || (i * 16 >= REC_U) || (i * 16 < IMG_KDT && ((i * 16) % 272) < 256) || (i * 16 >= IMG_KDT && i * 16 < IMG_HDR && (((i * 16) - IMG_KDT) % 80) < 64);
                if (!used) continue;
                const u32x4 w = rp[i];
                if (i * 16 == IMG_HDR) { hs += __builtin_bit_cast(float, w.x); continue; }
                hs += bflo(w.x) + bfhi(w.x) + bflo(w.y) + bfhi(w.y) + bflo(w.z) + bfhi(w.z) + bflo(w.w) + bfhi(w.w); } }
        for (int i = tid; i < 128 * 128; i += NTHREADS) dstp[i] = (i < NTHREADS) ? hs : 0.f;
        return;
    }
#endif
#pragma unroll
    for (int dt = 0; dt < 8; ++dt) S[dt] = (f32x4){0.f, 0.f, 0.f, 0.f};
    for (int i = tid; i < IMG_V4; i += NTHREADS) *(LDSP u32x4*)(l3 + LC_BUF0 + i * 16) = ((const u32x4*)rec)[i];
    __syncthreads();
#ifdef CHAIN_SIMPLE
    for (int n = 0; n < NCH; ++n) {
        if (n > 0) { const u32x4* rp = (const u32x4*)(rec + (size_t)n * REC_BYTES);
            for (int i = tid; i < IMG_V4; i += NTHREADS) *(LDSP u32x4*)(l3 + LC_BUF0 + i * 16) = rp[i];
            __syncthreads(); }
        const int rowbase = b * LP + (n == 0 ? 0 : NMETA + (n - 1) * CT), nvalid = n == 0 ? NMETA : CT;
        unsigned zs[8]; gdn_zs_prefetch(A, zs, rowbase, nvalid, h, wave, lane);
        u32x2 uw[2]; { const bf16_t* Uw = (const bf16_t*)(rec + (size_t)n * REC_BYTES + REC_U) + (size_t)wave * 512; uw[0] = *(const u32x2*)(Uw + (size_t)lane * 4); uw[1] = *(const u32x2*)(Uw + ((size_t)64 + lane) * 4); }
        gdn_step(l3 + LC_BUF0, uw, S, o, lane);
        gdn_norm_store(A, o, zs, gnw, PART, rowbase, nvalid, h, wave, lane);
        __syncthreads();
    }
#else
    u32x4 pfa[4], pfb[4]; u32x2 uw[2], uwn[2]; unsigned zs[8], zsn[8];
#define CH_LOADIMG(dst, nn) do { const u32x4* nx_ = (const u32x4*)(rec + (size_t)(nn) * REC_BYTES); _Pragma("unroll") for (int k = 0; k < 4; ++k) { const int i = tid + k * NTHREADS; if (i < IMG_V4) dst[k] = nx_[i]; } } while (0)
#define CH_STOREIMG(src, bufoff) do { _Pragma("unroll") for (int k = 0; k < 4; ++k) { const int i = tid + k * NTHREADS; if (i < IMG_V4) *(LDSP u32x4*)(l3 + (bufoff) + i * 16) = src[k]; } } while (0)
#define CH_LOADU(dst, nn) do { const bf16_t* Uw_ = (const bf16_t*)(rec + (size_t)(nn) * REC_BYTES + REC_U) + (size_t)wave * 512; dst[0] = *(const u32x2*)(Uw_ + (size_t)lane * 4); dst[1] = *(const u32x2*)(Uw_ + ((size_t)64 + lane) * 4); } while (0)
#define CH_ROWBASE(nn) (b * LP + ((nn) == 0 ? 0 : NMETA + ((nn) - 1) * CT))
    CH_LOADIMG(pfa, 1); CH_LOADU(uw, 0); gdn_zs_prefetch(A, zs, CH_ROWBASE(0), NMETA, h, wave, lane);
    CH_STOREIMG(pfa, LC_BUF1);
    lds_barrier();
    CH_LOADIMG(pfa, 2);
    for (int n = 0; n < NCH; n += 2) {
        if (n + 1 < NCH) { CH_LOADU(uwn, n + 1); gdn_zs_prefetch(A, zsn, CH_ROWBASE(n + 1), CT, h, wave, lane); }
        if (n + 3 < NCH) CH_LOADIMG(pfb, n + 3);
        gdn_step(l3 + LC_BUF0, uw, S, o, lane);
        gdn_norm_store(A, o, zs, gnw, PART, CH_ROWBASE(n), n == 0 ? NMETA : CT, h, wave, lane);
        if (n + 2 < NCH) CH_STOREIMG(pfa, LC_BUF0);
        lds_barrier();
        if (n + 1 >= NCH) break;
        if (n + 2 < NCH) { CH_LOADU(uw, n + 2); gdn_zs_prefetch(A, zs, CH_ROWBASE(n + 2), CT, h, wave, lane); }
        if (n + 4 < NCH) CH_LOADIMG(pfa, n + 4);
        gdn_step(l3 + LC_BUF1, uwn, S, o, lane);
        gdn_norm_store(A, o, zsn, gnw, PART, CH_ROWBASE(n + 1), CT, h, wave, lane);
        if (n + 3 < NCH) CH_STOREIMG(pfb, LC_BUF1);
        lds_barrier();
    }
#undef CH_LOADIMG
#undef CH_STOREIMG
#undef CH_LOADU
#undef CH_ROWBASE
#endif
#ifdef CHAIN_TWICE
    {
        float* scr = (float*)(A.ws + WS_C) + (size_t)(b * GH + h) * 128 * 128;
        if (CHAIN_PASS == 0) gdn_store_state(scr, S, wave, lane);
        else { const int q = lane >> 4, n = lane & 15; int bad = 0;
#pragma unroll
            for (int dt = 0; dt < 8; ++dt)
#pragma unroll
                for (int jj = 0; jj < 4; ++jj) bad |= (scr[(size_t)(dt * 16 + q * 4 + jj) * 128 + wave * 16 + n] != S[dt][jj]) ? 1 : 0;
            float* flagout = A.out + O_PRE + (size_t)(b * GH + h) * 512 + tid;
            if (!bad) *flagout = 0.f; }
    }
#else
#ifndef NO_PGDN
    gdn_store_state(A.out + O_PGDN + (size_t)(b * GH + h) * 128 * 128, S, wave, lane);
#endif
#endif
}

__device__ __forceinline__ void p5b_rows(const Args& A, int tid) {
    const int wave = tid >> 6, lane = tid & 63, G = gridDim.x;
    const bf16_t* MA = (const bf16_t*)(A.ws + WS_MIX); const bf16_t* MB = (const bf16_t*)(A.ws + WS_MIXB); bf16_t* F = (bf16_t*)(A.ws + WS_FB);
    f32x4 g1[4], g2[4];
#pragma unroll
    for (int j = 0; j < 4; ++j) { g1[j] = *(const f32x4*)(A.in[8] + 4 * lane + 256 * j); g2[j] = *(const f32x4*)(A.in[9] + 4 * lane + 256 * j); }
    for (int r0 = blockIdx.x * 8 + wave; r0 < T; r0 += G * 16) {
        int rr[2] = {r0, r0 + G * 8}; const bool has[2] = {true, rr[1] < T}; if (!has[1]) rr[1] = r0;
        u32x2 pa[2][4], pb[2][4]; f32x4 xv[2][4];
#pragma unroll
        for (int k = 0; k < 2; ++k) { const float* xr = x_row_ptr(A, rr[k]);
#pragma unroll
            for (int j = 0; j < 4; ++j) { pa[k][j] = *(const u32x2*)(MA + (size_t)rr[k] * 1024 + 4 * lane + 256 * j); pb[k][j] = *(const u32x2*)(MB + (size_t)rr[k] * 1024 + 4 * lane + 256 * j);
                xv[k][j] = *(const f32x4*)(xr + 4 * lane + 256 * j); } }
#pragma unroll
        for (int k = 0; k < 2; ++k) {
            if (!has[k]) continue;
            const int r = rr[k]; float* yr = y_row_ptr(A, r);
            f32x4 mvv[4]; float ss = 0.f;
#pragma unroll
            for (int j = 0; j < 4; ++j) { const u32x2 a = pa[k][j], b = pb[k][j];
                mvv[j] = (f32x4){bflo(a.x) + bflo(b.x), bfhi(a.x) + bfhi(b.x), bflo(a.y) + bflo(b.y), bfhi(a.y) + bfhi(b.y)};
                ss += (mvv[j][0] * mvv[j][0] + mvv[j][1] * mvv[j][1]) + (mvv[j][2] * mvv[j][2] + mvv[j][3] * mvv[j][3]); }
            const float rs = rsqrtf(wave_sum(ss) * (1.f / 1024.f) + EPS);
            f32x4 v[4]; float s1 = 0.f;
#pragma unroll
            for (int j = 0; j < 4; ++j) { v[j] = xv[k][j] + mvv[j] * rs * g1[j]; s1 += (v[j][0] * v[j][0] + v[j][1] * v[j][1]) + (v[j][2] * v[j][2] + v[j][3] * v[j][3]); }
            const float rs1 = rsqrtf(wave_sum(s1) * (1.f / 1024.f) + EPS);
#pragma unroll
            for (int j = 0; j < 4; ++j) {
                if (yr) *(f32x4*)(yr + 4 * lane + 256 * j) = v[j];
                const f32x4 f = v[j] * rs1 * g2[j]; u32x2 w; w.x = pk2(f[0], f[1]); w.y = pk2(f[2], f[3]); *(u32x2*)(F + (size_t)r * 1024 + 4 * lane + 256 * j) = w;
            }
        }
    }
}
__device__ __forceinline__ void p8_rows(const Args& A, int tid) {
    const int wave = tid >> 6, lane = tid & 63, G = gridDim.x;
    const bf16_t* FA = (const bf16_t*)(A.ws + WS_F2); const bf16_t* FB = (const bf16_t*)(A.ws + WS_F2B);
    f32x4 g1[4];
#pragma unroll
    for (int j = 0; j < 4; ++j) g1[j] = *(const f32x4*)(A.in[10] + 4 * lane + 256 * j);
    for (int r0 = blockIdx.x * 8 + wave; r0 < T; r0 += G * 16) {
        int rr[2] = {r0, r0 + G * 8}; float* yp[2];
        yp[0] = y_row_ptr(A, rr[0]); yp[1] = rr[1] < T ? y_row_ptr(A, rr[1]) : nullptr; if (rr[1] >= T) rr[1] = r0;
        u32x2 pa[2][4], pb[2][4]; f32x4 xv[2][4];
#pragma unroll
        for (int k = 0; k < 2; ++k) { const float* yr = yp[k] ? yp[k] : (yp[0] ? yp[0] : A.out);
#pragma unroll
            for (int j = 0; j < 4; ++j) { pa[k][j] = *(const u32x2*)(FA + (size_t)rr[k] * 1024 + 4 * lane + 256 * j); pb[k][j] = *(const u32x2*)(FB + (size_t)rr[k] * 1024 + 4 * lane + 256 * j);
                xv[k][j] = *(const f32x4*)(yr + 4 * lane + 256 * j); } }
#pragma unroll
        for (int k = 0; k < 2; ++k) {
            float* yr = yp[k]; if (!yr) continue;
            f32x4 f[4]; float ss = 0.f;
#pragma unroll
            for (int j = 0; j < 4; ++j) { const u32x2 a = pa[k][j], b = pb[k][j];
                f[j] = (f32x4){bflo(a.x) + bflo(b.x), bfhi(a.x) + bfhi(b.x), bflo(a.y) + bflo(b.y), bfhi(a.y) + bfhi(b.y)};
                ss += (f[j][0] * f[j][0] + f[j][1] * f[j][1]) + (f[j][2] * f[j][2] + f[j][3] * f[j][3]); }
            const float rs = rsqrtf(wave_sum(ss) * (1.f / 1024.f) + EPS);
#pragma unroll
            for (int j = 0; j < 4; ++j) *(f32x4*)(yr + 4 * lane + 256 * j) = xv[k][j] + f[j] * rs * g1[j];
        }
    }
}

__global__ void __launch_bounds__(NTHREADS, 2) hybrid_fwd(Args A) {
    extern __shared__ __attribute__((aligned(16))) unsigned char lds[];
    cg::grid_group grid = cg::this_grid();
    const int tid = threadIdx.x, wave = __builtin_amdgcn_readfirstlane(tid >> 6), lane = tid & 63, bid = blockIdx.x, G = gridDim.x;
    unsigned char* ws = A.ws;
    PG8_LAS unsigned char* ldsg = (PG8_LAS unsigned char*)lds;
    bf16_t* HN = (bf16_t*)(A.ws + WS_HN); bf16_t* GS = (bf16_t*)((unsigned char*)A.out + DO_GS);
#ifndef PHMASK
#define PHMASK 0x7ff
#endif
#ifndef DUPMASK
#define DUPMASK 0
#endif
#define IN(k) (((PHMASK >> (k)) & 1) && A.ph_lo <= (k) && (k) < A.ph_hi)
#define DUP(k) for (int rep_ = 0; rep_ < 1 + ((DUPMASK >> (k)) & 1); ++rep_)
#define DUPBAR(k) do { if (((DUPMASK >> (k)) & 1) && rep_ == 0) xcd_barrier(xbar); } while (0)
    volatile LAS unsigned* bst = (volatile LAS unsigned*)((LDSP unsigned char*)lds + (LDS_BYTES - 64));
    if (tid < 16) bst[tid] = 0u;
    __syncthreads();
    XcdBarrier xbar = xcd_barrier_post((unsigned*)(ws + WS_BAR), bst);
#define SEAM(k) do { if (IN(k) && IN((k) + 1)) xcd_barrier(xbar); } while (0)
    if (A.ph_lo < 0) grid.sync();
#ifdef L2_THRASH
    {
        const u32x4* src = (const u32x4*)A.in[0] + (size_t)bid * (L2_THRASH * 64); u32x4 accv = {0u, 0u, 0u, 0u};
        for (int i = tid; i < L2_THRASH * 64; i += NTHREADS) { const u32x4 v = src[i]; accv.x ^= v.x; accv.y ^= v.y; accv.z ^= v.z; accv.w ^= v.w; }
        if ((accv.x ^ accv.y ^ accv.z ^ accv.w) == 0x12345679u) ((unsigned*)(ws + WS_BAR))[4000] = 1u;
    }
#endif
#ifdef EXTRA_BARS
    for (int eb_ = 0; eb_ < EXTRA_BARS; ++eb_) xcd_barrier(xbar);
#endif
    if (IN(0)) DUP(0) {
#ifdef ZERO_REC
        { u32x4* zp = (u32x4*)(ws + WS_REC); const size_t nz = (size_t)32 * NCH * REC_BYTES / 16; const u32x4 z4 = {0u, 0u, 0u, 0u};
          for (size_t i = (size_t)bid * NTHREADS + tid; i < nz; i += (size_t)G * NTHREADS) zp[i] = z4; }
#endif
        p0_prologue(A, lds, tid, (G == 256) ? TR_I1 : TR_ITOT);
        DUPBAR(0);
    }
    SEAM(0);
    if (IN(1)) DUP(1) {
        if (G == 256) { p0_transposes(A, lds, tid, TR_I1, TR_ITOT, 158, 98); __syncthreads(); }
        pg8::StaticOrder so; so.init(TPAD, 2560, G, bid);
        EpiIn e{(bf16_t*)(ws + WS_U), (bf16_t*)(ws + WS_QKV), (bf16_t*)(ws + WS_ZS), A.out};
        pg8::gemm_phase<EpiIn, pg8::StaticOrder, true, true>(ldsg, pg8::Gemm{HN, (const bf16_t*)(ws + WS_W1), TPAD, 2560, 1024}, so, e);
        DUPBAR(1);
    }
    SEAM(1);
    if (IN(2)) DUP(2) {
        for (int u = bid; u < 2880; u += G) {
#ifndef NO_GDNP2
#ifndef P2R_A
#define P2R_A 1
#endif
#ifndef P2R_B
#define P2R_B 1
#endif
#ifndef P2R_C
#define P2R_C 1
#endif
            if (u < 2080) { const int bh = u / NCH, n = u - bh * NCH; for (int rr_ = 0; rr_ < P2R_A; ++rr_) gdn_prep(A, lds, 0, bh >> 2, bh & 3, n, tid); }
            else if (u < 2592) { const int bh = u - 2080; for (int rr_ = 0; rr_ < P2R_B; ++rr_) gdn_prep(A, lds, 1, bh >> 2, bh & 3, 0, tid); }
#endif
#ifndef NO_S5A
            if (u >= 2592 && u < 2848) { const int v = u - 2592, g = v >> 3, b = v & 7; for (int rr_ = 0; rr_ < P2R_C; ++rr_) s5_unit<0>(A, g, b, wave, lane); }
#endif
#ifndef NO_S5D
            if (u >= 2848) { const int v = (u - 2848) * 8 + wave, g = v >> 3, bg = v & 7; if (G * 8 < 2048) s5_decode(A, g, bg * 16, 16, lane); }
#endif
        }
        if (G * 8 >= 2048) for (int v = bid * 8 + wave; v < 2048; v += G * 8) s5_decode(A, v >> 6, (v & 63) * 2, 2, lane);
        DUPBAR(2);
    }
    SEAM(2);
    if (IN(3)) DUP(3) {
        const bool chainwg = (G >= 128) && (bid < 64);
        if (G >= 128) { if (chainwg) gdn_chain2(A, lds, bid >> 3, (bid >> 1) & 3, bid & 1, tid); }
        else if (bid < 32) { gdn_chain<0>(A, lds, bid >> 2, bid & 3, tid); }
        for (int u = bid; u < 256; u += G) { const int g = u >> 3, b = u & 7; s5_unit<1>(A, g, b, wave, lane); }
        __syncthreads();
#ifndef NO_GGEMM
        const bool skipg = chainwg;
        pg8::StaticOrder so; if (G >= 128) so.init(TPAD, 2048, G - 64, bid - 64); else so.init(TPAD, 2048, G, bid);
        EpiGates e{(bf16_t*)(ws + WS_SG)};
#ifndef P3R_GG
#define P3R_GG 1
#endif
        if (!skipg) for (int rr_ = 0; rr_ < P3R_GG; ++rr_) pg8::gemm_phase<EpiGates, pg8::StaticOrder, true, true>(ldsg, pg8::Gemm{HN, (const bf16_t*)(ws + WS_W1) + (size_t)2560 * 1024, TPAD, 2048, 1024}, so, e);
#endif
        DUPBAR(3);
    }
    SEAM(3);
    if (IN(4)) DUP(4) {
        pg8::StaticOrder so; so.init(TPAD, 2048, G, bid);
        if (G >= 128) gdn_finish_rows(A, tid, (67 * 8 > 2 * G && 67 * 8 < 3 * G) ? 67 * 8 - 2 * G : 0);
        EpiGlu e{(const bf16_t*)(ws + WS_SG), (bf16_t*)(ws + WS_SA)};
        pg8::gemm_phase<EpiGlu, pg8::StaticOrder, true, true>(ldsg, pg8::Gemm{GS, (const bf16_t*)(ws + WS_WGLU), TPAD, 2048, 512}, so, e);
        DUPBAR(4);
    }
    SEAM(4);
    if (IN(5)) DUP(5) {
        pg8::StaticOrder so; so.init(TPAD, 1024, G, bid);
        EpiGdnOut e{(const bf16_t*)(ws + WS_SG), (const bf16_t*)(ws + WS_SA), (bf16_t*)(ws + WS_MIXIN)};
        pg8::gemm_phase<EpiGdnOut, pg8::StaticOrder, true, true>(ldsg, pg8::Gemm{(const bf16_t*)((unsigned char*)A.out + DO_ON), (const bf16_t*)(ws + WS_WGO), TPAD, 1024, 512}, so, e);
        DUPBAR(5);
    }
    SEAM(5);
    if (IN(6)) DUP(6) {
        pg8::SplitK2Order so; so.init(TPAD, 1024, G, bid);
        EpiBf16Part e{(bf16_t*)(ws + WS_MIX), (bf16_t*)(ws + WS_MIXB)};
        pg8::gemm_phase<EpiBf16Part, pg8::SplitK2Order, true, true>(ldsg, pg8::Gemm{(const bf16_t*)(ws + WS_MIXIN), (const bf16_t*)(ws + WS_WO), TPAD, 1024, 512, 1024}, so, e);
    }
    SEAM(6);
    if (IN(7)) DUP(7) { p5b_rows(A, tid); DUPBAR(7); }
    SEAM(7);
    if (IN(8)) DUP(8) {
        pg8::StaticOrder so; so.init(TPAD, 5632, G, bid);
        EpiFfnUp e{(bf16_t*)(ws + WS_H)};
        pg8::gemm_phase<EpiFfnUp, pg8::StaticOrder, true, true>(ldsg, pg8::Gemm{(const bf16_t*)(ws + WS_FB), (const bf16_t*)(ws + WS_WGU), TPAD, 5632, 1024}, so, e);
        DUPBAR(8);
    }
    SEAM(8);
    if (IN(9)) DUP(9) {
        pg8::SplitK2Order so; so.init(TPAD, 1024, G, bid);
        EpiBf16Part e{(bf16_t*)(ws + WS_F2), (bf16_t*)(ws + WS_F2B)};
        pg8::gemm_phase<EpiBf16Part, pg8::SplitK2Order, true, true>(ldsg, pg8::Gemm{(const bf16_t*)(ws + WS_H), (const bf16_t*)(ws + WS_WD), TPAD, 1024, DFF / 2, DFF}, so, e);
    }
    SEAM(9);
    if (IN(10)) DUP(10) { p8_rows(A, tid); DUPBAR(10); }
#undef IN
#undef SEAM
}

extern "C" void kernel_launch(void* const* d_in, const int* in_sizes, int n_in, void* d_out, int out_size, void* d_ws, size_t ws_size, hipStream_t stream) {
    static int grid = 0;
    if (grid == 0) {
        int dev = 0, cus = 0, per_cu = 0;
        hipGetDevice(&dev);
        hipDeviceGetAttribute(&cus, hipDeviceAttributeMultiprocessorCount, dev);
        hipFuncSetAttribute((const void*)hybrid_fwd, hipFuncAttributeMaxDynamicSharedMemorySize, LDS_BYTES);
        hipOccupancyMaxActiveBlocksPerMultiprocessor(&per_cu, (const void*)hybrid_fwd, NTHREADS, LDS_BYTES);
        (void)hipGetLastError();
        if (per_cu < 1) per_cu = 1;
        grid = cus * per_cu;
        if (n_in != 31 || ws_size < 256 * MiB) fprintf(stderr, "kernel_launch: unexpected n_in %d / ws %zu\n", n_in, ws_size);
    }
    (void)hipMemsetAsync((unsigned char*)d_ws + WS_BAR, 0, 16384, stream);
    Args a{};
    for (int i = 0; i < 31; ++i) a.in[i] = (const float*)d_in[i];
    a.out = (float*)d_out; a.ws = (unsigned char*)d_ws; a.ph_lo = 0; a.ph_hi = 11;
#ifndef REP3
#define REP3 1
#endif
    a.rep3 = REP3; a.pad_ = 0;
    void* args[] = {&a};
    hipError_t e = hipLaunchCooperativeKernel((const void*)hybrid_fwd, dim3(grid), dim3(NTHREADS), args, LDS_BYTES, stream);
    if (e != hipSuccess) fprintf(stderr, "cooperative launch failed: %s (grid %d)\n", hipGetErrorString(e), grid);
}
```

```cpp
#include <hip/hip_runtime.h>
#include <hip/hip_cooperative_groups.h>
#include <cstdio>
#include <cstdint>
namespace cg = cooperative_groups;
namespace pg8 {
#define PG8_LAS __attribute__((address_space(3)))
typedef unsigned short bf16_t;
typedef short bf16x8 __attribute__((ext_vector_type(8)));
typedef float f32x4 __attribute__((ext_vector_type(4)));
typedef unsigned u32x4 __attribute__((ext_vector_type(4)));
constexpr int BM = 256, BK = 64, HALF = 128, HTB = HALF * BK * 2  , STAGE_BYTES = 8 * HTB, NXCD = 8, WGM = 8;

__host__ __device__ __forceinline__ int lds_byte(int r, int c) { const int st = (r >> 4) * 2 + (c >> 5), rr = r & 15, cc = c & 31, ob = rr * 64 + cc * 2; return st * 1024 + (ob ^ (((ob >> 9) & 1) << 5)); }
__host__ __device__ __forceinline__ void stage_rc(int b, int& R, int& C) { const int st = b / 1024, sb = b % 1024, swz = sb ^ (((sb >> 9) & 1) << 5); R = (st >> 1) * 16 + swz / 64; C = (st & 1) * 32 + (swz % 64) / 2; }
__host__ __device__ __forceinline__ int perm32(int rho) { const int n = rho >> 4, i = rho & 15; return 8 * (i >> 2) + 4 * n + (i & 3); }

struct Unit { int pm, pn, ks; };
struct SplitK2Order {
    int nM, nN, nwg, G, c;
    __host__ __device__ void init(int M, int N, int G_, int c_) { nM = M / BM; nN = N / BM; nwg = nM * nN; G = G_; c = c_; }
    __host__ __device__ bool next(int i, Unit& u) const {
        const long L = (long)i * G + c; if (L >= 2L * nwg) return false;
        int wgid = (int)(L >> 1); { const int q = nwg / NXCD, r = nwg % NXCD, xcd = wgid % NXCD, off = wgid / NXCD; wgid = (xcd < r ? xcd * (q + 1) : r * (q + 1) + (xcd - r) * q) + off; }
        const int nig = WGM * nN, gid = wgid / nig, fm = gid * WGM, gsz = (nM - fm) < WGM ? (nM - fm) : WGM;
        u.pm = fm + ((wgid % nig) % gsz); u.pn = (wgid % nig) / gsz; u.ks = (int)(L & 1); return true;
    }
    __device__ __forceinline__ void a_ready(const Unit&) const {}
    __device__ __forceinline__ void done(const Unit&) const {}
};
struct Gemm { const bf16_t* A; const bf16_t* Bt; int M, N, K; int ld; };
struct StaticOrder {
    int nM, nN, nwg, G, c;
    __host__ __device__ void init(int M, int N, int G_, int c_) { nM = M / BM; nN = N / BM; nwg = nM * nN; G = G_; c = c_; }
    __host__ __device__ bool next(int i, Unit& u) const {
        const long L = (long)i * G + c; if (L >= nwg) return false;
        int wgid = (int)L; { const int q = nwg / NXCD, r = nwg % NXCD, xcd = wgid % NXCD, off = wgid / NXCD; wgid = (xcd < r ? xcd * (q + 1) : r * (q + 1) + (xcd - r) * q) + off; }
        const int nig = WGM * nN, gid = wgid / nig, fm = gid * WGM, gsz = (nM - fm) < WGM ? (nM - fm) : WGM;
        u.pm = fm + ((wgid % nig) % gsz); u.pn = (wgid % nig) / gsz; u.ks = 0; return true;
    }
    __device__ __forceinline__ void a_ready(const Unit&) const {}
    __device__ __forceinline__ void done(const Unit&) const {}
};
__device__ __forceinline__ unsigned cvt_pk_bf16(float lo, float hi) { unsigned r; asm volatile("v_cvt_pk_bf16_f32 %0, %1, %2" : "=v"(r) : "v"(lo), "v"(hi)); return r; }
template <class Epi, class Sched, bool ALIGN_EPI = false, bool SP2 = false>
__device__ __forceinline__ void gemm_phase(PG8_LAS unsigned char* lds, const Gemm g, const Sched& S, const Epi& E) {
    const int tid = threadIdx.x, wid = __builtin_amdgcn_readfirstlane(tid >> 6), lane = tid & 63, wr = wid >> 2, wc = wid & 3, fr = lane & 15, fq = lane >> 4;
    const int K = g.K, nt = K / BK, LD = g.ld ? g.ld : g.K;
    unsigned voffA[2], voffB[2];
#pragma unroll
    for (int i = 0; i < 2; ++i) { int R, C; stage_rc(tid * 16 + i * 8192, R, C); const int Rb = Epi::PERM ? ((R & ~31) + perm32(R & 31)) : R;
        voffA[i] = (unsigned)(R * LD + C) * 2u; voffB[i] = (unsigned)(Rb * LD + C) * 2u; }
    const size_t kstep = (size_t)(BK * 2);
    const size_t hstep = (size_t)HALF * LD * 2;
    const size_t tstep = 2 * hstep;
    const unsigned ldsw = (unsigned)wid * 1024u;
    const int aoff = lds_byte(wr * 64 + fr, fq * 8), boff = lds_byte(wc * 32 + fr, fq * 8);
#define PG8_SA(b, h) (((b) * 2 + (h)) * HTB)
#define PG8_SB(b, h) ((4 + (b) * 2 + (h)) * HTB)
#define PG8_STAGE(bufoff, gbase, voff) do { _Pragma("unroll") for (int _i = 0; _i < 2; ++_i) \
        __builtin_amdgcn_global_load_lds((const unsigned*)((const char*)(gbase) + (voff)[_i]), (PG8_LAS unsigned*)(lds + (bufoff) + ldsw + _i * 8192), 16, 0, 0); } while (0)
#define PG8_LDA(dst, b, h) do { _Pragma("unroll") for (int m = 0; m < 4; ++m) _Pragma("unroll") for (int k = 0; k < 2; ++k) dst[m][k] = *(const PG8_LAS bf16x8*)(lds + PG8_SA(b, h) + aoff + m * 2048 + k * 1024); } while (0)
#define PG8_LDB(dst, b, h) do { _Pragma("unroll") for (int n = 0; n < 2; ++n) _Pragma("unroll") for (int k = 0; k < 2; ++k) dst[n][k] = *(const PG8_LAS bf16x8*)(lds + PG8_SB(b, h) + boff + n * 2048 + k * 1024); } while (0)
#define PG8_MMA(ai, bj, At, Bt) do { __builtin_amdgcn_s_setprio(1); _Pragma("unroll") for (int m = 0; m < 4; ++m) _Pragma("unroll") for (int n = 0; n < 2; ++n) _Pragma("unroll") for (int k = 0; k < 2; ++k) \
        acc[ai][bj][m][n] = __builtin_amdgcn_mfma_f32_16x16x32_bf16(Bt[n][k], At[m][k], acc[ai][bj][m][n], 0, 0, 0); __builtin_amdgcn_s_setprio(0); } while (0)
#define PG8_WAIT_V(n) asm volatile("s_waitcnt vmcnt(" #n ")" ::: "memory")
#define PG8_WAIT_L(n) asm volatile("s_waitcnt lgkmcnt(" #n ")" ::: "memory")
#define PG8_BAR __builtin_amdgcn_s_barrier()
#define PG8_SCHED __builtin_amdgcn_sched_barrier(0)
    Unit cur, nxt; int ui = 0;
    if (!S.next(0, cur)) return;
    f32x4 acc[2][2][4][2];
#pragma unroll
    for (int a = 0; a < 2; ++a)
#pragma unroll
        for (int b = 0; b < 2; ++b)
#pragma unroll
            for (int m = 0; m < 4; ++m)
#pragma unroll
                for (int n = 0; n < 2; ++n) acc[a][b][m][n] = (f32x4){0.f, 0.f, 0.f, 0.f};
    bf16x8 At[4][2], B0[2][2], B1[2][2];
    const size_t kslice = (size_t)K * 2;
    const char* cA = (const char*)g.A + (size_t)cur.pm * tstep + (size_t)cur.ks * kslice; const char* cB = (const char*)g.Bt + (size_t)cur.pn * tstep + (size_t)cur.ks * kslice;
    S.a_ready(cur);
    if constexpr (SP2) {
        PG8_STAGE(PG8_SB(0, 0), cB, voffB); PG8_STAGE(PG8_SB(0, 1), cB + hstep, voffB); PG8_STAGE(PG8_SA(0, 0), cA, voffA); PG8_STAGE(PG8_SA(0, 1), cA + hstep, voffA);
        if (wr == 1) PG8_BAR;
        PG8_WAIT_V(2); PG8_BAR;
        PG8_STAGE(PG8_SB(1, 0), cB + kstep, voffB); PG8_STAGE(PG8_SA(1, 0), cA + kstep, voffA); PG8_STAGE(PG8_SB(1, 1), cB + hstep + kstep, voffB);
        PG8_WAIT_V(6); PG8_BAR;
    } else {
        PG8_STAGE(PG8_SB(0, 0), cB, voffB); PG8_STAGE(PG8_SA(0, 0), cA, voffA); PG8_STAGE(PG8_SB(0, 1), cB + hstep, voffB); PG8_STAGE(PG8_SA(0, 1), cA + hstep, voffA);
        if (wr == 1) PG8_BAR;
        PG8_WAIT_V(4); PG8_BAR;
        PG8_STAGE(PG8_SB(1, 0), cB + kstep, voffB); PG8_STAGE(PG8_SA(1, 0), cA + kstep, voffA); PG8_STAGE(PG8_SB(1, 1), cB + hstep + kstep, voffB);
        PG8_WAIT_V(6); PG8_BAR;
    }
    for (;;) {
        const bool has_next = S.next(ui + 1, nxt);
        const char* nA = has_next ? (const char*)g.A + (size_t)nxt.pm * tstep + (size_t)nxt.ks * kslice : cA; const char* nB = has_next ? (const char*)g.Bt + (size_t)nxt.pn * tstep + (size_t)nxt.ks * kslice : cB;
        for (int t = 0; t < nt; t += 2) {
            const bool last = (t == nt - 2);
            const char* a1 = cA + (size_t)(t + 1) * kstep;
            const char* a2 = last ? nA : cA + (size_t)(t + 2) * kstep; const char* b2 = last ? nB : cB + (size_t)(t + 2) * kstep;
            const char* a3 = a2 + kstep; const char* b3 = b2 + kstep;
            if (last && has_next) S.a_ready(nxt);
            if constexpr (SP2) {
            PG8_LDB(B0, 0, 0); PG8_LDB(B1, 0, 1); PG8_SCHED; PG8_LDA(At, 0, 0); PG8_STAGE(PG8_SA(1, 1), a1 + hstep, voffA);
            PG8_WAIT_V(8); PG8_WAIT_L(0); PG8_BAR; PG8_MMA(0, 0, At, B0); PG8_MMA(0, 1, At, B1); PG8_BAR; PG8_SCHED;
            PG8_LDA(At, 0, 1); PG8_STAGE(PG8_SB(0, 0), b2, voffB); PG8_STAGE(PG8_SB(0, 1), b2 + hstep, voffB); PG8_STAGE(PG8_SA(0, 0), a2, voffA);
            PG8_WAIT_V(8); PG8_WAIT_L(0); PG8_BAR; PG8_MMA(1, 0, At, B0); PG8_MMA(1, 1, At, B1); PG8_BAR; PG8_SCHED;
            PG8_LDB(B0, 1, 0); PG8_LDB(B1, 1, 1); PG8_SCHED; PG8_LDA(At, 1, 0); PG8_STAGE(PG8_SA(0, 1), a2 + hstep, voffA);
            PG8_WAIT_V(8); PG8_WAIT_L(0); PG8_BAR; PG8_MMA(0, 0, At, B0); PG8_MMA(0, 1, At, B1); PG8_BAR; PG8_SCHED;
            PG8_LDA(At, 1, 1); PG8_STAGE(PG8_SB(1, 0), b3, voffB); PG8_STAGE(PG8_SB(1, 1), b3 + hstep, voffB); PG8_STAGE(PG8_SA(1, 0), a3, voffA);
            PG8_WAIT_V(8); PG8_WAIT_L(0); PG8_BAR; PG8_MMA(1, 0, At, B0); PG8_MMA(1, 1, At, B1); PG8_BAR; PG8_SCHED;
            } else {
            PG8_LDB(B0, 0, 0); PG8_SCHED; PG8_LDA(At, 0, 0); PG8_STAGE(PG8_SA(1, 1), a1 + hstep, voffA);
            PG8_WAIT_L(8); PG8_BAR; PG8_WAIT_L(0); PG8_MMA(0, 0, At, B0); PG8_BAR; PG8_SCHED;
            PG8_LDB(B1, 0, 1); PG8_STAGE(PG8_SB(0, 0), b2, voffB);
            PG8_BAR; PG8_WAIT_L(0); PG8_MMA(0, 1, At, B1); PG8_BAR;
            PG8_LDA(At, 0, 1); PG8_STAGE(PG8_SA(0, 0), a2, voffA);
            PG8_BAR; PG8_WAIT_L(0); PG8_MMA(1, 0, At, B0); PG8_BAR; PG8_SCHED;
            PG8_STAGE(PG8_SB(0, 1), b2 + hstep, voffB);
            PG8_WAIT_V(6); PG8_BAR; PG8_MMA(1, 1, At, B1); PG8_BAR;
            PG8_LDB(B0, 1, 0); PG8_SCHED; PG8_LDA(At, 1, 0); PG8_STAGE(PG8_SA(0, 1), a2 + hstep, voffA);
            PG8_WAIT_L(8); PG8_BAR; PG8_WAIT_L(0); PG8_MMA(0, 0, At, B0); PG8_BAR; PG8_SCHED;
            PG8_LDB(B1, 1, 1); PG8_STAGE(PG8_SB(1, 0), b3, voffB);
            PG8_BAR; PG8_WAIT_L(0); PG8_MMA(0, 1, At, B1); PG8_BAR;
            PG8_LDA(At, 1, 1); PG8_STAGE(PG8_SA(1, 0), a3, voffA);
            PG8_BAR; PG8_WAIT_L(0); PG8_MMA(1, 0, At, B0); PG8_BAR; PG8_SCHED;
            PG8_STAGE(PG8_SB(1, 1), b3 + hstep, voffB);
            PG8_WAIT_V(6); PG8_BAR; PG8_MMA(1, 1, At, B1); PG8_BAR;
            }
        }
        if constexpr (ALIGN_EPI) { if (wr == 0) PG8_BAR; }
        if constexpr (!Epi::AFTER_DRAIN) { E(acc, cur, wr, wc, fr, fq); S.done(cur); }
        if (!has_next) break;
#pragma unroll
        for (int a = 0; a < 2; ++a)
#pragma unroll
            for (int b = 0; b < 2; ++b)
#pragma unroll
                for (int m = 0; m < 4; ++m)
#pragma unroll
                    for (int n = 0; n < 2; ++n) acc[a][b][m][n] = (f32x4){0.f, 0.f, 0.f, 0.f};
        cur = nxt; cA = nA; cB = nB; ++ui;
        if constexpr (ALIGN_EPI) { if (wr == 1) PG8_BAR; }
    }
    PG8_WAIT_V(0);
    if constexpr (!ALIGN_EPI) { if (wr == 0) PG8_BAR; }
    PG8_BAR;
    if constexpr (Epi::AFTER_DRAIN) { E.fused(acc, cur, wr, wc, fr, fq, lds, wid, lane); S.done(cur); }
#undef PG8_SA
#undef PG8_SB
#undef PG8_STAGE
#undef PG8_LDA
#undef PG8_LDB
#undef PG8_MMA
#undef PG8_WAIT_V
#undef PG8_WAIT_L
#undef PG8_BAR
#undef PG8_SCHED
}
}

using pg8::bf16_t; using pg8::bf16x8; using pg8::f32x4; using pg8::u32x4;
typedef unsigned u32x2 __attribute__((ext_vector_type(2)));
typedef float f32x2 __attribute__((ext_vector_type(2)));
#define LDSP __attribute__((address_space(3)))

constexpr int DM = 1024, NB = 8, SEQ = 2048, NMETA = 16, LP = SEQ + NMETA, DB = 128, DS = 4;
constexpr int TPR = NB * LP;
constexpr int T = TPR + DB * DS;
constexpr int TPAD = 17152;
constexpr int S5W = 512, S5G = 32, S5P = 64;
constexpr int GH = 4, QKVW = 1536, DFF = 2816, INW = 4616;
constexpr float EPS = 1e-6f;
constexpr int NTHREADS = 512;
constexpr int LDS_BYTES = 163840;

constexpr size_t O_YP = 0, O_YS = 16777216, O_PRE = 17301504, O_PIM = 17317888, O_PGDN = 17334272, O_PCONV = 17858560,
                 O_SRE = 17895424, O_SIM = 18157568, O_SGDN = 18419712, O_SCONV = 26808320;
constexpr size_t DO_ON = 0, DO_GS = (size_t)TPAD * 512 * 2;
constexpr size_t MiB = 1u << 20;
constexpr size_t WS_W1 = 0, WS_WGLU = WS_W1 + (size_t)4608 * 1024 * 2, WS_WGO = WS_WGLU + (size_t)2048 * 512 * 2, WS_WO = WS_WGO + (size_t)1024 * 512 * 2,
                 WS_WGU = WS_WO + (size_t)1024 * 1024 * 2, WS_WD = WS_WGU + (size_t)5632 * 1024 * 2, WS_WEND = WS_WD + (size_t)1024 * 2816 * 2;
static_assert(WS_WEND <= 31 * MiB - 512 * 1024, "weights");
constexpr size_t WS_AB = 31 * MiB - 512 * 1024;
constexpr size_t WS_S5A = WS_AB + 640 * 1024;
constexpr size_t WS_S5C = WS_S5A + 262144;
constexpr size_t WS_S5K = WS_S5C + 131072;
constexpr size_t WS_S5ADV = WS_S5K + 1310720;
constexpr size_t WS_S5END = WS_S5ADV + 16384;
constexpr size_t WS_SSQ = WS_S5END + 1048576;
constexpr size_t WS_SSQ2 = WS_SSQ + 1089536;
constexpr size_t WS_BAR = 36 * MiB - 16384;
static_assert(WS_SSQ2 + 1089536 <= WS_BAR, "small region");
constexpr size_t WS_B = 36 * MiB;
constexpr size_t WS_C = 113 * MiB;
constexpr size_t WS_REC = WS_B, WS_SA = WS_B, WS_MIXIN = 70 * MiB, WS_FB = WS_B, WS_F2 = WS_B, WS_F2B = 70 * MiB;
constexpr size_t WS_QKV = WS_C, WS_SG = WS_C, WS_MIX = WS_C, WS_MIXB = WS_C + 34 * MiB, WS_H = WS_C;
constexpr size_t WS_U = 180 * MiB, WS_ZS = 197 * MiB, WS_HN = 214 * MiB;
static_assert(WS_SA + (size_t)T * 1024 * 2 <= WS_MIXIN && WS_MIXIN + (size_t)TPAD * 1024 * 2 <= WS_C, "B");
static_assert(WS_SG + (size_t)T * 2048 * 2 <= WS_U && WS_U + (size_t)T * 512 * 2 <= WS_ZS && WS_ZS + (size_t)T * 512 * 2 <= WS_HN, "C/D");
static_assert(WS_H + (size_t)TPAD * DFF * 2 <= WS_HN && WS_HN + (size_t)TPAD * 1024 * 2 <= 256 * MiB, "H/HN");

constexpr int CT = 32, NCH = 65;
constexpr int IMG_WN = 0, IMG_QD = 8704, IMG_KDT = 17408, IMG_QK = 27648, IMG_HDR = 30208, IMG_BYTES = 30272;
constexpr int REC_U = IMG_BYTES, REC_BYTES = IMG_BYTES + 8192 + 64;
constexpr int IMG_V4 = IMG_BYTES / 16;
static_assert(WS_REC + (size_t)32 * NCH * REC_BYTES <= WS_C, "rec");
constexpr int L_OPK = 0, L_OPKB = 8704, L_OPQ = 17408, L_MX = 30272, L_GC = 34880, L_BETA = 35008, L_EG = 35136, L_EGLK = 35264, L_SSQ = 35392,
              L_ULDS = 36864, L_PART = 45056, L_RED = 46080;
constexpr int LC_BUF0 = 0, LC_BUF1 = IMG_BYTES, LC_PART = 2 * IMG_BYTES;

struct Args { const float* in[31]; float* out; unsigned char* ws; int ph_lo, ph_hi; int rep3, pad_; };

typedef __bf16 bf16x2_t __attribute__((ext_vector_type(2)));
__device__ __forceinline__ unsigned pk2(float lo, float hi) { const f32x2 v = {lo, hi}; return __builtin_bit_cast(unsigned, __builtin_convertvector(v, bf16x2_t)); }
__device__ __forceinline__ unsigned short f2bf(float f) { return (unsigned short)(pk2(f, 0.f) & 0xffffu); }
__device__ __forceinline__ float bf2f(unsigned short b) { return __builtin_bit_cast(float, (unsigned)b << 16); }
__device__ __forceinline__ float bflo(unsigned w) { return __builtin_bit_cast(float, w << 16); }
__device__ __forceinline__ float bfhi(unsigned w) { return __builtin_bit_cast(float, w & 0xffff0000u); }
__device__ __forceinline__ float sigmoidf_(float x) { return 1.0f / (1.0f + __expf(-x)); }
__device__ __forceinline__ float siluf_(float x) { return x / (1.0f + __expf(-x)); }
__device__ __forceinline__ float geluf_(float x) { const float u = 1.5957691216057308f * (x + 0.044715f * x * x * x); return x / (1.0f + __expf(-u)); }
template <int CTRL> __device__ __forceinline__ float dpp0(float v) {
    return __builtin_bit_cast(float, __builtin_amdgcn_update_dpp(0, __builtin_bit_cast(int, v), CTRL, 0xF, 0xF, true));
}
__device__ __forceinline__ float row16_sum(float v) {
    v += dpp0<0xB1>(v); v += dpp0<0x4E>(v); v += dpp0<0x141>(v); v += dpp0<0x140>(v); return v;
}
__device__ __forceinline__ float wave_sum(float v) { v = row16_sum(v); v += __shfl_xor(v, 16); v += __shfl_xor(v, 32); return v; }
__device__ __forceinline__ bf16x8 pack8(const f32x4& a, const f32x4& b) {
    u32x4 w; w.x = pk2(a[0], a[1]); w.y = pk2(a[2], a[3]); w.z = pk2(b[0], b[1]); w.w = pk2(b[2], b[3]); return __builtin_bit_cast(bf16x8, w);
}
__device__ __forceinline__ int pos32(int d) { return (d >> 5) * 32 + ((d >> 2) & 3) * 8 + ((d >> 4) & 1) * 4 + (d & 3); }
__device__ __forceinline__ f32x4 mfma16(const bf16x8& a, const bf16x8& b, const f32x4& c) { return __builtin_amdgcn_mfma_f32_16x16x32_bf16(a, b, c, 0, 0, 0); }

__device__ __forceinline__ void lds_barrier() { asm volatile("s_waitcnt lgkmcnt(0)" ::: "memory"); __builtin_amdgcn_s_barrier(); asm volatile("" ::: "memory"); }
__device__ __forceinline__ const float* x_row_ptr(const Args& A, int r) {
    if (r < TPR) { const int b = r / LP, t = r - b * LP; return t < NMETA ? A.in[6] + (size_t)t * DM : A.in[0] + ((size_t)b * SEQ + (t - NMETA)) * DM; }
    return A.in[1] + (size_t)(r - TPR) * DM;
}
__device__ __forceinline__ float* y_row_ptr(const Args& A, int r) {
    if (r < TPR) { const int b = r / LP, t = r - b * LP; return t < NMETA ? nullptr : A.out + O_YP + ((size_t)b * SEQ + (t - NMETA)) * DM; }
    return A.out + O_YS + (size_t)(r - TPR) * DM;
}

#define EPI_LOOP4 _Pragma("unroll") for (int ai = 0; ai < 2; ++ai) _Pragma("unroll") for (int m = 0; m < 4; ++m)
struct EpiIn {
    static constexpr bool PERM = false, AFTER_DRAIN = false;
    bf16_t* U; bf16_t* QKV; bf16_t* ZS; float* out;
    __device__ __forceinline__ void operator()(const f32x4 (&acc)[2][2][4][2], const pg8::Unit& u, int wr, int wc, int fr, int fq) const {
        const int pn = u.pn;
        EPI_LOOP4 {
            const int r = u.pm * 256 + ai * 128 + wr * 64 + m * 16 + fr;
            if (r >= T) continue;
            float* cdst = nullptr;
            if (pn >= 2 && pn < 8) {
                if (r < TPR) { const int b = r / LP, t = r - b * LP; if (t >= LP - 3) cdst = out + O_PCONV + ((size_t)b * 3 + (t - (LP - 3))) * QKVW; }
                else { const int rr = r - TPR, b = rr >> 2, t = rr & 3; if (t >= 1) cdst = out + O_SCONV + ((size_t)b * 3 + (t - 1)) * QKVW; }
            }
#pragma unroll
            for (int bj = 0; bj < 2; ++bj)
#pragma unroll
                for (int n = 0; n < 2; ++n) {
                    const int c = pn * 256 + bj * 128 + wc * 32 + n * 16 + fq * 4; const f32x4 v = acc[ai][bj][m][n];
                    if (pn < 2) { u32x2 w; w.x = pk2(v[0], v[1]); w.y = pk2(v[2], v[3]); *(u32x2*)(U + (size_t)r * 512 + c) = w; }
                    else if (pn < 8) { u32x2 w; w.x = pk2(v[0], v[1]); w.y = pk2(v[2], v[3]); *(u32x2*)(QKV + (size_t)r * QKVW + (c - 512)) = w;
                        if (cdst) *(f32x4*)(cdst + (c - 512)) = v; }
                    else { u32x2 w; w.x = pk2(siluf_(v[0]), siluf_(v[1])); w.y = pk2(siluf_(v[2]), siluf_(v[3])); *(u32x2*)(ZS + (size_t)r * 512 + (c - 2048)) = w; }
                }
        }
    }
};
struct EpiGates {
    static constexpr bool PERM = false, AFTER_DRAIN = false;
    bf16_t* SG;
    __device__ __forceinline__ void operator()(const f32x4 (&acc)[2][2][4][2], const pg8::Unit& u, int wr, int wc, int fr, int fq) const {
        EPI_LOOP4 {
            const int r = u.pm * 256 + ai * 128 + wr * 64 + m * 16 + fr;
            if (r >= T) continue;
#pragma unroll
            for (int bj = 0; bj < 2; ++bj)
#pragma unroll
                for (int n = 0; n < 2; ++n) {
                    const int c = u.pn * 256 + bj * 128 + wc * 32 + n * 16 + fq * 4; const f32x4 v = acc[ai][bj][m][n];
                    u32x2 w; w.x = pk2(sigmoidf_(v[0]), sigmoidf_(v[1])); w.y = pk2(sigmoidf_(v[2]), sigmoidf_(v[3])); *(u32x2*)(SG + (size_t)r * 2048 + c) = w;
                }
        }
    }
};
struct EpiGlu {
    static constexpr bool PERM = false, AFTER_DRAIN = false;
    const bf16_t* SG; bf16_t* SA;
    __device__ __forceinline__ void operator()(const f32x4 (&acc)[2][2][4][2], const pg8::Unit& u, int wr, int wc, int fr, int fq) const {
        EPI_LOOP4 {
            const int r = u.pm * 256 + ai * 128 + wr * 64 + m * 16 + fr;
            if (r >= T) continue;
#pragma unroll
            for (int n = 0; n < 2; ++n) {
                const int c = u.pn * 128 + wc * 32 + n * 16 + fq * 4; const f32x4 a = acc[ai][0][m][n], b = acc[ai][1][m][n];
                const u32x2 g = *(const u32x2*)(SG + (size_t)r * 2048 + c);
                u32x2 w; w.x = pk2(bflo(g.x) * a[0] * sigmoidf_(b[0]), bfhi(g.x) * a[1] * sigmoidf_(b[1]));
                w.y = pk2(bflo(g.y) * a[2] * sigmoidf_(b[2]), bfhi(g.y) * a[3] * sigmoidf_(b[3]));
                *(u32x2*)(SA + (size_t)r * 1024 + c) = w;
            }
        }
    }
};
struct EpiGdnOut {
    static constexpr bool PERM = false, AFTER_DRAIN = false;
    const bf16_t* SG; const bf16_t* SA; bf16_t* MIXIN;
    __device__ __forceinline__ void operator()(const f32x4 (&acc)[2][2][4][2], const pg8::Unit& u, int wr, int wc, int fr, int fq) const {
        EPI_LOOP4 {
            const int r = u.pm * 256 + ai * 128 + wr * 64 + m * 16 + fr;
            if (r >= T) continue;
#pragma unroll
            for (int bj = 0; bj < 2; ++bj)
#pragma unroll
                for (int n = 0; n < 2; ++n) {
                    const int c = u.pn * 256 + bj * 128 + wc * 32 + n * 16 + fq * 4; const f32x4 v = acc[ai][bj][m][n];
                    const u32x2 g = *(const u32x2*)(SG + (size_t)r * 2048 + 1024 + c); const u32x2 s = *(const u32x2*)(SA + (size_t)r * 1024 + c);
                    u32x2 w; w.x = pk2(bflo(s.x) + bflo(g.x) * v[0], bfhi(s.x) + bfhi(g.x) * v[1]); w.y = pk2(bflo(s.y) + bflo(g.y) * v[2], bfhi(s.y) + bfhi(g.y) * v[3]);
                    *(u32x2*)(MIXIN + (size_t)r * 1024 + c) = w;
                }
        }
    }
};
struct EpiF32Ssq {
    static constexpr bool PERM = false, AFTER_DRAIN = false;
    float* O; float* SSQ;
    __device__ __forceinline__ void operator()(const f32x4 (&acc)[2][2][4][2], const pg8::Unit& u, int wr, int wc, int fr, int fq) const {
        EPI_LOOP4 {
            const int r = u.pm * 256 + ai * 128 + wr * 64 + m * 16 + fr;
            float ss = 0.f;
#pragma unroll
            for (int bj = 0; bj < 2; ++bj)
#pragma unroll
                for (int n = 0; n < 2; ++n) {
                    const int c = u.pn * 256 + bj * 128 + wc * 32 + n * 16 + fq * 4; const f32x4 v = acc[ai][bj][m][n];
                    ss += (v[0] * v[0] + v[1] * v[1]) + (v[2] * v[2] + v[3] * v[3]);
                    if (r < T) *(f32x4*)(O + (size_t)r * 1024 + c) = v;
                }
            ss += __shfl_xor(ss, 16); ss += __shfl_xor(ss, 32);
            if (fq == 0 && r < T) SSQ[((size_t)u.pn * T + r) * 4 + wc] = ss;
        }
    }
};
struct EpiBf16Part {
    static constexpr bool PERM = false, AFTER_DRAIN = false;
    bf16_t* O0; bf16_t* O1;
    __device__ __forceinline__ void operator()(const f32x4 (&acc)[2][2][4][2], const pg8::Unit& u, int wr, int wc, int fr, int fq) const {
        bf16_t* O = u.ks ? O1 : O0;
        EPI_LOOP4 {
            const int r = u.pm * 256 + ai * 128 + wr * 64 + m * 16 + fr;
            if (r >= T) continue;
#pragma unroll
            for (int bj = 0; bj < 2; ++bj)
#pragma unroll
                for (int n = 0; n < 2; ++n) {
                    const int c = u.pn * 256 + bj * 128 + wc * 32 + n * 16 + fq * 4; const f32x4 v = acc[ai][bj][m][n];
                    u32x2 w; w.x = pk2(v[0], v[1]); w.y = pk2(v[2], v[3]); *(u32x2*)(O + (size_t)r * 1024 + c) = w;
                }
        }
    }
};
struct EpiFfnUp {
    static constexpr bool PERM = false, AFTER_DRAIN = false;
    bf16_t* H;
    __device__ __forceinline__ void operator()(const f32x4 (&acc)[2][2][4][2], const pg8::Unit& u, int wr, int wc, int fr, int fq) const {
        EPI_LOOP4 {
            const int r = u.pm * 256 + ai * 128 + wr * 64 + m * 16 + fr;
            if (r >= T) continue;
#pragma unroll
            for (int n = 0; n < 2; ++n) {
                const int c = u.pn * 128 + wc * 32 + n * 16 + fq * 4; const f32x4 g = acc[ai][0][m][n], v = acc[ai][1][m][n];
                u32x2 w; w.x = pk2(siluf_(g[0]) * v[0], siluf_(g[1]) * v[1]); w.y = pk2(siluf_(g[2]) * v[2], siluf_(g[3]) * v[3]);
                *(u32x2*)(H + (size_t)r * DFF + c) = w;
            }
        }
    }
};
#define LAS __attribute__((address_space(3)))
#define XB_TMO      128
#define XB_XCNT(j)  (256  + 64 * (j))
#define XB_XSUB(j)  (1280 + 64 * (j))
#define XB_XGEN(j)  (2304 + 64 * (j))
#define XB_TOP      3328
#define XB_TOPGEN   3392
#define XCD_BAR_WORDS 3456
#define XB_SPIN_CAP (1u << 18)

__device__ __forceinline__ unsigned xb_ld(unsigned* p)              { return __hip_atomic_load(p, __ATOMIC_RELAXED, __HIP_MEMORY_SCOPE_AGENT); }
__device__ __forceinline__ unsigned xb_add(unsigned* p, unsigned v) { return __hip_atomic_fetch_add(p, v, __ATOMIC_RELAXED, __HIP_MEMORY_SCOPE_AGENT); }
__device__ __forceinline__ unsigned xb_xcc_id() { return (unsigned)__builtin_amdgcn_s_getreg((3 << 11) | 20) & 0xFu; }
#define XB_SPIN(cond, bar) do { unsigned _sp = 0; while (cond) { __builtin_amdgcn_s_sleep(1); \
    if ((++_sp & 255u) == 0u) { if (xb_ld(&(bar)[XB_TMO])) break; if (_sp > XB_SPIN_CAP) { atomicAdd(&(bar)[XB_TMO], 1u); break; } } } } while (0)

struct XcdBarrier {
    unsigned* bar; unsigned x;
    volatile LAS unsigned* st;
};

__device__ __forceinline__ XcdBarrier xcd_barrier_post(unsigned* bar, volatile LAS unsigned* st) {
    XcdBarrier b; b.bar = bar; b.x = xb_xcc_id(); b.st = st;
    if (threadIdx.x == 0) (void)xb_add(&bar[XB_XCNT(b.x)], 1u);
    return b;
}
__device__ __forceinline__ void xcd_barrier_complete(unsigned* bar, unsigned x, unsigned& nloc, unsigned& nx) {
    const unsigned G = gridDim.x * gridDim.y * gridDim.z;
    unsigned sum, cnt, mine, sp = 0u;
    for (;;) {
        sum = 0u; cnt = 0u; mine = 0u;
#pragma unroll
        for (unsigned j = 0; j < 16; ++j) { const unsigned c = xb_ld(&bar[XB_XCNT(j)]); sum += c; cnt += (c > 0u) ? 1u : 0u; mine = (j == x) ? c : mine; }
        if (sum == G) break;
        __builtin_amdgcn_s_sleep(1);
        if ((++sp & 255u) == 0u) { if (xb_ld(&bar[XB_TMO])) break; if (sp > XB_SPIN_CAP) { atomicAdd(&bar[XB_TMO], 1u); break; } }
    }
    nloc = mine > 0u ? mine : 1u; nx = cnt > 0u ? cnt : 1u;
}

__device__ __forceinline__ void xcd_barrier(const XcdBarrier& b) {
    asm volatile("s_waitcnt vmcnt(0)" ::: "memory");
    __syncthreads();
    if (threadIdx.x == 0) {
        unsigned* bar = b.bar;
        __builtin_amdgcn_s_waitcnt(0);
        unsigned nloc = b.st[0], nx = b.st[1];
        if (nloc == 0u) { xcd_barrier_complete(bar, b.x, nloc, nx); b.st[0] = nloc; b.st[1] = nx; }
        const unsigned old = xb_add(&bar[XB_XSUB(b.x)], 1u);
        const unsigned gen = old / nloc;
        if (old + 1u == (gen + 1u) * nloc) {
            __builtin_amdgcn_fence(__ATOMIC_RELEASE, "agent");
            asm volatile("s_waitcnt vmcnt(0)" ::: "memory");
            const unsigned og = xb_add(&bar[XB_TOP], 1u);
            const unsigned tg = og / nx;
            if (og + 1u == (tg + 1u) * nx) xb_add(&bar[XB_TOPGEN], 1u);
            else XB_SPIN(xb_ld(&bar[XB_TOPGEN]) == tg, bar);
            __builtin_amdgcn_fence(__ATOMIC_ACQUIRE, "agent");
            xb_add(&bar[XB_XGEN(b.x)], 1u);
            asm volatile("s_waitcnt vmcnt(0)" ::: "memory");
        } else {
            XB_SPIN(xb_ld(&bar[XB_XGEN(b.x)]) == gen, bar);
            __builtin_amdgcn_fence(__ATOMIC_ACQUIRE, "agent");
            asm volatile("s_waitcnt vmcnt(0)" ::: "memory");
        }
    }
    __syncthreads();
}

__device__ __forceinline__ void transpose_item(const float* src, int ld, int col0, int k0, bf16_t* dst, int K, int drow0, float* tile, int tid) {
    {
        const int k = tid >> 3, n8 = (tid & 7) * 8;
        const f32x4 a = *(const f32x4*)(src + (size_t)(k0 + k) * ld + col0 + n8), b = *(const f32x4*)(src + (size_t)(k0 + k) * ld + col0 + n8 + 4);
        float* tp = tile + k * 65 + n8;
        tp[0] = a[0]; tp[1] = a[1]; tp[2] = a[2]; tp[3] = a[3]; tp[4] = b[0]; tp[5] = b[1]; tp[6] = b[2]; tp[7] = b[3];
    }
    __syncthreads();
    {
        const int n = tid >> 3, k8 = (tid & 7) * 8; const float* tp = tile + k8 * 65 + n;
        u32x4 w; w.x = pk2(tp[0], tp[65]); w.y = pk2(tp[130], tp[195]); w.z = pk2(tp[260], tp[325]); w.w = pk2(tp[390], tp[455]);
        *(u32x4*)(dst + (size_t)(drow0 + n) * K + k0 + k8) = w;
    }
    __syncthreads();
}

__device__ __forceinline__ void cpow_(float lr, float li, float dt, int k, float& re, float& im) {
    const float mag = expf((float)k * lr * dt);
    double rev = (double)k * (double)li * (double)dt * 0.15915494309189535; rev -= rint(rev);
    const float rf = (float)rev;
    re = mag * __builtin_amdgcn_cosf(rf); im = mag * __builtin_amdgcn_sinf(rf);
}

__device__ __forceinline__ void p0_transposes(const Args& A, unsigned char* lds, int tid, int it_lo, int it_hi, int blk0, int nblk) {
    unsigned char* ws = A.ws;
    const int bid = (int)blockIdx.x - blk0; if (bid < 0 || bid >= nblk) return;
    const int G = nblk;
    float* tile = (float*)lds;
    constexpr int I1 = 72 * 16, I2 = 32 * 8, I3 = 16 * 8, I4 = 16 * 16, I5 = 88 * 16;
    struct TI { const float* src; int ld, col0, k0; bf16_t* dst; int K, drow0; };
    auto item = [&](int it) -> TI {
        int r = it;
        if (r < I1) { const int nb = r >> 4, kb = r & 15, n0 = nb * 64; return TI{A.in[11], INW, n0 < 2560 ? n0 : n0 + 8, kb * 64, (bf16_t*)(ws + WS_W1), 1024, n0}; } r -= I1;
        if (r < I2) { const int nb = r >> 3, kb = r & 7, n0 = nb * 64, pn = n0 >> 8, j = n0 & 255; return TI{j < 128 ? A.in[20] : A.in[21], 1024, pn * 128 + (j & 127), kb * 64, (bf16_t*)(ws + WS_WGLU), 512, n0}; } r -= I2;
        if (r < I3) { const int nb = r >> 3, kb = r & 7; return TI{A.in[26], 1024, nb * 64, kb * 64, (bf16_t*)(ws + WS_WGO), 512, nb * 64}; } r -= I3;
        if (r < I4) { const int nb = r >> 4, kb = r & 15; return TI{A.in[27], 1024, nb * 64, kb * 64, (bf16_t*)(ws + WS_WO), 1024, nb * 64}; } r -= I4;
        if (r < I5) { const int nb = r >> 4, kb = r & 15, n0 = nb * 64, pn = n0 >> 8, j = n0 & 255; return TI{j < 128 ? A.in[28] : A.in[29], DFF, pn * 128 + (j & 127), kb * 64, (bf16_t*)(ws + WS_WGU), 1024, n0}; } r -= I5;
        const int nb = r / 44, kb = r - nb * 44; return TI{A.in[30], 1024, nb * 64, kb * 64, (bf16_t*)(ws + WS_WD), DFF, nb * 64};
    };
    float* tile2 = (float*)(lds + 65536);
    for (int it = it_lo + bid; it < it_hi; it += 2 * G) {
        const bool two = it + G < it_hi;
        const TI t0 = item(it), t1 = item(two ? it + G : it);
        {
            const int k = tid >> 3, n8 = (tid & 7) * 8;
            const f32x4 a0 = *(const f32x4*)(t0.src + (size_t)(t0.k0 + k) * t0.ld + t0.col0 + n8), b0 = *(const f32x4*)(t0.src + (size_t)(t0.k0 + k) * t0.ld + t0.col0 + n8 + 4);
            const f32x4 a1 = *(const f32x4*)(t1.src + (size_t)(t1.k0 + k) * t1.ld + t1.col0 + n8), b1 = *(const f32x4*)(t1.src + (size_t)(t1.k0 + k) * t1.ld + t1.col0 + n8 + 4);
            float* tp = tile + k * 65 + n8; tp[0] = a0[0]; tp[1] = a0[1]; tp[2] = a0[2]; tp[3] = a0[3]; tp[4] = b0[0]; tp[5] = b0[1]; tp[6] = b0[2]; tp[7] = b0[3];
            float* tq = tile2 + k * 65 + n8; tq[0] = a1[0]; tq[1] = a1[1]; tq[2] = a1[2]; tq[3] = a1[3]; tq[4] = b1[0]; tq[5] = b1[1]; tq[6] = b1[2]; tq[7] = b1[3];
        }
        __syncthreads();
        {
            const int n = tid >> 3, k8 = (tid & 7) * 8; const float* tp = tile + k8 * 65 + n; const float* tq = tile2 + k8 * 65 + n;
            u32x4 w; w.x = pk2(tp[0], tp[65]); w.y = pk2(tp[130], tp[195]); w.z = pk2(tp[260], tp[325]); w.w = pk2(tp[390], tp[455]);
            *(u32x4*)(t0.dst + (size_t)(t0.drow0 + n) * t0.K + t0.k0 + k8) = w;
            if (two) { u32x4 v; v.x = pk2(tq[0], tq[65]); v.y = pk2(tq[130], tq[195]); v.z = pk2(tq[260], tq[325]); v.w = pk2(tq[390], tq[455]);
                *(u32x4*)(t1.dst + (size_t)(t1.drow0 + n) * t1.K + t1.k0 + k8) = v; }
        }
        __syncthreads();
    }
}
constexpr int TR_I1 = 72 * 16, TR_ITOT = 72 * 16 + 32 * 8 + 16 * 8 + 16 * 16 + 88 * 16 + 16 * 44;

__device__ __forceinline__ void p0_prologue(const Args& A, unsigned char* lds, int tid, int tr_hi) {
    unsigned char* ws = A.ws;
    const int G = gridDim.x, bid = blockIdx.x;
    float* wab = (float*)(lds + 20480);
    p0_transposes(A, lds, tid, 0, tr_hi, 0, G);
    {
        const int gt = bid * NTHREADS + tid, NT = G * NTHREADS;
        const float* Are = A.in[12]; const float* Aim = A.in[13]; const float* Bre = A.in[14]; const float* Bim = A.in[15];
        const float* Cre = A.in[16]; const float* Cim = A.in[17]; const float* ldt = A.in[18];
        for (int e = gt; e < 32 * 8 * 64; e += NT) {
            const int g = e >> 9, tile_ = (e >> 6) & 7, lane = e & 63, q = lane >> 4, r = lane & 15;
            const float dt = expf(ldt[g]);
            {
                const int pp = tile_ * 16 + r, st = pp >> 1, part = pp & 1;
                const float lr = Are[g * 64 + st], li = Aim[g * 64 + st];
                float ar, ai; cpow_(lr, li, dt, 1, ar, ai);
                const float nr = ar - 1.f, ni = ai, den = 1.f / (lr * lr + li * li);
                const float cr = (nr * lr + ni * li) * den, ci = (ni * lr - nr * li) * den;
                float v[8];
#pragma unroll
                for (int j = 0; j < 8; ++j) {
                    if (q < 2) { const int c = q * 8 + j; const float br = Bre[(g * 64 + st) * 16 + c], bi = Bim[(g * 64 + st) * 16 + c];
                        v[j] = part == 0 ? (cr * br - ci * bi) : (cr * bi + ci * br); } else v[j] = 0.f;
                }
                u32x4 w; w.x = pk2(v[0], v[1]); w.y = pk2(v[2], v[3]); w.z = pk2(v[4], v[5]); w.w = pk2(v[6], v[7]);
                *(u32x4*)(ws + WS_S5A + (size_t)e * 16) = w;
            }
            {
                float* kd = (float*)(ws + WS_S5K) + (size_t)e * 20;
#pragma unroll
                for (int s = 0; s < 2; ++s) {
                    const int st = tile_ * 8 + q * 2 + s; const float lr = Are[g * 64 + st], li = Aim[g * 64 + st];
                    float re, im;
                    cpow_(lr, li, dt, -r, re, im); kd[s * 6 + 0] = re; kd[s * 6 + 1] = im;
                    cpow_(lr, li, dt, r, re, im); kd[s * 6 + 2] = re; kd[s * 6 + 3] = im;
                    cpow_(lr, li, dt, r + 1, re, im); kd[s * 6 + 4] = re; kd[s * 6 + 5] = im;
                }
            }
            if (r == 0) {
                f32x4 o;
                { const int st = tile_ * 8 + q * 2; float re, im; cpow_(Are[g * 64 + st], Aim[g * 64 + st], dt, 256, re, im); o[0] = re; o[1] = im; }
                { const int st = tile_ * 8 + q * 2 + 1; float re, im; cpow_(Are[g * 64 + st], Aim[g * 64 + st], dt, 256, re, im); o[2] = re; o[3] = im; }
                *(f32x4*)(ws + WS_S5ADV + (size_t)((g * 8 + tile_) * 4 + q) * 16) = o;
            }
            if (tile_ < 4) {
                const int pair = tile_; float v[8];
#pragma unroll
                for (int jj = 0; jj < 8; ++jj) { const int pp = (2 * pair + (jj >> 2)) * 16 + q * 4 + (jj & 3), st = pp >> 1;
                    v[jj] = (pp & 1) ? -Cim[(g * 16 + r) * 64 + st] : Cre[(g * 16 + r) * 64 + st]; }
                u32x4 w; w.x = pk2(v[0], v[1]); w.y = pk2(v[2], v[3]); w.z = pk2(v[4], v[5]); w.w = pk2(v[6], v[7]);
                *(u32x4*)(ws + WS_S5C + (size_t)((g * 4 + pair) * 64 + lane) * 16) = w;
            }
        }
    }
    {
        for (int idx = tid; idx < 8192; idx += NTHREADS) { const int k = idx >> 3, o = idx & 7; wab[o * 1024 + k] = A.in[11][(size_t)k * INW + 2560 + o]; }
        __syncthreads();
        const int wave = tid >> 6, lane = tid & 63;
        bf16_t* HN = (bf16_t*)(A.ws + WS_HN); float* AB = (float*)(ws + WS_AB);
        const float* gw = A.in[7];
        f32x4 gv[4];
#pragma unroll
        for (int j = 0; j < 4; ++j) gv[j] = *(const f32x4*)(gw + 4 * lane + 256 * j);
        for (int r0 = bid * 8 + wave; r0 < T; r0 += G * 16) {
            int rr[2] = {r0, r0 + G * 8}; const bool has1 = rr[1] < T; if (!has1) rr[1] = r0;
            f32x4 vv[2][4];
#pragma unroll
            for (int k = 0; k < 2; ++k) { const float* xr = x_row_ptr(A, rr[k]);
#pragma unroll
                for (int j = 0; j < 4; ++j) vv[k][j] = *(const f32x4*)(xr + 4 * lane + 256 * j); }
#pragma unroll
            for (int k = 0; k < 2; ++k) {
                if (k == 1 && !has1) continue;
                const int r = rr[k]; f32x4 v[4]; float s = 0.f;
#pragma unroll
                for (int j = 0; j < 4; ++j) { v[j] = vv[k][j]; s += (v[j][0] * v[j][0] + v[j][1] * v[j][1]) + (v[j][2] * v[j][2] + v[j][3] * v[j][3]); }
                const float rs = rsqrtf(wave_sum(s) * (1.f / 1024.f) + EPS);
#pragma unroll
                for (int j = 0; j < 4; ++j) { v[j] = v[j] * rs * gv[j]; u32x2 w; w.x = pk2(v[j][0], v[j][1]); w.y = pk2(v[j][2], v[j][3]); *(u32x2*)(HN + (size_t)r * 1024 + 4 * lane + 256 * j) = w; }
                float ab[8];
#pragma unroll
                for (int o = 0; o < 8; ++o) { float d = 0.f;
#pragma unroll
                    for (int j = 0; j < 4; ++j) { const f32x4 w4 = *(const f32x4*)(wab + o * 1024 + 4 * lane + 256 * j); d += (v[j][0] * w4[0] + v[j][1] * w4[1]) + (v[j][2] * w4[2] + v[j][3] * w4[3]); }
                    ab[o] = wave_sum(d); }
                if (lane == 0) { *(f32x4*)(AB + (size_t)r * 8) = (f32x4){ab[0], ab[1], ab[2], ab[3]}; *(f32x4*)(AB + (size_t)r * 8 + 4) = (f32x4){ab[4], ab[5], ab[6], ab[7]}; }
            }
        }
        __syncthreads();
    }
}

__device__ __forceinline__ void s5_scan_tile(f32x4& h, const f32x4& k0, const f32x4& k1, const f32x4& k2, const f32x4&, const f32x4&) {
    const float n0r = k0[0], n0i = k0[1], t0r = k0[2], t0i = k0[3], n1r = k1[2], n1i = k1[3], t1r = k2[0], t1i = k2[1];
    float g0 = n0r * h[0] - n0i * h[1], g1 = n0r * h[1] + n0i * h[0], g2 = n1r * h[2] - n1i * h[3], g3 = n1r * h[3] + n1i * h[2];
#define S5_PFX(CTRL) { g0 += dpp0<CTRL>(g0); g1 += dpp0<CTRL>(g1); g2 += dpp0<CTRL>(g2); g3 += dpp0<CTRL>(g3); }
    S5_PFX(0x111) S5_PFX(0x112) S5_PFX(0x114) S5_PFX(0x118)
#undef S5_PFX
    h[0] = t0r * g0 - t0i * g1; h[1] = t0r * g1 + t0i * g0; h[2] = t1r * g2 - t1i * g3; h[3] = t1r * g3 + t1i * g2;
}
__device__ __forceinline__ void s5_add_carry(f32x4& h, const f32x4& cr, const f32x4& k1, const f32x4& k2) {
    const float p0r = k1[0], p0i = k1[1], p1r = k2[2], p1i = k2[3];
    h[0] += p0r * cr[0] - p0i * cr[1]; h[1] += p0r * cr[1] + p0i * cr[0];
    h[2] += p1r * cr[2] - p1i * cr[3]; h[3] += p1r * cr[3] + p1i * cr[2];
}

template <int MODE> __device__ __forceinline__ void s5_unit(const Args& A, int g, int b, int run, int lane) {
    unsigned char* ws = A.ws;
    asm volatile("" : "+v"(lane));
    const int q = lane >> 4, t = lane & 15;
    const bf16_t* U = (const bf16_t*)(ws + WS_U);
    bf16_t* GS = (bf16_t*)((unsigned char*)A.out + DO_GS);
    constexpr int NSMAX = (MODE == 2) ? 16 : 17;
    constexpr int NV = (MODE == 2) ? 4 : 16;
    int nsub, row0, rstride;
    if (MODE == 2) { nsub = 16; row0 = TPR + b * 16 * DS; rstride = DS; }
    else { const int sc0 = run == 0 ? 0 : 17 + (run - 1) * 16; nsub = run == 0 ? 17 : 16; row0 = b * LP + sc0 * 16; rstride = 16; }
    f32x4 Y[NSMAX];
#pragma unroll
    for (int sc = 0; sc < NSMAX; ++sc) Y[sc] = (f32x4){0.f, 0.f, 0.f, 0.f};
    const bool uvalid = (q < 2) && (t < NV);
    for (int pair = 0; pair < 4; ++pair) {
        const int t0 = 2 * pair, t1 = 2 * pair + 1;
        const f32x4* kp0 = (const f32x4*)(ws + WS_S5K) + ((size_t)(g * 8 + t0) * 64 + lane) * 5;
        const f32x4* kp1 = (const f32x4*)(ws + WS_S5K) + ((size_t)(g * 8 + t1) * 64 + lane) * 5;
        const f32x4 ka0 = kp0[0], ka1 = kp0[1], ka2 = kp0[2], ka3 = ka0, ka4 = ka0;
        const f32x4 kb0 = kp1[0], kb1 = kp1[1], kb2 = kp1[2], kb3 = kb0, kb4 = kb0;
        const bf16x8 A0 = *(const bf16x8*)(ws + WS_S5A + ((size_t)(g * 8 + t0) * 64 + lane) * 16);
        const bf16x8 A1 = *(const bf16x8*)(ws + WS_S5A + ((size_t)(g * 8 + t1) * 64 + lane) * 16);
        const bf16x8 Cop = *(const bf16x8*)(ws + WS_S5C + ((size_t)(g * 4 + pair) * 64 + lane) * 16);
        f32x4 c0 = (f32x4){0.f, 0.f, 0.f, 0.f}, c1 = c0;
        const bf16_t* up = U + (size_t)(row0 + t) * 512 + g * 16 + q * 8;
        const bf16x8 bzero = (bf16x8){0, 0, 0, 0, 0, 0, 0, 0};
        bf16x8 bq[NSMAX + 2];
        bq[0] = uvalid ? *(const bf16x8*)up : bzero; up += rstride * 512; asm volatile("" : "+v"(up));
        bq[1] = (uvalid && 1 < nsub) ? *(const bf16x8*)up : bzero; up += rstride * 512; asm volatile("" : "+v"(up));
        if (MODE == 1) {
            const f32x4 ad0 = *(const f32x4*)(ws + WS_S5ADV + (size_t)((g * 8 + t0) * 4 + q) * 16), ad1 = *(const f32x4*)(ws + WS_S5ADV + (size_t)((g * 8 + t1) * 4 + q) * 16);
            const float* endp = (const float*)(ws + WS_S5END) + ((size_t)(b * 32 + g) * 8) * 128;
            for (int rp = 0; rp < run; ++rp) {
                const f32x4 e0 = *(const f32x4*)(endp + rp * 128 + t0 * 16 + q * 4), e1 = *(const f32x4*)(endp + rp * 128 + t1 * 16 + q * 4);
                f32x4 n0, n1;
                n0[0] = ad0[0] * c0[0] - ad0[1] * c0[1] + e0[0]; n0[1] = ad0[0] * c0[1] + ad0[1] * c0[0] + e0[1];
                n0[2] = ad0[2] * c0[2] - ad0[3] * c0[3] + e0[2]; n0[3] = ad0[2] * c0[3] + ad0[3] * c0[2] + e0[3];
                n1[0] = ad1[0] * c1[0] - ad1[1] * c1[1] + e1[0]; n1[1] = ad1[0] * c1[1] + ad1[1] * c1[0] + e1[1];
                n1[2] = ad1[2] * c1[2] - ad1[3] * c1[3] + e1[2]; n1[3] = ad1[2] * c1[3] + ad1[3] * c1[2] + e1[3];
                c0 = n0; c1 = n1;
            }
        }
#pragma unroll
        for (int sc = 0; sc < NSMAX; ++sc) {
            if (sc < nsub) {
                if (sc + 2 < NSMAX) { bq[sc + 2] = (uvalid && sc + 2 < nsub) ? *(const bf16x8*)up : bzero; up += rstride * 512; asm volatile("" : "+v"(up)); }
                const bf16x8 Bop = bq[sc];
                const f32x4 z = (f32x4){0.f, 0.f, 0.f, 0.f};
                f32x4 h0 = mfma16(A0, Bop, z), h1 = mfma16(A1, Bop, z);
                s5_scan_tile(h0, ka0, ka1, ka2, ka3, ka4);
                s5_scan_tile(h1, kb0, kb1, kb2, kb3, kb4);
                if (MODE == 2) {
                    const int bb = b * 16 + sc; const float* sre = A.in[2] + ((size_t)bb * 32 + g) * 64; const float* sim = A.in[3] + ((size_t)bb * 32 + g) * 64;
                    const int s0 = t0 * 8 + q * 2, s1 = t1 * 8 + q * 2;
                    c0 = (f32x4){sre[s0], sim[s0], sre[s0 + 1], sim[s0 + 1]}; c1 = (f32x4){sre[s1], sim[s1], sre[s1 + 1], sim[s1 + 1]};
                }
                s5_add_carry(h0, c0, ka1, ka2); s5_add_carry(h1, c1, kb1, kb2);
                const int src = (lane & 48) | (NV - 1);
#pragma unroll
                for (int k = 0; k < 4; ++k) { c0[k] = __shfl(h0[k], src); c1[k] = __shfl(h1[k], src); }
                if (MODE == 2) {
                    if (t == NV - 1) { const int bb = b * 16 + sc; float* ore = A.out + O_SRE + ((size_t)bb * 32 + g) * 64; float* oim = A.out + O_SIM + ((size_t)bb * 32 + g) * 64;
                        const int s0 = t0 * 8 + q * 2, s1 = t1 * 8 + q * 2;
                        ore[s0] = h0[0]; oim[s0] = h0[1]; ore[s0 + 1] = h0[2]; oim[s0 + 1] = h0[3];
                        ore[s1] = h1[0]; oim[s1] = h1[1]; ore[s1 + 1] = h1[2]; oim[s1 + 1] = h1[3]; }
                }
                if (MODE != 0) Y[sc] = mfma16(Cop, pack8(h0, h1), Y[sc]);
                asm volatile("" ::: "memory");
            }
        }
        if (MODE == 0) {
            if (t == 15) { float* endp = (float*)(ws + WS_S5END) + ((size_t)((b * 32 + g) * 8 + run)) * 128;
                *(f32x4*)(endp + t0 * 16 + q * 4) = c0; *(f32x4*)(endp + t1 * 16 + q * 4) = c1; }
        }
        if (MODE == 1) {
            if (run == 7 && t == 15) { float* ore = A.out + O_PRE + ((size_t)b * 32 + g) * 64; float* oim = A.out + O_PIM + ((size_t)b * 32 + g) * 64;
                const int s0 = t0 * 8 + q * 2, s1 = t1 * 8 + q * 2;
                ore[s0] = c0[0]; oim[s0] = c0[1]; ore[s0 + 1] = c0[2]; oim[s0 + 1] = c0[3];
                ore[s1] = c1[0]; oim[s1] = c1[1]; ore[s1 + 1] = c1[2]; oim[s1 + 1] = c1[3]; }
        }
    }
    if (MODE != 0) {
        const f32x4 Dv = *(const f32x4*)(A.in[19] + g * 16 + q * 4);
        size_t eoff = (size_t)(row0 + t) * 512 + g * 16 + q * 4;
#pragma unroll
        for (int sc = 0; sc < NSMAX; ++sc) {
            if (sc < nsub && t < NV) {
                const u32x2 uu = *(const u32x2*)(U + eoff);
                const float y0 = Y[sc][0] + Dv[0] * bflo(uu.x), y1 = Y[sc][1] + Dv[1] * bfhi(uu.x), y2 = Y[sc][2] + Dv[2] * bflo(uu.y), y3 = Y[sc][3] + Dv[3] * bfhi(uu.y);
                u32x2 w; w.x = pk2(geluf_(y0), geluf_(y1)); w.y = pk2(geluf_(y2), geluf_(y3));
                *(u32x2*)(GS + eoff) = w;
            }
            eoff += rstride * 512; asm volatile("" : "+v"(eoff));
        }
    }
}

__device__ __forceinline__ void s5_decode(const Args& A, int g, int seq0, int nseq, int lane) {
    unsigned char* ws = A.ws;
    asm volatile("" : "+v"(lane));
    const int q = lane >> 4, t = lane & 15;
    const bf16_t* U = (const bf16_t*)(ws + WS_U);
    bf16_t* GS = (bf16_t*)((unsigned char*)A.out + DO_GS);
    const bool uvalid = (q < 2) && (t < DS);
    const f32x4 Dv = *(const f32x4*)(A.in[19] + g * 16 + q * 4);
#pragma unroll 1
    for (int sc = 0; sc < nseq; ++sc) {
        const int bb = seq0 + sc, row = TPR + bb * DS + t;
        bf16x8 Bop = (bf16x8){0, 0, 0, 0, 0, 0, 0, 0};
        if (uvalid) Bop = *(const bf16x8*)(U + (size_t)row * 512 + g * 16 + q * 8);
        const float* sre = A.in[2] + ((size_t)bb * 32 + g) * 64; const float* sim = A.in[3] + ((size_t)bb * 32 + g) * 64;
        float* ore = A.out + O_SRE + ((size_t)bb * 32 + g) * 64; float* oim = A.out + O_SIM + ((size_t)bb * 32 + g) * 64;
        f32x4 Y = (f32x4){0.f, 0.f, 0.f, 0.f};
#pragma unroll 1
        for (int pair = 0; pair < 4; ++pair) {
            const int t0 = 2 * pair, t1 = 2 * pair + 1;
            const f32x4* kp0 = (const f32x4*)(ws + WS_S5K) + ((size_t)(g * 8 + t0) * 64 + lane) * 5;
            const f32x4* kp1 = (const f32x4*)(ws + WS_S5K) + ((size_t)(g * 8 + t1) * 64 + lane) * 5;
            const f32x4 ka0 = kp0[0], ka1 = kp0[1], ka2 = kp0[2], ka3 = ka0, ka4 = ka0;
            const f32x4 kb0 = kp1[0], kb1 = kp1[1], kb2 = kp1[2], kb3 = kb0, kb4 = kb0;
            const bf16x8 A0 = *(const bf16x8*)(ws + WS_S5A + ((size_t)(g * 8 + t0) * 64 + lane) * 16);
            const bf16x8 A1 = *(const bf16x8*)(ws + WS_S5A + ((size_t)(g * 8 + t1) * 64 + lane) * 16);
            const bf16x8 Cop = *(const bf16x8*)(ws + WS_S5C + ((size_t)(g * 4 + pair) * 64 + lane) * 16);
            const f32x4 z = (f32x4){0.f, 0.f, 0.f, 0.f};
            f32x4 h0 = mfma16(A0, Bop, z), h1 = mfma16(A1, Bop, z);
            s5_scan_tile(h0, ka0, ka1, ka2, ka3, ka4);
            s5_scan_tile(h1, kb0, kb1, kb2, kb3, kb4);
            const int s0 = t0 * 8 + q * 2, s1 = t1 * 8 + q * 2;
            const f32x4 c0 = (f32x4){sre[s0], sim[s0], sre[s0 + 1], sim[s0 + 1]}, c1 = (f32x4){sre[s1], sim[s1], sre[s1 + 1], sim[s1 + 1]};
            s5_add_carry(h0, c0, ka1, ka2); s5_add_carry(h1, c1, kb1, kb2);
            if (t == DS - 1) { ore[s0] = h0[0]; oim[s0] = h0[1]; ore[s0 + 1] = h0[2]; oim[s0 + 1] = h0[3];
                               ore[s1] = h1[0]; oim[s1] = h1[1]; ore[s1 + 1] = h1[2]; oim[s1 + 1] = h1[3]; }
            Y = mfma16(Cop, pack8(h0, h1), Y);
        }
        if (t < DS) {
            const u32x2 uu = *(const u32x2*)(U + (size_t)row * 512 + g * 16 + q * 4);
            const float y0 = Y[0] + Dv[0] * bflo(uu.x), y1 = Y[1] + Dv[1] * bfhi(uu.x), y2 = Y[2] + Dv[2] * bflo(uu.y), y3 = Y[3] + Dv[3] * bfhi(uu.y);
            u32x2 w; w.x = pk2(geluf_(y0), geluf_(y1)); w.y = pk2(geluf_(y2), geluf_(y3));
            *(u32x2*)(GS + (size_t)row * 512 + g * 16 + q * 4) = w;
        }
    }
}

__device__ __forceinline__ void gdn_step(const LDSP unsigned char* img, const u32x2 (&uw)[2], f32x4 (&S)[8], f32x4 (&o)[2], int lane) {
    const int q = lane >> 4, r = lane & 15;
    bf16x8 Sop[4];
#pragma unroll
    for (int i = 0; i < 4; ++i) Sop[i] = pack8(S[2 * i], S[2 * i + 1]);
    bf16x8 aw[2][4];
#pragma unroll
    for (int mt = 0; mt < 2; ++mt)
#pragma unroll
        for (int i = 0; i < 4; ++i) aw[mt][i] = *(const LDSP bf16x8*)(img + IMG_WN + (mt * 16 + r) * 272 + i * 64 + q * 16);
    bf16x8 aq[2][5];
#pragma unroll
    for (int mt = 0; mt < 2; ++mt) {
#pragma unroll
        for (int i = 0; i < 4; ++i) aq[mt][i] = *(const LDSP bf16x8*)(img + IMG_QD + (mt * 16 + r) * 272 + i * 64 + q * 16);
        aq[mt][4] = *(const LDSP bf16x8*)(img + IMG_QK + (mt * 16 + r) * 80 + q * 16);
    }
    f32x4 vn[2];
#pragma unroll
    for (int mt = 0; mt < 2; ++mt) vn[mt] = (f32x4){bflo(uw[mt].x), bfhi(uw[mt].x), bflo(uw[mt].y), bfhi(uw[mt].y)};
#pragma unroll
    for (int i = 0; i < 4; ++i)
#pragma unroll
        for (int mt = 0; mt < 2; ++mt) vn[mt] = mfma16(aw[mt][i], Sop[i], vn[mt]);
    bf16x8 ak[8];
#pragma unroll
    for (int dt = 0; dt < 8; ++dt) ak[dt] = *(const LDSP bf16x8*)(img + IMG_KDT + (dt * 16 + r) * 80 + q * 16);
    const float egl = *(const LDSP float*)(img + IMG_HDR);
#pragma unroll
    for (int mt = 0; mt < 2; ++mt) o[mt] = (f32x4){0.f, 0.f, 0.f, 0.f};
#pragma unroll
    for (int i = 0; i < 4; ++i)
#pragma unroll
        for (int mt = 0; mt < 2; ++mt) o[mt] = mfma16(aq[mt][i], Sop[i], o[mt]);
    const bf16x8 Vop = pack8(vn[0], vn[1]);
#pragma unroll
    for (int mt = 0; mt < 2; ++mt) o[mt] = mfma16(aq[mt][4], Vop, o[mt]);
#pragma unroll
    for (int dt = 0; dt < 8; ++dt) S[dt] = mfma16(ak[dt], Vop, S[dt] * egl);
}
__device__ __forceinline__ void gdn_zs_prefetch(const Args& A, unsigned (&zs)[8], int rowbase, int nvalid, int h, int wave, int lane) {
    const int q = lane >> 4, n = lane & 15; const bf16_t* ZS = (const bf16_t*)(A.ws + WS_ZS); const int e = h * 128 + wave * 16 + n;
#pragma unroll
    for (int mt = 0; mt < 2; ++mt)
#pragma unroll
        for (int jj = 0; jj < 4; ++jj) { const int tok = mt * 16 + q * 4 + jj; zs[mt * 4 + jj] = tok < nvalid ? (unsigned)ZS[(size_t)(rowbase + tok) * 512 + e] : 0u; }
}
__device__ __forceinline__ void gdn_norm_store(const Args& A, const f32x4 (&o)[2], unsigned (&zs)[8], float gn, LDSP float* part, int rowbase, int nvalid, int h, int wave, int lane) {
    const int q = lane >> 4, n = lane & 15;
#pragma unroll
    for (int mt = 0; mt < 2; ++mt)
#pragma unroll
        for (int jj = 0; jj < 4; ++jj) { const float s = row16_sum(o[mt][jj] * o[mt][jj]); if (n == 0) part[wave * 32 + mt * 16 + q * 4 + jj] = s; }
    lds_barrier();
#pragma unroll
    for (int k = 0; k < 8; ++k) asm volatile("" : "+v"(zs[k]));
    bf16_t* ON = (bf16_t*)((unsigned char*)A.out + DO_ON);
    const int e = h * 128 + wave * 16 + n;
#pragma unroll
    for (int mt = 0; mt < 2; ++mt)
#pragma unroll
        for (int jj = 0; jj < 4; ++jj) {
            const int tok = mt * 16 + q * 4 + jj;
            if (tok < nvalid) {
                float tot = 0.f;
#pragma unroll
                for (int w = 0; w < 8; ++w) tot += part[w * 32 + tok];
                const float rs = rsqrtf(tot * (1.f / 128.f) + EPS);
                const size_t row = (size_t)(rowbase + tok);
#ifndef NO_ONSTORE
                ON[row * 512 + e] = f2bf(o[mt][jj] * rs * gn * __builtin_bit_cast(float, zs[mt * 4 + jj] << 16));
#endif
            }
        }
}
__device__ __forceinline__ void gdn_store_state(float* dst, const f32x4 (&S)[8], int wave, int lane) {
    const int q = lane >> 4, n = lane & 15;
#pragma unroll
    for (int dt = 0; dt < 8; ++dt)
#pragma unroll
        for (int jj = 0; jj < 4; ++jj) {
#ifdef SANITIZE
            float v = S[dt][jj]; if (!(fabsf(v) < 1e30f)) v = 12345.f; dst[(size_t)(dt * 16 + q * 4 + jj) * 128 + wave * 16 + n] = v;
#else
            dst[(size_t)(dt * 16 + q * 4 + jj) * 128 + wave * 16 + n] = S[dt][jj];
#endif
        }
}

__device__ __forceinline__ void gdn_prep(const Args& A, unsigned char* lds, int kind, int b, int h, int nchunk, int tid) {
    unsigned char* ws = A.ws;
    asm volatile("" : "+v"(tid));
    const int wave = tid >> 6, lane = tid & 63, grp = tid >> 7, cc = tid & 127;
    int rowbase, nvalid; bool hist_rows;
    if (kind == 0) { const int t0 = nchunk == 0 ? 0 : NMETA + (nchunk - 1) * CT; nvalid = nchunk == 0 ? NMETA : CT; rowbase = b * LP + t0; hist_rows = nchunk > 0; }
    else { nvalid = DS; rowbase = TPR + b * DS; hist_rows = false; }
    LDSP unsigned char* l3 = (LDSP unsigned char*)lds; asm volatile("" : "+v"(l3));
    LDSP float* MX = (LDSP float*)(l3 + L_MX); LDSP float* GC = (LDSP float*)(l3 + L_GC); LDSP float* BETA = (LDSP float*)(l3 + L_BETA); LDSP float* EG = (LDSP float*)(l3 + L_EG);
    LDSP float* EGLK = (LDSP float*)(l3 + L_EGLK); LDSP float* SSQ = (LDSP float*)(l3 + L_SSQ); LDSP float* PART = (LDSP float*)(l3 + L_PART);
    float x[CT];
    if (grp < 3) {
        const int colq = (grp == 0 ? 1024 : grp == 1 ? 512 : 0) + h * 128 + cc;
        const float* cw = A.in[22];
        const float w0 = cw[colq], w1 = cw[QKVW + colq], w2 = cw[2 * QKVW + colq], w3 = cw[3 * QKVW + colq];
        const bf16_t* QKV = (const bf16_t*)(ws + WS_QKV);
        float p0 = 0.f, p1 = 0.f, p2 = 0.f;
        if (kind == 1) { const float* sc = A.in[5] + (size_t)b * 3 * QKVW + colq; p0 = sc[0]; p1 = sc[QKVW]; p2 = sc[2 * QKVW]; }
        else if (hist_rows) { p0 = bf2f(QKV[(size_t)(rowbase - 3) * QKVW + colq]); p1 = bf2f(QKV[(size_t)(rowbase - 2) * QKVW + colq]); p2 = bf2f(QKV[(size_t)(rowbase - 1) * QKVW + colq]); }
#pragma unroll
        for (int i = 0; i < CT; ++i) {
            float cur = 0.f, v = 0.f;
            if (i < nvalid) { cur = bf2f(QKV[(size_t)(rowbase + i) * QKVW + colq]); const float y = w0 * p0 + w1 * p1 + w2 * p2 + w3 * cur; v = siluf_(y); }
            x[i] = v; p0 = p1; p1 = p2; p2 = cur;
        }
        if (grp >= 1) {
            LDSP float* red = (LDSP float*)(l3 + L_RED) + (wave - 2) * (CT * 68);
#pragma unroll
            for (int i = 0; i < CT; ++i) red[i * 68 + lane] = x[i] * x[i];
            asm volatile("s_waitcnt lgkmcnt(0)" ::: "memory");
            if (lane < CT) {
                f32x4 acc4 = (f32x4){0.f, 0.f, 0.f, 0.f};
#pragma unroll
                for (int c4 = 0; c4 < 16; ++c4) acc4 += *(const LDSP f32x4*)(red + lane * 68 + c4 * 4);
                SSQ[(wave - 2) * CT + lane] = (acc4[0] + acc4[1]) + (acc4[2] + acc4[3]);
            }
        }
    } else if (wave == 7) {
        float gval = 0.f, beta = 0.f;
        if (lane < nvalid) {
            const float* ab = (const float*)(ws + WS_AB) + (size_t)(rowbase + lane) * 8;
            const float a = ab[h] + A.in[24][h];
            const float sp = a > 20.f ? a : log1pf(expf(a));
            gval = -expf(A.in[23][h]) * sp;
            beta = 1.0f / (1.0f + expf(-ab[4 + h]));
        }
        float gc = gval;
#pragma unroll
        for (int off = 1; off < 64; off <<= 1) { const float v = __shfl_up(gc, off); if (lane >= off) gc += v; }
        const float gl = __shfl(gc, 63);
        if (lane < CT) { GC[lane] = gc; BETA[lane] = beta; EG[lane] = expf(gc); EGLK[lane] = expf(gl - gc); }
        if (lane == 0) *(LDSP float*)(l3 + IMG_HDR) = expf(gl);
    }
    lds_barrier();
    if (grp == 1 || grp == 2) {
        const int g0 = (grp - 1) * 2; const float sc = grp == 2 ? 0.08838834764831845f : 1.0f;
        LDSP bf16_t* op0 = (LDSP bf16_t*)(l3 + (grp == 1 ? L_OPK : L_OPQ)); LDSP bf16_t* opkb = (LDSP bf16_t*)(l3 + L_OPKB);
#pragma unroll
        for (int i = 0; i < CT; ++i) {
            const float inv = rsqrtf(SSQ[g0 * CT + i] + SSQ[(g0 + 1) * CT + i] + EPS) * sc;
            x[i] *= inv;
            op0[i * 136 + cc] = f2bf(x[i]);
            if (grp == 1) opkb[i * 136 + cc] = f2bf(x[i] * BETA[i]);
        }
    }
    lds_barrier();
    if (wave < 4) {
        const int q = lane >> 4, r = lane & 15, mt = wave >> 1, nt = wave & 1;
        f32x4 am = (f32x4){0.f, 0.f, 0.f, 0.f}, aq = am;
        if (nt <= mt) {
#pragma unroll
            for (int ks = 0; ks < 4; ++ks) {
                const bf16x8 bk = *(const LDSP bf16x8*)(l3 + L_OPK + (nt * 16 + r) * 272 + ks * 64 + q * 16);
                const bf16x8 akb = *(const LDSP bf16x8*)(l3 + L_OPKB + (mt * 16 + r) * 272 + ks * 64 + q * 16);
                const bf16x8 aqn = *(const LDSP bf16x8*)(l3 + L_OPQ + (mt * 16 + r) * 272 + ks * 64 + q * 16);
                am = mfma16(akb, bk, am); aq = mfma16(aqn, bk, aq);
            }
        }
        const int j = nt * 16 + r; const float gj = GC[j];
        LDSP bf16_t* qk = (LDSP bf16_t*)(l3 + IMG_QK);
#pragma unroll
        for (int jj = 0; jj < 4; ++jj) {
            const int i = mt * 16 + q * 4 + jj;
            const float dec = (i >= j) ? __expf(GC[i] - gj) : 0.f;
            MX[i * 36 + j] = (i > j) ? am[jj] * dec : 0.f;
            qk[i * 40 + pos32(j)] = f2bf(aq[jj] * dec);
        }
    }
    lds_barrier();
    if (grp == 1) {
        LDSP bf16_t* kdt = (LDSP bf16_t*)(l3 + IMG_KDT);
#pragma unroll
        for (int i = 0; i < CT; ++i) { kdt[cc * 40 + pos32(i)] = f2bf(x[i] * EGLK[i]); x[i] *= BETA[i] * EG[i]; }
    } else if (grp == 2) {
        LDSP bf16_t* qd = (LDSP bf16_t*)(l3 + IMG_QD); const int pc = pos32(cc);
#pragma unroll
        for (int i = 0; i < CT; ++i) qd[i * 136 + pc] = f2bf(x[i] * EG[i]);
    } else if (grp == 0) {
#pragma unroll
        for (int i = 0; i < CT; ++i) x[i] *= BETA[i];
    }
    if (grp < 2) {
#pragma unroll
        for (int i = 1; i < CT; ++i) {
            float s = x[i];
#pragma unroll
            for (int j4 = 0; j4 < (i + 3) / 4; ++j4) {
                const f32x4 mv = *(const LDSP f32x4*)(MX + i * 36 + j4 * 4);
                if (j4 * 4 + 0 < i) s -= mv[0] * x[j4 * 4 + 0];
                if (j4 * 4 + 1 < i) s -= mv[1] * x[j4 * 4 + 1];
                if (j4 * 4 + 2 < i) s -= mv[2] * x[j4 * 4 + 2];
                if (j4 * 4 + 3 < i) s -= mv[3] * x[j4 * 4 + 3];
            }
            x[i] = s;
            if ((i & 1) == 1) asm volatile("" ::: "memory");
        }
    }
    if (grp == 1) {
        LDSP bf16_t* wn = (LDSP bf16_t*)(l3 + IMG_WN); const int pc = pos32(cc);
#pragma unroll
        for (int i = 0; i < CT; ++i) wn[i * 136 + pc] = f2bf(-x[i]);
    } else if (grp == 0) {
        unsigned char* ub = (kind == 0) ? (ws + WS_REC + (size_t)((b * GH + h) * NCH + nchunk) * REC_BYTES + REC_U) : (lds + L_ULDS);
        const int et = cc >> 4, n = cc & 15;
#pragma unroll
        for (int mt = 0; mt < 2; ++mt)
#pragma unroll
            for (int qq = 0; qq < 4; ++qq) {
                u32x2 w; w.x = pk2(x[mt * 16 + qq * 4 + 0], x[mt * 16 + qq * 4 + 1]); w.y = pk2(x[mt * 16 + qq * 4 + 2], x[mt * 16 + qq * 4 + 3]);
                *(u32x2*)(ub + ((size_t)((et * 2 + mt) * 64 + qq * 16 + n)) * 8) = w;
            }
    }
    lds_barrier();
    if (kind == 0) {
        u32x4* dst = (u32x4*)(ws + WS_REC + (size_t)((b * GH + h) * NCH + nchunk) * REC_BYTES);
        for (int i = tid; i < IMG_V4; i += NTHREADS) dst[i] = *(const LDSP u32x4*)(l3 + i * 16);
    } else {
        f32x4 S[8], o[2];
        const float* s0 = A.in[4] + (size_t)(b * GH + h) * 128 * 128;
        const int q = lane >> 4, n = lane & 15;
#pragma unroll
        for (int dt = 0; dt < 8; ++dt)
#pragma unroll
            for (int jj = 0; jj < 4; ++jj) S[dt][jj] = s0[(size_t)(dt * 16 + q * 4 + jj) * 128 + wave * 16 + n];
        const float gnw = A.in[25][wave * 16 + (lane & 15)];
        unsigned zs[8]; gdn_zs_prefetch(A, zs, rowbase, nvalid, h, wave, lane);
        u32x2 uw[2]; { const bf16_t* Uw = (const bf16_t*)(lds + L_ULDS) + (size_t)wave * 512; uw[0] = *(const u32x2*)(Uw + (size_t)lane * 4); uw[1] = *(const u32x2*)(Uw + ((size_t)64 + lane) * 4); }
        gdn_step(l3, uw, S, o, lane);
        gdn_norm_store(A, o, zs, gnw, PART, rowbase, nvalid, h, wave, lane);
        gdn_store_state(A.out + O_SGDN + (size_t)(b * GH + h) * 128 * 128, S, wave, lane);
    }
    lds_barrier();
}

__device__ __forceinline__ void gdn_chain2(const Args& A, unsigned char* lds, int b, int h, int half, int tid) {
    const int wave = tid >> 6, lane = tid & 63, q = lane >> 4, nn = lane & 15;
    const bool act = wave < 4; const int et = half * 4 + (wave & 3);
    const unsigned char* rec = A.ws + WS_REC + (size_t)((b * GH + h) * NCH) * REC_BYTES;
    LDSP unsigned char* l3 = (LDSP unsigned char*)lds; asm volatile("" : "+v"(l3));
    const int e = h * 128 + et * 16 + nn;
    const float gnw = A.in[25][et * 16 + nn];
    bf16_t* ON = (bf16_t*)((unsigned char*)A.out + DO_ON); float* PSS = (float*)(A.ws + WS_SSQ);
    f32x4 S[8], o[2];
#pragma unroll
    for (int dt = 0; dt < 8; ++dt) S[dt] = (f32x4){0.f, 0.f, 0.f, 0.f};
    for (int i = tid; i < IMG_V4; i += NTHREADS) *(LDSP u32x4*)(l3 + LC_BUF0 + i * 16) = ((const u32x4*)rec)[i];
    u32x4 pfa[4], pfb[4]; u32x2 uw[2], uwn[2]; unsigned zs[8], zsn[8];
#define CH_LOADIMG(dst, nn_) do { const u32x4* nx_ = (const u32x4*)(rec + (size_t)(nn_) * REC_BYTES); _Pragma("unroll") for (int k = 0; k < 4; ++k) { const int i = tid + k * NTHREADS; if (i < IMG_V4) dst[k] = nx_[i]; } } while (0)
#define CH_STOREIMG(src, bufoff) do { _Pragma("unroll") for (int k = 0; k < 4; ++k) { const int i = tid + k * NTHREADS; if (i < IMG_V4) *(LDSP u32x4*)(l3 + (bufoff) + i * 16) = src[k]; } } while (0)
#define CH_LOADU(dst, nn_) do { if (act) { const bf16_t* Uw_ = (const bf16_t*)(rec + (size_t)(nn_) * REC_BYTES + REC_U) + (size_t)et * 512; dst[0] = *(const u32x2*)(Uw_ + (size_t)lane * 4); dst[1] = *(const u32x2*)(Uw_ + ((size_t)64 + lane) * 4); } } while (0)
#define CH_ROWBASE(nn_) (b * LP + ((nn_) == 0 ? 0 : NMETA + ((nn_) - 1) * CT))
#define CH_ZS(dst, nn_, nv_) do { if (act) { const bf16_t* ZS_ = (const bf16_t*)(A.ws + WS_ZS); _Pragma("unroll") for (int mt = 0; mt < 2; ++mt) _Pragma("unroll") for (int jj = 0; jj < 4; ++jj) { const int tok = mt * 16 + q * 4 + jj; dst[mt * 4 + jj] = tok < (nv_) ? (unsigned)ZS_[(size_t)(CH_ROWBASE(nn_) + tok) * 512 + e] : 0u; } } } while (0)
#define CH_OUT(zz, nn_, nv_) do { if (act) { _Pragma("unroll") for (int k = 0; k < 8; ++k) asm volatile("" : "+v"(zz[k])); \
        _Pragma("unroll") for (int mt = 0; mt < 2; ++mt) _Pragma("unroll") for (int jj = 0; jj < 4; ++jj) { const int tok = mt * 16 + q * 4 + jj; \
            const float ssq = row16_sum(o[mt][jj] * o[mt][jj]); \
            if (tok < (nv_)) { const size_t row = (size_t)(CH_ROWBASE(nn_) + tok); \
                ON[row * 512 + e] = f2bf(o[mt][jj] * gnw * __builtin_bit_cast(float, zz[mt * 4 + jj] << 16)); \
                if (nn == 0) PSS[row * 32 + h * 8 + et] = ssq; } } } } while (0)
    CH_LOADIMG(pfa, 1); CH_LOADU(uw, 0); CH_ZS(zs, 0, NMETA);
    CH_STOREIMG(pfa, IMG_BYTES);
    lds_barrier();
    CH_LOADIMG(pfa, 2);
    for (int n = 0; n < NCH; n += 2) {
        if (n + 1 < NCH) { CH_LOADU(uwn, n + 1); CH_ZS(zsn, n + 1, CT); }
        if (n + 3 < NCH) CH_LOADIMG(pfb, n + 3);
        if (act) gdn_step(l3 + (n % 3) * IMG_BYTES, uw, S, o, lane);
        CH_OUT(zs, n, (n == 0 ? NMETA : CT));
        if (n + 2 < NCH) CH_STOREIMG(pfa, ((n + 2) % 3) * IMG_BYTES);
        lds_barrier();
        if (n + 1 >= NCH) break;
        if (n + 2 < NCH) { CH_LOADU(uw, n + 2); CH_ZS(zs, n + 2, CT); }
        if (n + 4 < NCH) CH_LOADIMG(pfa, n + 4);
        if (act) gdn_step(l3 + ((n + 1) % 3) * IMG_BYTES, uwn, S, o, lane);
        CH_OUT(zsn, n + 1, CT);
        if (n + 3 < NCH) CH_STOREIMG(pfb, (n % 3) * IMG_BYTES);
        lds_barrier();
    }
#undef CH_LOADIMG
#undef CH_STOREIMG
#undef CH_LOADU
#undef CH_ROWBASE
#undef CH_ZS
#undef CH_OUT
    if (act) gdn_store_state(A.out + O_PGDN + (size_t)(b * GH + h) * 128 * 128, S, et, lane);
}
__device__ __forceinline__ void gdn_finish_rows(const Args& A, int tid, int skip) {
    if ((int)blockIdx.x < skip) return;
    const int wave = tid >> 6, lane = tid & 63, G = gridDim.x - skip;
    bf16_t* ON = (bf16_t*)((unsigned char*)A.out + DO_ON); const float* PSS = (const float*)(A.ws + WS_SSQ);
    for (int r = ((int)blockIdx.x - skip) * 8 + wave; r < TPR; r += G * 8) {
        float ps = (lane < 32) ? PSS[(size_t)r * 32 + lane] : 0.f;
        ps += __shfl_xor(ps, 1); ps += __shfl_xor(ps, 2); ps += __shfl_xor(ps, 4);
        const float tot = __shfl(ps, (lane >> 4) * 8);
        const float rs = rsqrtf(tot * (1.f / 128.f) + EPS);
        u32x4* p = (u32x4*)(ON + (size_t)r * 512 + lane * 8); u32x4 w = *p;
        w.x = pk2(bflo(w.x) * rs, bfhi(w.x) * rs); w.y = pk2(bflo(w.y) * rs, bfhi(w.y) * rs); w.z = pk2(bflo(w.z) * rs, bfhi(w.z) * rs); w.w = pk2(bflo(w.w) * rs, bfhi(w.w) * rs);
        *p = w;
    }
}

template <int CHAIN_PASS> __device__ __forceinline__ void gdn_chain(const Args& A, unsigned char* lds, int b, int h, int tid) {
    const int wave = tid >> 6, lane = tid & 63;
    const unsigned char* rec = A.ws + WS_REC + (size_t)((b * GH + h) * NCH) * REC_BYTES;
    LDSP unsigned char* l3 = (LDSP unsigned char*)lds; asm volatile("" : "+v"(l3));
    LDSP float* PART = (LDSP float*)(l3 + LC_PART);
    const float gnw = A.in[25][wave * 16 + (lane & 15)];
    f32x4 S[8], o[2];
#ifdef CHAIN_HASH
    {
        float hs = 0.f; float* dstp = A.out + O_PGDN + (size_t)(b * GH + h) * 128 * 128;
        for (int n = 0; n < NCH; ++n) { const u32x4* rp = (const u32x4*)(rec + (size_t)n * REC_BYTES);
            for (int i = tid; i < REC_BYTES / 16; i += NTHREADS) {
                const bool used = (i * 16 >= IMG_HDR && i * 16 < IMG_HDR + 16) || (i * 16 >= REC_U) || (i * 16 < IMG_KDT && ((i * 16) % 272) < 256) || (i * 16 >= IMG_KDT && i * 16 < IMG_HDR && (((i * 16) - IMG_KDT) % 80) < 64);
                if (!used) continue;
                const u32x4 w = rp[i];
                if (i * 16 == IMG_HDR) { hs += __builtin_bit_cast(float, w.x); continue; }
                hs += bflo(w.x) + bfhi(w.x) + bflo(w.y) + bfhi(w.y) + bflo(w.z) + bfhi(w.z) + bflo(w.w) + bfhi(w.w); } }
        for (int i = tid; i < 128 * 128; i += NTHREADS) dstp[i] = (i < NTHREADS) ? hs : 0.f;
        return;
    }
#endif
#pragma unroll
    for (int dt = 0; dt < 8; ++dt) S[dt] = (f32x4){0.f, 0.f, 0.f, 0.f};
    for (int i = tid; i < IMG_V4; i += NTHREADS) *(LDSP u32x4*)(l3 + LC_BUF0 + i * 16) = ((const u32x4*)rec)[i];
    __syncthreads();
#ifdef CHAIN_SIMPLE
    for (int n = 0; n < NCH; ++n) {
        if (n > 0) { const u32x4* rp = (const u32x4*)(rec + (size_t)n * REC_BYTES);
            for (int i = tid; i < IMG_V4; i += NTHREADS) *(LDSP u32x4*)(l3 + LC_BUF0 + i * 16) = rp[i];
            __syncthreads(); }
        const int rowbase = b * LP + (n == 0 ? 0 : NMETA + (n - 1) * CT), nvalid = n == 0 ? NMETA : CT;
        unsigned zs[8]; gdn_zs_prefetch(A, zs, rowbase, nvalid, h, wave, lane);
        u32x2 uw[2]; { const bf16_t* Uw = (const bf16_t*)(rec + (size_t)n * REC_BYTES + REC_U) + (size_t)wave * 512; uw[0] = *(const u32x2*)(Uw + (size_t)lane * 4); uw[1] = *(const u32x2*)(Uw + ((size_t)64 + lane) * 4); }
        gdn_step(l3 + LC_BUF0, uw, S, o, lane);
        gdn_norm_store(A, o, zs, gnw, PART, rowbase, nvalid, h, wave, lane);
        __syncthreads();
    }
#else
    u32x4 pfa[4], pfb[4]; u32x2 uw[2], uwn[2]; unsigned zs[8], zsn[8];
#define CH_LOADIMG(dst, nn) do { const u32x4* nx_ = (const u32x4*)(rec + (size_t)(nn) * REC_BYTES); _Pragma("unroll") for (int k = 0; k < 4; ++k) { const int i = tid + k * NTHREADS; if (i < IMG_V4) dst[k] = nx_[i]; } } while (0)
#define CH_STOREIMG(src, bufoff) do { _Pragma("unroll") for (int k = 0; k < 4; ++k) { const int i = tid + k * NTHREADS; if (i < IMG_V4) *(LDSP u32x4*)(l3 + (bufoff) + i * 16) = src[k]; } } while (0)
#define CH_LOADU(dst, nn) do { const bf16_t* Uw_ = (const bf16_t*)(rec + (size_t)(nn) * REC_BYTES + REC_U) + (size_t)wave * 512; dst[0] = *(const u32x2*)(Uw_ + (size_t)lane * 4); dst[1] = *(const u32x2*)(Uw_ + ((size_t)64 + lane) * 4); } while (0)
#define CH_ROWBASE(nn) (b * LP + ((nn) == 0 ? 0 : NMETA + ((nn) - 1) * CT))
    CH_LOADIMG(pfa, 1); CH_LOADU(uw, 0); gdn_zs_prefetch(A, zs, CH_ROWBASE(0), NMETA, h, wave, lane);
    CH_STOREIMG(pfa, LC_BUF1);
    lds_barrier();
    CH_LOADIMG(pfa, 2);
    for (int n = 0; n < NCH; n += 2) {
        if (n + 1 < NCH) { CH_LOADU(uwn, n + 1); gdn_zs_prefetch(A, zsn, CH_ROWBASE(n + 1), CT, h, wave, lane); }
        if (n + 3 < NCH) CH_LOADIMG(pfb, n + 3);
        gdn_step(l3 + LC_BUF0, uw, S, o, lane);
        gdn_norm_store(A, o, zs, gnw, PART, CH_ROWBASE(n), n == 0 ? NMETA : CT, h, wave, lane);
        if (n + 2 < NCH) CH_STOREIMG(pfa, LC_BUF0);
        lds_barrier();
        if (n + 1 >= NCH) break;
        if (n + 2 < NCH) { CH_LOADU(uw, n + 2); gdn_zs_prefetch(A, zs, CH_ROWBASE(n + 2), CT, h, wave, lane); }
        if (n + 4 < NCH) CH_LOADIMG(pfa, n + 4);
        gdn_step(l3 + LC_BUF1, uwn, S, o, lane);
        gdn_norm_store(A, o, zsn, gnw, PART, CH_ROWBASE(n + 1), CT, h, wave, lane);
        if (n + 3 < NCH) CH_STOREIMG(pfb, LC_BUF1);
        lds_barrier();
    }
#undef CH_LOADIMG
#undef CH_STOREIMG
#undef CH_LOADU
#undef CH_ROWBASE
#endif
#ifdef CHAIN_TWICE
    {
        float* scr = (float*)(A.ws + WS_C) + (size_t)(b * GH + h) * 128 * 128;
        if (CHAIN_PASS == 0) gdn_store_state(scr, S, wave, lane);
        else { const int q = lane >> 4, n = lane & 15; int bad = 0;
#pragma unroll
            for (int dt = 0; dt < 8; ++dt)
#pragma unroll
                for (int jj = 0; jj < 4; ++jj) bad |= (scr[(size_t)(dt * 16 + q * 4 + jj) * 128 + wave * 16 + n] != S[dt][jj]) ? 1 : 0;
            float* flagout = A.out + O_PRE + (size_t)(b * GH + h) * 512 + tid;
            if (!bad) *flagout = 0.f; }
    }
#else
#ifndef NO_PGDN
    gdn_store_state(A.out + O_PGDN + (size_t)(b * GH + h) * 128 * 128, S, wave, lane);
#endif
#endif
}

__device__ __forceinline__ void p5b_rows(const Args& A, int tid) {
    const int wave = tid >> 6, lane = tid & 63, G = gridDim.x;
    const bf16_t* MA = (const bf16_t*)(A.ws + WS_MIX); const bf16_t* MB = (const bf16_t*)(A.ws + WS_MIXB); bf16_t* F = (bf16_t*)(A.ws + WS_FB);
    f32x4 g1[4], g2[4];
#pragma unroll
    for (int j = 0; j < 4; ++j) { g1[j] = *(const f32x4*)(A.in[8] + 4 * lane + 256 * j); g2[j] = *(const f32x4*)(A.in[9] + 4 * lane + 256 * j); }
    for (int r0 = blockIdx.x * 8 + wave; r0 < T; r0 += G * 16) {
        int rr[2] = {r0, r0 + G * 8}; const bool has[2] = {true, rr[1] < T}; if (!has[1]) rr[1] = r0;
        u32x2 pa[2][4], pb[2][4]; f32x4 xv[2][4];
#pragma unroll
        for (int k = 0; k < 2; ++k) { const float* xr = x_row_ptr(A, rr[k]);
#pragma unroll
            for (int j = 0; j < 4; ++j) { pa[k][j] = *(const u32x2*)(MA + (size_t)rr[k] * 1024 + 4 * lane + 256 * j); pb[k][j] = *(const u32x2*)(MB + (size_t)rr[k] * 1024 + 4 * lane + 256 * j);
                xv[k][j] = *(const f32x4*)(xr + 4 * lane + 256 * j); } }
#pragma unroll
        for (int k = 0; k < 2; ++k) {
            if (!has[k]) continue;
            const int r = rr[k]; float* yr = y_row_ptr(A, r);
            f32x4 mvv[4]; float ss = 0.f;
#pragma unroll
            for (int j = 0; j < 4; ++j) { const u32x2 a = pa[k][j], b = pb[k][j];
                mvv[j] = (f32x4){bflo(a.x) + bflo(b.x), bfhi(a.x) + bfhi(b.x), bflo(a.y) + bflo(b.y), bfhi(a.y) + bfhi(b.y)};
                ss += (mvv[j][0] * mvv[j][0] + mvv[j][1] * mvv[j][1]) + (mvv[j][2] * mvv[j][2] + mvv[j][3] * mvv[j][3]); }
            const float rs = rsqrtf(wave_sum(ss) * (1.f / 1024.f) + EPS);
            f32x4 v[4]; float s1 = 0.f;
#pragma unroll
            for (int j = 0; j < 4; ++j) { v[j] = xv[k][j] + mvv[j] * rs * g1[j]; s1 += (v[j][0] * v[j][0] + v[j][1] * v[j][1]) + (v[j][2] * v[j][2] + v[j][3] * v[j][3]); }
            const float rs1 = rsqrtf(wave_sum(s1) * (1.f / 1024.f) + EPS);
#pragma unroll
            for (int j = 0; j < 4; ++j) {
                if (yr) *(f32x4*)(yr + 4 * lane + 256 * j) = v[j];
                const f32x4 f = v[j] * rs1 * g2[j]; u32x2 w; w.x = pk2(f[0], f[1]); w.y = pk2(f[2], f[3]); *(u32x2*)(F + (size_t)r * 1024 + 4 * lane + 256 * j) = w;
            }
        }
    }
}
__device__ __forceinline__ void p8_rows(const Args& A, int tid) {
    const int wave = tid >> 6, lane = tid & 63, G = gridDim.x;
    const bf16_t* FA = (const bf16_t*)(A.ws + WS_F2); const bf16_t* FB = (const bf16_t*)(A.ws + WS_F2B);
    f32x4 g1[4];
#pragma unroll
    for (int j = 0; j < 4; ++j) g1[j] = *(const f32x4*)(A.in[10] + 4 * lane + 256 * j);
    for (int r0 = blockIdx.x * 8 + wave; r0 < T; r0 += G * 16) {
        int rr[2] = {r0, r0 + G * 8}; float* yp[2];
        yp[0] = y_row_ptr(A, rr[0]); yp[1] = rr[1] < T ? y_row_ptr(A, rr[1]) : nullptr; if (rr[1] >= T) rr[1] = r0;
        u32x2 pa[2][4], pb[2][4]; f32x4 xv[2][4];
#pragma unroll
        for (int k = 0; k < 2; ++k) { const float* yr = yp[k] ? yp[k] : (yp[0] ? yp[0] : A.out);
#pragma unroll
            for (int j = 0; j < 4; ++j) { pa[k][j] = *(const u32x2*)(FA + (size_t)rr[k] * 1024 + 4 * lane + 256 * j); pb[k][j] = *(const u32x2*)(FB + (size_t)rr[k] * 1024 + 4 * lane + 256 * j);
                xv[k][j] = *(const f32x4*)(yr + 4 * lane + 256 * j); } }
#pragma unroll
        for (int k = 0; k < 2; ++k) {
            float* yr = yp[k]; if (!yr) continue;
            f32x4 f[4]; float ss = 0.f;
#pragma unroll
            for (int j = 0; j < 4; ++j) { const u32x2 a = pa[k][j], b = pb[k][j];
                f[j] = (f32x4){bflo(a.x) + bflo(b.x), bfhi(a.x) + bfhi(b.x), bflo(a.y) + bflo(b.y), bfhi(a.y) + bfhi(b.y)};
                ss += (f[j][0] * f[j][0] + f[j][1] * f[j][1]) + (f[j][2] * f[j][2] + f[j][3] * f[j][3]); }
            const float rs = rsqrtf(wave_sum(ss) * (1.f / 1024.f) + EPS);
#pragma unroll
            for (int j = 0; j < 4; ++j) *(f32x4*)(yr + 4 * lane + 256 * j) = xv[k][j] + f[j] * rs * g1[j];
        }
    }
}

__global__ void __launch_bounds__(NTHREADS, 2) hybrid_fwd(Args A) {
    extern __shared__ __attribute__((aligned(16))) unsigned char lds[];
    cg::grid_group grid = cg::this_grid();
    const int tid = threadIdx.x, wave = __builtin_amdgcn_readfirstlane(tid >> 6), lane = tid & 63, bid = blockIdx.x, G = gridDim.x;
    unsigned char* ws = A.ws;
    PG8_LAS unsigned char* ldsg = (PG8_LAS unsigned char*)lds;
    bf16_t* HN = (bf16_t*)(A.ws + WS_HN); bf16_t* GS = (bf16_t*)((unsigned char*)A.out + DO_GS);
#ifndef PHMASK
#define PHMASK 0x7ff
#endif
#ifndef DUPMASK
#define DUPMASK 0
#endif
#define IN(k) (((PHMASK >> (k)) & 1) && A.ph_lo <= (k) && (k) < A.ph_hi)
#define DUP(k) for (int rep_ = 0; rep_ < 1 + ((DUPMASK >> (k)) & 1); ++rep_)
#define DUPBAR(k) do { if (((DUPMASK >> (k)) & 1) && rep_ == 0) xcd_barrier(xbar); } while (0)
    volatile LAS unsigned* bst = (volatile LAS unsigned*)((LDSP unsigned char*)lds + (LDS_BYTES - 64));
    if (tid < 16) bst[tid] = 0u;
    __syncthreads();
    XcdBarrier xbar = xcd_barrier_post((unsigned*)(ws + WS_BAR), bst);
#define SEAM(k) do { if (IN(k) && IN((k) + 1)) xcd_barrier(xbar); } while (0)
    if (A.ph_lo < 0) grid.sync();
#ifdef L2_THRASH
    {
        const u32x4* src = (const u32x4*)A.in[0] + (size_t)bid * (L2_THRASH * 64); u32x4 accv = {0u, 0u, 0u, 0u};
        for (int i = tid; i < L2_THRASH * 64; i += NTHREADS) { const u32x4 v = src[i]; accv.x ^= v.x; accv.y ^= v.y; accv.z ^= v.z; accv.w ^= v.w; }
        if ((accv.x ^ accv.y ^ accv.z ^ accv.w) == 0x12345679u) ((unsigned*)(ws + WS_BAR))[4000] = 1u;
    }
#endif
#ifdef EXTRA_BARS
    for (int eb_ = 0; eb_ < EXTRA_BARS; ++eb_) xcd_barrier(xbar);
#endif
    if (IN(0)) DUP(0) {
#ifdef ZERO_REC
        { u32x4* zp = (u32x4*)(ws + WS_REC); const size_t nz = (size_t)32 * NCH * REC_BYTES / 16; const u32x4 z4 = {0u, 0u, 0u, 0u};
          for (size_t i = (size_t)bid * NTHREADS + tid; i < nz; i += (size_t)G * NTHREADS) zp[i] = z4; }
#endif
        p0_prologue(A, lds, tid, (G == 256) ? TR_I1 : TR_ITOT);
        DUPBAR(0);
    }
    SEAM(0);
    if (IN(1)) DUP(1) {
        if (G == 256) { p0_transposes(A, lds, tid, TR_I1, TR_ITOT, 158, 98); __syncthreads(); }
        pg8::StaticOrder so; so.init(TPAD, 2560, G, bid);
        EpiIn e{(bf16_t*)(ws + WS_U), (bf16_t*)(ws + WS_QKV), (bf16_t*)(ws + WS_ZS), A.out};
        pg8::gemm_phase<EpiIn, pg8::StaticOrder, true, true>(ldsg, pg8::Gemm{HN, (const bf16_t*)(ws + WS_W1), TPAD, 2560, 1024}, so, e);
        DUPBAR(1);
    }
    SEAM(1);
    if (IN(2)) DUP(2) {
        for (int u = bid; u < 2880; u += G) {
#ifndef NO_GDNP2
#ifndef P2R_A
#define P2R_A 1
#endif
#ifndef P2R_B
#define P2R_B 1
#endif
#ifndef P2R_C
#define P2R_C 1
#endif
            if (u < 2080) { const int bh = u / NCH, n = u - bh * NCH; for (int rr_ = 0; rr_ < P2R_A; ++rr_) gdn_prep(A, lds, 0, bh >> 2, bh & 3, n, tid); }
            else if (u < 2592) { const int bh = u - 2080; for (int rr_ = 0; rr_ < P2R_B; ++rr_) gdn_prep(A, lds, 1, bh >> 2, bh & 3, 0, tid); }
#endif
#ifndef NO_S5A
            if (u >= 2592 && u < 2848) { const int v = u - 2592, g = v >> 3, b = v & 7; for (int rr_ = 0; rr_ < P2R_C; ++rr_) s5_unit<0>(A, g, b, wave, lane); }
#endif
#ifndef NO_S5D
            if (u >= 2848) { const int v = (u - 2848) * 8 + wave, g = v >> 3, bg = v & 7; if (G * 8 < 2048) s5_decode(A, g, bg * 16, 16, lane); }
#endif
        }
        if (G == 256) { if (bid >= 32) for (int v = (bid - 32) * 8 + wave; v < 4096; v += 224 * 8) s5_decode(A, v >> 7, v & 127, 1, lane); }
        else if (G * 8 >= 2048) for (int v = bid * 8 + wave; v < 2048; v += G * 8) s5_decode(A, v >> 6, (v & 63) * 2, 2, lane);
        DUPBAR(2);
    }
    SEAM(2);
    if (IN(3)) DUP(3) {
        const bool chainwg = (G >= 128) && (bid < 64);
        if (G >= 128) { if (chainwg) gdn_chain2(A, lds, bid >> 3, (bid >> 1) & 3, bid & 1, tid); }
        else if (bid < 32) { gdn_chain<0>(A, lds, bid >> 2, bid & 3, tid); }
        for (int u = bid; u < 256; u += G) { const int g = u >> 3, b = u & 7; s5_unit<1>(A, g, b, wave, lane); }
        __syncthreads();
#ifndef NO_GGEMM
        const bool skipg = chainwg;
        pg8::StaticOrder so; if (G >= 128) so.init(TPAD, 2048, G - 64, bid - 64); else so.init(TPAD, 2048, G, bid);
        EpiGates e{(bf16_t*)(ws + WS_SG)};
#ifndef P3R_GG
#define P3R_GG 1
#endif
        if (!skipg) for (int rr_ = 0; rr_ < P3R_GG; ++rr_) pg8::gemm_phase<EpiGates, pg8::StaticOrder, true, true>(ldsg, pg8::Gemm{HN, (const bf16_t*)(ws + WS_W1) + (size_t)2560 * 1024, TPAD, 2048, 1024}, so, e);
#endif
        DUPBAR(3);
    }
    SEAM(3);
    if (IN(4)) DUP(4) {
        pg8::StaticOrder so; so.init(TPAD, 2048, G, bid);
        if (G >= 128) gdn_finish_rows(A, tid, (67 * 8 > 2 * G && 67 * 8 < 3 * G) ? 67 * 8 - 2 * G : 0);
        EpiGlu e{(const bf16_t*)(ws + WS_SG), (bf16_t*)(ws + WS_SA)};
        pg8::gemm_phase<EpiGlu, pg8::StaticOrder, true, true>(ldsg, pg8::Gemm{GS, (const bf16_t*)(ws + WS_WGLU), TPAD, 2048, 512}, so, e);
        DUPBAR(4);
    }
    SEAM(4);
    if (IN(5)) DUP(5) {
        pg8::StaticOrder so; so.init(TPAD, 1024, G, bid);
        EpiGdnOut e{(const bf16_t*)(ws + WS_SG), (const bf16_t*)(ws + WS_SA), (bf16_t*)(ws + WS_MIXIN)};
        pg8::gemm_phase<EpiGdnOut, pg8::StaticOrder, true, true>(ldsg, pg8::Gemm{(const bf16_t*)((unsigned char*)A.out + DO_ON), (const bf16_t*)(ws + WS_WGO), TPAD, 1024, 512}, so, e);
        DUPBAR(5);
    }
    SEAM(5);
    if (IN(6)) DUP(6) {
        pg8::SplitK2Order so; so.init(TPAD, 1024, G, bid);
        EpiBf16Part e{(bf16_t*)(ws + WS_MIX), (bf16_t*)(ws + WS_MIXB)};
        pg8::gemm_phase<EpiBf16Part, pg8::SplitK2Order, true, true>(ldsg, pg8::Gemm{(const bf16_t*)(ws + WS_MIXIN), (const bf16_t*)(ws + WS_WO), TPAD, 1024, 512, 1024}, so, e);
    }
    SEAM(6);
    if (IN(7)) DUP(7) { p5b_rows(A, tid); DUPBAR(7); }
    SEAM(7);
    if (IN(8)) DUP(8) {
        pg8::StaticOrder so; so.init(TPAD, 5632, G, bid);
        EpiFfnUp e{(bf16_t*)(ws + WS_H)};
        pg8::gemm_phase<EpiFfnUp, pg8::StaticOrder, true, true>(ldsg, pg8::Gemm{(const bf16_t*)(ws + WS_FB), (const bf16_t*)(ws + WS_WGU), TPAD, 5632, 1024}, so, e);
        DUPBAR(8);
    }
    SEAM(8);
    if (IN(9)) DUP(9) {
        pg8::SplitK2Order so; so.init(TPAD, 1024, G, bid);
        EpiBf16Part e{(bf16_t*)(ws + WS_F2), (bf16_t*)(ws + WS_F2B)};
        pg8::gemm_phase<EpiBf16Part, pg8::SplitK2Order, true, true>(ldsg, pg8::Gemm{(const bf16_t*)(ws + WS_H), (const bf16_t*)(ws + WS_WD), TPAD, 1024, DFF / 2, DFF}, so, e);
    }
    SEAM(9);
    if (IN(10)) DUP(10) { p8_rows(A, tid); DUPBAR(10); }
#undef IN
#undef SEAM
}

extern "C" void kernel_launch(void* const* d_in, const int* in_sizes, int n_in, void* d_out, int out_size, void* d_ws, size_t ws_size, hipStream_t stream) {
    static int grid = 0;
    if (grid == 0) {
        int dev = 0, cus = 0, per_cu = 0;
        hipGetDevice(&dev);
        hipDeviceGetAttribute(&cus, hipDeviceAttributeMultiprocessorCount, dev);
        hipFuncSetAttribute((const void*)hybrid_fwd, hipFuncAttributeMaxDynamicSharedMemorySize, LDS_BYTES);
        hipOccupancyMaxActiveBlocksPerMultiprocessor(&per_cu, (const void*)hybrid_fwd, NTHREADS, LDS_BYTES);
        (void)hipGetLastError();
        if (per_cu < 1) per_cu = 1;
        grid = cus * per_cu;
        if (n_in != 31 || ws_size < 256 * MiB) fprintf(stderr, "kernel_launch: unexpected n_in %d / ws %zu\n", n_in, ws_size);
    }
    (void)hipMemsetAsync((unsigned char*)d_ws + WS_BAR, 0, 16384, stream);
    Args a{};
    for (int i = 0; i < 31; ++i) a.in[i] = (const float*)d_in[i];
    a.out = (float*)d_out; a.ws = (unsigned char*)d_ws; a.ph_lo = 0; a.ph_hi = 11;
#ifndef REP3
#define REP3 1
#endif
    a.rep3 = REP3; a.pad_ = 0;
    void* args[] = {&a};
    hipError_t e = hipLaunchCooperativeKernel((const void*)hybrid_fwd, dim3(grid), dim3(NTHREADS), args, LDS_BYTES, stream);
    if (e != hipSuccess) fprintf(stderr, "cooperative launch failed: %s (grid %d)\n", hipGetErrorString(e), grid);
}
```
